# Optimizing an MI355X kernel written in HIP

```python
import jax, jax.numpy as jnp
from jax import lax
import numpy as np

D_MODEL = 2048
BATCH = 4
SEQ = 2048
DEPTH = 1
DEC_BATCH = 128
DEC_SEQ = 4
PAST_LEN = 16384
PAGE_SIZE = 128

HEAD_DIM = 64
D_RWKV = D_MODEL // 2
N_HEADS = D_RWKV // HEAD_DIM
RANK_W = 64
RANK_A = 64
RANK_G = 160
D_SHIFT = 3 * D_RWKV + RANK_W + RANK_A + RANK_G
D_POOL = D_MODEL // 2
POOL_WINDOWS = (2, 4, 8, 16)
N_POOL_GROUPS = len(POOL_WINDOWS)
POOL_GROUP = D_POOL // N_POOL_GROUPS
POOL_HIST = max(POOL_WINDOWS) - 1
D_IN = D_SHIFT + D_POOL + 2 * D_MODEL
D_FF = 5632
CONV_W = 3
NORM_EPS = 1e-6
GN_EPS = 64e-5

kernel_name = 'rwkv7_pool_gated_hybrid_step'


def _rmsnorm(x, g):
    xf = x.astype(jnp.float32)
    y = xf * lax.rsqrt(jnp.mean(xf * xf, axis=-1, keepdims=True) + NORM_EPS)
    return (y * g.astype(jnp.float32)).astype(x.dtype)


def _wkv_scan(s0, r, decay, k, v, a, b):
    def step(s, inp):
        r_t, w_t, k_t, v_t, a_t, b_t = inp
        sa = jnp.einsum('bhvk,bhk->bhv', s, a_t)
        s = s * w_t[:, :, None, :] + sa[..., None] * b_t[:, :, None, :] + v_t[..., None] * k_t[:, :, None, :]
        return s, jnp.einsum('bhvk,bhk->bhv', s, r_t)
    xs = tuple(jnp.moveaxis(t, 1, 0) for t in (r, decay, k, v, a, b))
    s, ys = lax.scan(step, s0, xs)
    return jnp.moveaxis(ys, 0, 1), s


def _rwkv7_branch(zs, wkv0, w0, w2, a0, a2, g2, k_k, k_a, r_k, lnx_w, lnx_b):
    B, T, _ = zs.shape
    f = zs.astype(jnp.float32)
    cuts = [D_RWKV, 2 * D_RWKV, 3 * D_RWKV, 3 * D_RWKV + RANK_W, 3 * D_RWKV + RANK_W + RANK_A]
    r, k, v, zw, za, zg = jnp.split(f, cuts, axis=-1)
    w_log = -jax.nn.softplus(-(w0 + jnp.tanh(zw) @ w2)) - 0.5
    decay = jnp.exp(-jnp.exp(w_log))
    a = jax.nn.sigmoid(a0 + za @ a2)
    g = jax.nn.sigmoid(zg) @ g2
    hs = lambda t: t.reshape(B, T, N_HEADS, HEAD_DIM)
    kk = hs(k * k_k)
    kk = kk / jnp.maximum(jnp.sqrt(jnp.sum(kk * kk, axis=-1, keepdims=True)), 1e-12)
    k = k * (1.0 + (a - 1.0) * k_a)
    rh, kh, vh, ah = hs(r), hs(k), hs(v), hs(a)
    y, wkv = _wkv_scan(wkv0.astype(jnp.float32), rh, hs(decay), kh, vh, -kk, kk * ah)
    mu = jnp.mean(y, axis=-1, keepdims=True)
    var = jnp.mean(jnp.square(y - mu), axis=-1, keepdims=True)
    y = ((y - mu) * lax.rsqrt(var + GN_EPS)).reshape(B, T, D_RWKV) * lnx_w + lnx_b
    bonus = jnp.sum(rh * kh * r_k, axis=-1, keepdims=True) * vh
    y = (y + bonus.reshape(B, T, D_RWKV)) * g
    return y.astype(zs.dtype), wkv.astype(wkv0.dtype)


def _pool_branch(zp, pool0, pos0, pool_w, pool_scale):
    B, T, _ = zp.shape
    buf = jnp.concatenate([pool0.astype(zp.dtype), zp], axis=1)
    c = jnp.cumsum(buf.astype(jnp.float32), axis=1)
    c = jnp.concatenate([jnp.zeros((B, 1, D_POOL), jnp.float32), c], axis=1)
    end = c[:, POOL_HIST + 1:]
    pos = pos0 + jnp.arange(T)
    means = []
    for gi, win in enumerate(POOL_WINDOWS):
        lo, hi = gi * POOL_GROUP, (gi + 1) * POOL_GROUP
        start = c[:, POOL_HIST + 1 - win: POOL_HIST + 1 - win + T, lo:hi]
        cnt = jnp.minimum(win, pos + 1).astype(jnp.float32)[None, :, None]
        means.append((end[..., lo:hi] - start) / cnt)
    d = jnp.concatenate(means, axis=-1) - zp.astype(jnp.float32)
    d = d.reshape(B, T, N_POOL_GROUPS, POOL_GROUP)
    y = jnp.einsum('btgc,gcd->btgd', d, pool_w).reshape(B, T, D_POOL) * pool_scale
    return y.astype(zp.dtype), buf[:, -POOL_HIST:]


def _conv_ffn(h, conv0, w_ffn_in, conv_w, conv_b, w_ffn_out):
    T = h.shape[1]
    gate, up = jnp.split(h @ w_ffn_in, 2, axis=-1)
    buf = jnp.concatenate([conv0.astype(gate.dtype), gate], axis=1)
    cv = conv_b + sum(conv_w[j] * buf[:, j:j + T] for j in range(CONV_W))
    out = (jax.nn.gelu(cv, approximate=True) * up) @ w_ffn_out
    return out, buf[:, -(CONV_W - 1):]


def _layer(x, st_shift, st_wkv, st_pool, st_conv, pos0,
           norm_pre_mix, w_in, mu_shift, w0, w2, a0, a2, g2, k_k, k_a, r_k, lnx_w, lnx_b,
           w_branch_a, pool_w, pool_scale, w_branch_b, w_out, norm_post_mix,
           norm_pre_ffn, w_ffn_in, conv_w, conv_b, w_ffn_out, norm_post_ffn):
    h = _rmsnorm(x, norm_pre_mix)
    z = h @ w_in
    zs, zp, zga, zgb = jnp.split(z, [D_SHIFT, D_SHIFT + D_POOL, D_SHIFT + D_POOL + D_MODEL], axis=-1)
    prev = jnp.concatenate([st_shift.astype(zs.dtype), zs[:, :-1]], axis=1)
    zs_mix = zs + (prev - zs) * mu_shift
    ya, new_wkv = _rwkv7_branch(zs_mix, st_wkv, w0, w2, a0, a2, g2, k_k, k_a, r_k, lnx_w, lnx_b)
    yb, new_pool = _pool_branch(zp, st_pool, pos0, pool_w, pool_scale)
    m = jax.nn.sigmoid(zga) * (ya @ w_branch_a) + jax.nn.sigmoid(zgb) * (yb @ w_branch_b)
    x = x + _rmsnorm(m @ w_out, norm_post_mix)
    f, new_conv = _conv_ffn(_rmsnorm(x, norm_pre_ffn), st_conv, w_ffn_in, conv_w, conv_b, w_ffn_out)
    x = x + _rmsnorm(f.astype(x.dtype), norm_post_ffn)
    return x, zs[:, -1:], new_wkv, new_pool, new_conv


def setup_inputs(seed: int = 0) -> dict:
    key = jax.random.key(seed)
    ks = iter(jax.random.split(key, 40))
    nrm = lambda shape, scale: jax.random.normal(next(ks), shape, jnp.float32) * scale
    L = DEPTH
    return {
        'x_prompt': nrm((BATCH, SEQ, D_MODEL), 1.0),
        'x_sample': nrm((DEC_BATCH, DEC_SEQ, D_MODEL), 1.0),
        'state_shift': nrm((L, DEC_BATCH, 1, D_SHIFT), 1.0),
        'state_wkv': nrm((L, DEC_BATCH, N_HEADS, HEAD_DIM, HEAD_DIM), 0.3),
        'state_pool': nrm((L, DEC_BATCH, POOL_HIST, D_POOL), 1.0),
        'state_conv': nrm((L, DEC_BATCH, CONV_W - 1, D_FF), 1.0),
        'norm_pre_mix': 1.0 + nrm((L, D_MODEL), 0.02),
        'w_in': nrm((L, D_MODEL, D_IN), D_MODEL ** -0.5),
        'mu_shift': jax.random.uniform(next(ks), (L, D_SHIFT), jnp.float32),
        'w0': nrm((L, D_RWKV), 0.5) - 0.5,
        'w2': nrm((L, RANK_W, D_RWKV), 0.1),
        'a0': nrm((L, D_RWKV), 0.1),
        'a2': nrm((L, RANK_A, D_RWKV), 0.1),
        'g2': nrm((L, RANK_G, D_RWKV), RANK_G ** -0.5),
        'k_k': 0.85 + nrm((L, D_RWKV), 0.02),
        'k_a': 1.0 + nrm((L, D_RWKV), 0.02),
        'r_k': nrm((L, N_HEADS, HEAD_DIM), 0.1),
        'lnx_w': 1.0 + nrm((L, D_RWKV), 0.02),
        'lnx_b': nrm((L, D_RWKV), 0.02),
        'w_branch_a': nrm((L, D_RWKV, D_MODEL), D_RWKV ** -0.5),
        'pool_w': nrm((L, N_POOL_GROUPS, POOL_GROUP, POOL_GROUP), POOL_GROUP ** -0.5),
        'pool_scale': 1.0 + nrm((L, D_POOL), 0.02),
        'w_branch_b': nrm((L, D_POOL, D_MODEL), D_POOL ** -0.5),
        'w_out': nrm((L, D_MODEL, D_MODEL), D_MODEL ** -0.5),
        'norm_post_mix': 1.0 + nrm((L, D_MODEL), 0.02),
        'norm_pre_ffn': 1.0 + nrm((L, D_MODEL), 0.02),
        'w_ffn_in': nrm((L, D_MODEL, 2 * D_FF), D_MODEL ** -0.5),
        'conv_w': nrm((L, CONV_W, D_FF), CONV_W ** -0.5),
        'conv_b': nrm((L, D_FF), 0.02),
        'w_ffn_out': nrm((L, D_FF, D_MODEL), D_FF ** -0.5),
        'norm_post_ffn': 1.0 + nrm((L, D_MODEL), 0.02),
    }


def reference(x_prompt, x_sample, state_shift, state_wkv, state_pool, state_conv,
              norm_pre_mix, w_in, mu_shift, w0, w2, a0, a2, g2, k_k, k_a, r_k, lnx_w, lnx_b,
              w_branch_a, pool_w, pool_scale, w_branch_b, w_out, norm_post_mix,
              norm_pre_ffn, w_ffn_in, conv_w, conv_b, w_ffn_out, norm_post_ffn):
    weights = (norm_pre_mix, w_in, mu_shift, w0, w2, a0, a2, g2, k_k, k_a, r_k, lnx_w, lnx_b,
               w_branch_a, pool_w, pool_scale, w_branch_b, w_out, norm_post_mix,
               norm_pre_ffn, w_ffn_in, conv_w, conv_b, w_ffn_out, norm_post_ffn)
    bp = x_prompt.shape[0]
    dt = x_prompt.dtype
    yp, ys = x_prompt, x_sample
    p_shift, p_wkv, p_pool, p_conv = [], [], [], []
    s_shift, s_wkv, s_pool, s_conv = [], [], [], []
    for l in range(DEPTH):
        p = tuple(w[l] for w in weights)
        yp, a1, a2_, a3, a4 = _layer(
            yp,
            jnp.zeros((bp, 1, D_SHIFT), dt),
            jnp.zeros((bp, N_HEADS, HEAD_DIM, HEAD_DIM), state_wkv.dtype),
            jnp.zeros((bp, POOL_HIST, D_POOL), dt),
            jnp.zeros((bp, CONV_W - 1, D_FF), dt),
            0, *p)
        p_shift.append(a1); p_wkv.append(a2_); p_pool.append(a3); p_conv.append(a4)
        ys, b1, b2, b3, b4 = _layer(ys, state_shift[l], state_wkv[l], state_pool[l], state_conv[l],
                                    PAST_LEN, *p)
        s_shift.append(b1); s_wkv.append(b2); s_pool.append(b3); s_conv.append(b4)
    return (yp, ys,
            jnp.stack(p_shift), jnp.stack(p_wkv), jnp.stack(p_pool), jnp.stack(p_conv),
            jnp.stack(s_shift), jnp.stack(s_wkv), jnp.stack(s_pool), jnp.stack(s_conv))
```

```cpp
#include <hip/hip_runtime.h>
#include <hip/hip_cooperative_groups.h>
#include <cstdio>
namespace cg = cooperative_groups;

#define LAS __attribute__((address_space(3)))
typedef unsigned short bf16_t;
typedef short bf16x8 __attribute__((ext_vector_type(8)));
typedef float f32x4 __attribute__((ext_vector_type(4)));
typedef float f32x2 __attribute__((ext_vector_type(2)));
typedef unsigned u32x4 __attribute__((ext_vector_type(4)));
typedef unsigned u32x2 __attribute__((ext_vector_type(2)));

constexpr int M = 8704;
constexpr int MP = 8192;
constexpr int DM = 2048, DR = 1024, DSH = 3360, DFF = 5632;
constexpr int ZLD = 8704;
constexpr int ZC_LR = 3072, ZC_P = 3584, ZC_GA = 4608, ZC_GB = 6656;
constexpr int NTHR = 512;
constexpr int LDS_BYTES = 131072;
constexpr float NORM_EPS = 1e-6f, GN_EPS = 64e-5f;

constexpr size_t O_Y = 0;
constexpr size_t O_PSHIFT = 17825792, O_PWKV = 17839232, O_PPOOL = 18101376, O_PCONV = 18162816;
constexpr size_t O_SSHIFT = 18207872, O_SWKV = 18637952, O_SPOOL = 27026560, O_SCONV = 28992640;

constexpr size_t SZ_M1024_BF = (size_t)M * 1024 * 2;
constexpr size_t W_AB = 0;
constexpr size_t W_O = W_AB + 8388608;
constexpr size_t W_POOL = W_O + 8388608;
constexpr size_t W_LR = W_POOL + 524288;
constexpr size_t W_SSQ = W_LR + 1572864;
constexpr size_t W_RA = W_SSQ + (size_t)M * 32 * 4;
constexpr size_t W_IN = W_RA;
constexpr size_t W_H = W_RA + (size_t)8704 * 2048 * 2;
constexpr size_t W_GU = W_RA;
constexpr size_t W_D = W_RA + (size_t)11264 * 2048 * 2;
constexpr size_t W_Z = W_RA + (size_t)2 * 8704 * 2048 * 2;
constexpr size_t W_H2 = W_Z;
constexpr size_t W_GATE = W_Z + (size_t)M * 2048 * 2;
constexpr size_t W_F = W_Z;
constexpr size_t W_O16 = W_Z + (size_t)M * 2048 * 4 + (size_t)1048576;
constexpr size_t W_PART5 = W_Z + (size_t)M * 2048 * 2;
constexpr size_t W_PART9 = W_Z + (size_t)M * 2048 * 4;
constexpr size_t W_RC = W_Z + (size_t)M * ZLD * 2;
constexpr size_t W_XW = W_RC;
constexpr size_t W_XA = W_XW + SZ_M1024_BF;
constexpr size_t W_GG = W_XA + SZ_M1024_BF;
constexpr size_t W_DYA = W_GG + SZ_M1024_BF;
constexpr size_t W_YB = W_DYA + SZ_M1024_BF;
constexpr size_t W_A2 = W_YB + SZ_M1024_BF;
constexpr size_t W_MM = W_XW;
constexpr size_t W_ACT = W_RC;
constexpr size_t W_BAR = W_A2 + (size_t)M * 768 * 2;
constexpr size_t W_SF = W_BAR + 16384;
constexpr size_t W_END = W_SF + (size_t)2048 * 8192;

struct Params { const float* in[31]; float* out; unsigned char* ws; };
typedef const __attribute__((address_space(4))) Params* KArgP;
__device__ __forceinline__ KArgP kargs() { KArgP q = (KArgP)__builtin_amdgcn_kernarg_segment_ptr(); asm volatile("" : "+s"(q)); return q; }

__device__ __forceinline__ float bf2f(bf16_t b) { return __uint_as_float(((unsigned)b) << 16); }
__device__ __forceinline__ bf16_t f2bf(float f) { unsigned u = __float_as_uint(f); u += 0x7FFFu + ((u >> 16) & 1u); return (bf16_t)(u >> 16); }
typedef __bf16 bf16n2 __attribute__((ext_vector_type(2)));
__device__ __forceinline__ unsigned cvt_pk_bf16(float lo, float hi) { const f32x2 v = {lo, hi}; const bf16n2 r = __builtin_convertvector(v, bf16n2); unsigned u; __builtin_memcpy(&u, &r, 4); return u; }
__device__ __forceinline__ float lo_bf(unsigned w) { return __uint_as_float(w << 16); }
__device__ __forceinline__ float hi_bf(unsigned w) { return __uint_as_float(w & 0xffff0000u); }
__device__ __forceinline__ float sigmoidf_(float x) { return __builtin_amdgcn_rcpf(1.0f + __expf(-x)); }
#define DPP_ADD(v, ctrl) ((v) + __uint_as_float(__builtin_amdgcn_update_dpp(0u, __float_as_uint(v), (ctrl), 0xF, 0xF, true)))
__device__ __forceinline__ float xor16_sum(float v) { const auto r = __builtin_amdgcn_permlane16_swap(__float_as_uint(v), __float_as_uint(v), false, false); return __uint_as_float(r[0]) + __uint_as_float(r[1]); }
__device__ __forceinline__ float xor32_sum(float v) { const auto r = __builtin_amdgcn_permlane32_swap(__float_as_uint(v), __float_as_uint(v), false, false); return __uint_as_float(r[0]) + __uint_as_float(r[1]); }
__device__ __forceinline__ float wave_sum(float v) {
    v = DPP_ADD(v, 0xB1);
    v = DPP_ADD(v, 0x4E);
    v = DPP_ADD(v, 0x141);
    v = DPP_ADD(v, 0x140);
    v = xor16_sum(v);
    return xor32_sum(v);
}
__device__ __forceinline__ const float* xrow(KArgP p, int r) { return r < MP ? p->in[0] + (size_t)r * DM : p->in[1] + (size_t)(r - MP) * DM; }
__device__ __forceinline__ float gelu_tanh(float x) {
    const float u = 0.7978845608f * (x + 0.044715f * x * x * x);
    return x * __builtin_amdgcn_rcpf(1.0f + __expf(-2.0f * u));
}


#define XB_TMO      128
#define XB_XCNT(j)  (256  + 64 * (j))
#define XB_XSUB(j)  (1280 + 64 * (j))
#define XB_XGEN(j)  (2304 + 64 * (j))
#define XB_TOP      3328
#define XB_TOPGEN   3392
#define XCD_BAR_WORDS 3456
#define XB_SPIN_CAP (1u << 18)
__device__ __forceinline__ unsigned xb_ld(unsigned* p)              { return __hip_atomic_load(p, __ATOMIC_RELAXED, __HIP_MEMORY_SCOPE_AGENT); }
__device__ __forceinline__ unsigned xb_add(unsigned* p, unsigned v) { return __hip_atomic_fetch_add(p, v, __ATOMIC_RELAXED, __HIP_MEMORY_SCOPE_AGENT); }
__device__ __forceinline__ unsigned xb_xcc_id() { return (unsigned)__builtin_amdgcn_s_getreg((3 << 11) | 20) & 0xFu; }
#define XB_SPIN(cond, bar) do { unsigned _sp = 0; while (cond) { __builtin_amdgcn_s_sleep(1); \
    if ((++_sp & 255u) == 0u) { if (xb_ld(&(bar)[XB_TMO])) break; if (_sp > XB_SPIN_CAP) { atomicAdd(&(bar)[XB_TMO], 1u); break; } } } } while (0)
struct XcdBarrier { unsigned* bar; unsigned x; volatile LAS unsigned* st; };
__device__ __forceinline__ XcdBarrier xcd_barrier_post(unsigned* bar, volatile LAS unsigned* st) {
    XcdBarrier b; b.bar = bar; b.x = xb_xcc_id(); b.st = st;
    if (threadIdx.x == 0) (void)xb_add(&bar[XB_XCNT(b.x)], 1u);
    return b;
}
__device__ __forceinline__ void xcd_barrier_complete(unsigned* bar, unsigned x, unsigned& nloc, unsigned& nx) {
    const unsigned G = gridDim.x * gridDim.y * gridDim.z;
    unsigned sum, cnt, mine, sp = 0u;
    for (;;) {
        sum = 0u; cnt = 0u; mine = 0u;
#pragma unroll
        for (unsigned j = 0; j < 16; ++j) { const unsigned c = xb_ld(&bar[XB_XCNT(j)]); sum += c; cnt += (c > 0u) ? 1u : 0u; mine = (j == x) ? c : mine; }
        if (sum == G) break;
        __builtin_amdgcn_s_sleep(1);
        if ((++sp & 255u) == 0u) { if (xb_ld(&bar[XB_TMO])) break; if (sp > XB_SPIN_CAP) { atomicAdd(&bar[XB_TMO], 1u); break; } }
    }
    nloc = mine > 0u ? mine : 1u; nx = cnt > 0u ? cnt : 1u;
}
__device__ __forceinline__ void xcd_barrier(const XcdBarrier& b) {
    asm volatile("s_waitcnt vmcnt(0)" ::: "memory");
    __syncthreads();
    if (threadIdx.x == 0) {
        unsigned* bar = b.bar;
        __builtin_amdgcn_s_waitcnt(0);
        unsigned nloc = b.st[0], nx = b.st[1];
        if (nloc == 0u) { xcd_barrier_complete(bar, b.x, nloc, nx); b.st[0] = nloc; b.st[1] = nx; }
        const unsigned old = xb_add(&bar[XB_XSUB(b.x)], 1u);
        const unsigned gen = old / nloc;
        if (old + 1u == (gen + 1u) * nloc) {
            __builtin_amdgcn_fence(__ATOMIC_RELEASE, "agent");
            asm volatile("s_waitcnt vmcnt(0)" ::: "memory");
            const unsigned og = xb_add(&bar[XB_TOP], 1u);
            const unsigned tg = og / nx;
            if (og + 1u == (tg + 1u) * nx) xb_add(&bar[XB_TOPGEN], 1u);
            else XB_SPIN(xb_ld(&bar[XB_TOPGEN]) == tg, bar);
            __builtin_amdgcn_fence(__ATOMIC_ACQUIRE, "agent");
            xb_add(&bar[XB_XGEN(b.x)], 1u);
            asm volatile("s_waitcnt vmcnt(0)" ::: "memory");
        } else {
            XB_SPIN(xb_ld(&bar[XB_XGEN(b.x)]) == gen, bar);
            __builtin_amdgcn_fence(__ATOMIC_ACQUIRE, "agent");
            asm volatile("s_waitcnt vmcnt(0)" ::: "memory");
        }
    }
    __syncthreads();
}

namespace pg8 {
constexpr int BM = 256, BK = 64, HALF = 128, HTB = HALF * BK * 2, NXCD = 8, WGM = 8;
__device__ __forceinline__ int lds_byte(int r, int c) { const int st = (r >> 4) * 2 + (c >> 5), rr = r & 15, cc = c & 31, ob = rr * 64 + cc * 2; return st * 1024 + (ob ^ (((ob >> 9) & 1) << 5)); }
__device__ __forceinline__ void stage_rc(int b, int& R, int& C) { const int st = b / 1024, sb = b % 1024, swz = sb ^ (((sb >> 9) & 1) << 5); R = (st >> 1) * 16 + swz / 64; C = (st & 1) * 32 + (swz % 64) / 2; }
__device__ __forceinline__ int perm32(int rho) { const int n = rho >> 4, i = rho & 15; return 8 * (i >> 2) + 4 * n + (i & 3); }

struct Unit { int pm, pn, k0, nt, sp; };
struct Gemm { const bf16_t* A; const bf16_t* Bt; int M, N, K, lda, ldb, agshift, agcols; };

struct StaticOrder {
    int nM, nN, nwg, G, c;
    int ntk;
    __device__ __forceinline__ void init(int M_, int N_, int G_, int c_, int K_) { nM = M_ / BM; nN = N_ / BM; nwg = nM * nN; G = G_; c = c_; ntk = K_ / BK; }
    __device__ __forceinline__ Unit get(int i) const {
        Unit u; u.pm = 0; u.pn = 0; u.k0 = 0; u.nt = 0; u.sp = -1;
        const long L = (long)i * G + c; if (L >= nwg) return u;
        int wgid = (int)L; { const int q = nwg / NXCD, r = nwg % NXCD, xcd = wgid % NXCD, off = wgid / NXCD; wgid = (xcd < r ? xcd * (q + 1) : r * (q + 1) + (xcd - r) * q) + off; }
        const int nig = WGM * nN, gid = wgid / nig, fm = gid * WGM, gsz = (nM - fm) < WGM ? (nM - fm) : WGM;
        u.pm = fm + ((wgid % nig) % gsz); u.pn = (wgid % nig) / gsz; u.nt = ntk; return u;
    }
};
struct SampleOrder {
    StaticOrder base;
    __device__ __forceinline__ Unit get(int i) const {
        int cnt = 0; Unit e; e.pm = 0; e.pn = 0; e.k0 = 0; e.nt = 0; e.sp = -1;
#pragma unroll
        for (int k = 0; k < 3; ++k) { const Unit u = base.get(k); if (u.nt != 0 && u.pm >= 32) { if (cnt == i) return u; ++cnt; } }
        return e;
    }
};
struct MixOrder {
    StaticOrder base; int G, c; bool sample_only;
    __device__ __forceinline__ Unit get(int i) const {
        Unit u; u.pm = 0; u.pn = 0; u.k0 = 0; u.nt = 0; u.sp = -1;
        const int np = G - 16;
        if (c < np) { if (sample_only) return u; StaticOrder b = base; b.G = 1 << 20; b.c = c + i * np; return (i < 64 && c + i * np < 256) ? b.get(0) : u; }
        const int t = c - np; if (i == 0 && t < 16) { u.pm = 32 + (t >> 3); u.pn = t & 7; u.nt = base.ntk; }
        return u;
    }
};
struct SplitOrder {
    StaticOrder base; int S, nbase;
    __device__ __forceinline__ void init(int G_, int c_, int K_, int S_) { base.init(8192, 2048, G_, c_, K_); S = S_; nbase = (c_ < 256) ? (256 - c_ + G_ - 1) / G_ : 0; }
    __device__ __forceinline__ Unit get(int i) const {
        if (i < nbase) return base.get(i);
        Unit u; u.pm = 0; u.pn = 0; u.k0 = 0; u.nt = 0; u.sp = -1;
        if (i == nbase && base.c < 16 * S) { const int uu = base.c / S, sp = base.c % S; u.pm = 32 + (uu >> 3); u.pn = uu & 7; u.nt = base.ntk / S; u.k0 = sp * u.nt; u.sp = sp; }
        return u;
    }
};

template <class Epi, class Sched>
__device__ __forceinline__ void gemm_phase(LAS unsigned char* lds, const Gemm g, const Sched& S, const Epi& E) {
    int tid = threadIdx.x; asm volatile("" : "+v"(tid));
    const int wid = __builtin_amdgcn_readfirstlane(tid >> 6), lane = tid & 63, wr = wid >> 2, wc = wid & 3, fr = lane & 15, fq = lane >> 4;
    unsigned voffA[2], voffB[2];
#pragma unroll
    for (int i = 0; i < 2; ++i) { int R, C; stage_rc(tid * 16 + i * 8192, R, C); const int Rb = Epi::PERM ? ((R & ~31) + perm32(R & 31)) : R;
        voffA[i] = (unsigned)(R * g.lda + C) * 2u; voffB[i] = (unsigned)(Rb * g.ldb + C) * 2u; }
    const size_t kstep = (size_t)(BK * 2);
    const size_t hstepA = (size_t)HALF * g.lda * 2, hstepB = (size_t)HALF * g.ldb * 2;
    const size_t tstepA = 2 * hstepA, tstepB = 2 * hstepB;
    const unsigned ldsw = (unsigned)wid * 1024u;
    const int aoff = lds_byte(wr * 64 + fr, fq * 8), boff = lds_byte(wc * 32 + fr, fq * 8);
#define PG8_SA(b, h) (((b) * 2 + (h)) * HTB)
#define PG8_SB(b, h) ((4 + (b) * 2 + (h)) * HTB)
#define PG8_STAGE(bufoff, gbase, voff) do { _Pragma("unroll") for (int _i = 0; _i < 2; ++_i) \
        __builtin_amdgcn_global_load_lds((const unsigned*)((const char*)(gbase) + (voff)[_i]), (LAS unsigned*)(lds + (bufoff) + ldsw + _i * 8192), 16, 0, 0); } while (0)
#define PG8_LDA(dst, b, h) do { _Pragma("unroll") for (int m = 0; m < 4; ++m) _Pragma("unroll") for (int k = 0; k < 2; ++k) dst[m][k] = *(const LAS bf16x8*)(lds + PG8_SA(b, h) + aoff + m * 2048 + k * 1024); } while (0)
#define PG8_LDB(dst, b, h) do { _Pragma("unroll") for (int n = 0; n < 2; ++n) _Pragma("unroll") for (int k = 0; k < 2; ++k) dst[n][k] = *(const LAS bf16x8*)(lds + PG8_SB(b, h) + boff + n * 2048 + k * 1024); } while (0)
#define PG8_MMA(ai, bj, At, Bt) do { __builtin_amdgcn_s_setprio(1); _Pragma("unroll") for (int m = 0; m < 4; ++m) _Pragma("unroll") for (int n = 0; n < 2; ++n) _Pragma("unroll") for (int k = 0; k < 2; ++k) \
        acc[ai][bj][m][n] = __builtin_amdgcn_mfma_f32_16x16x32_bf16(Bt[n][k], At[m][k], acc[ai][bj][m][n], 0, 0, 0); __builtin_amdgcn_s_setprio(0); } while (0)
#define PG8_WAIT_V(n) asm volatile("s_waitcnt vmcnt(" #n ")" ::: "memory")
#define PG8_WAIT_L(n) asm volatile("s_waitcnt lgkmcnt(" #n ")" ::: "memory")
#define PG8_BAR __builtin_amdgcn_s_barrier()
#define PG8_SCHED __builtin_amdgcn_sched_barrier(0)
    Unit cur = S.get(0), nxt; int ui = 0;
    if (cur.nt == 0) return;
    f32x4 acc[2][2][4][2];
#pragma unroll
    for (int a = 0; a < 2; ++a)
#pragma unroll
        for (int b = 0; b < 2; ++b)
#pragma unroll
            for (int m = 0; m < 4; ++m)
#pragma unroll
                for (int n = 0; n < 2; ++n) acc[a][b][m][n] = (f32x4){0.f, 0.f, 0.f, 0.f};
    bf16x8 At[4][2], B0[2][2], B1[2][2];
    const char* cA = (const char*)g.A + (size_t)cur.pm * tstepA + (size_t)((cur.pn >> g.agshift) * g.agcols) * 2 + (size_t)cur.k0 * kstep; const char* cB = (const char*)g.Bt + (size_t)cur.pn * tstepB + (size_t)cur.k0 * kstep;
    PG8_STAGE(PG8_SB(0, 0), cB, voffB); PG8_STAGE(PG8_SA(0, 0), cA, voffA); PG8_STAGE(PG8_SB(0, 1), cB + hstepB, voffB); PG8_STAGE(PG8_SA(0, 1), cA + hstepA, voffA);
    if (wr == 1) PG8_BAR;
    PG8_WAIT_V(4); PG8_BAR;
    PG8_STAGE(PG8_SB(1, 0), cB + kstep, voffB); PG8_STAGE(PG8_SA(1, 0), cA + kstep, voffA); PG8_STAGE(PG8_SB(1, 1), cB + hstepB + kstep, voffB);
    PG8_WAIT_V(6); PG8_BAR;
    for (;;) {
        nxt = S.get(ui + 1); const bool has_next = nxt.nt != 0;
        const char* nA = has_next ? (const char*)g.A + (size_t)nxt.pm * tstepA + (size_t)((nxt.pn >> g.agshift) * g.agcols) * 2 + (size_t)nxt.k0 * kstep : cA; const char* nB = has_next ? (const char*)g.Bt + (size_t)nxt.pn * tstepB + (size_t)nxt.k0 * kstep : cB;
        const int nt = cur.nt;
        for (int t = 0; t < nt; t += 2) {
            const bool last = (t == nt - 2);
            const char* a1 = cA + (size_t)(t + 1) * kstep;
            const char* a2 = last ? nA : cA + (size_t)(t + 2) * kstep; const char* b2 = last ? nB : cB + (size_t)(t + 2) * kstep;
            const char* a3 = a2 + kstep; const char* b3 = b2 + kstep;
            PG8_LDB(B0, 0, 0); PG8_SCHED; PG8_LDA(At, 0, 0); PG8_STAGE(PG8_SA(1, 1), a1 + hstepA, voffA);
            PG8_WAIT_L(8); PG8_BAR; PG8_WAIT_L(0); PG8_MMA(0, 0, At, B0); PG8_BAR; PG8_SCHED;
            PG8_LDB(B1, 0, 1); PG8_STAGE(PG8_SB(0, 0), b2, voffB);
            PG8_BAR; PG8_WAIT_L(0); PG8_MMA(0, 1, At, B1); PG8_BAR;
            PG8_LDA(At, 0, 1); PG8_STAGE(PG8_SA(0, 0), a2, voffA);
            PG8_BAR; PG8_WAIT_L(0); PG8_MMA(1, 0, At, B0); PG8_BAR; PG8_SCHED;
            PG8_STAGE(PG8_SB(0, 1), b2 + hstepB, voffB);
            PG8_WAIT_V(6); PG8_BAR; PG8_MMA(1, 1, At, B1); PG8_BAR;
            PG8_LDB(B0, 1, 0); PG8_SCHED; PG8_LDA(At, 1, 0); PG8_STAGE(PG8_SA(0, 1), a2 + hstepA, voffA);
            PG8_WAIT_L(8); PG8_BAR; PG8_WAIT_L(0); PG8_MMA(0, 0, At, B0); PG8_BAR; PG8_SCHED;
            PG8_LDB(B1, 1, 1); PG8_STAGE(PG8_SB(1, 0), b3, voffB);
            PG8_BAR; PG8_WAIT_L(0); PG8_MMA(0, 1, At, B1); PG8_BAR;
            PG8_LDA(At, 1, 1); PG8_STAGE(PG8_SA(1, 0), a3, voffA);
            PG8_BAR; PG8_WAIT_L(0); PG8_MMA(1, 0, At, B0); PG8_BAR; PG8_SCHED;
            PG8_STAGE(PG8_SB(1, 1), b3 + hstepB, voffB);
            PG8_WAIT_V(6); PG8_BAR; PG8_MMA(1, 1, At, B1); PG8_BAR;
        }
        E(acc, cur, wr, wc, fr, fq);
        if (!has_next) break;
#pragma unroll
        for (int a = 0; a < 2; ++a)
#pragma unroll
            for (int b = 0; b < 2; ++b)
#pragma unroll
                for (int m = 0; m < 4; ++m)
#pragma unroll
                    for (int n = 0; n < 2; ++n) acc[a][b][m][n] = (f32x4){0.f, 0.f, 0.f, 0.f};
        cur = nxt; cA = nA; cB = nB; ++ui;
    }
    PG8_WAIT_V(0);
    if (wr == 0) PG8_BAR;
    PG8_BAR;
#undef PG8_SA
#undef PG8_SB
#undef PG8_STAGE
#undef PG8_LDA
#undef PG8_LDB
#undef PG8_MMA
#undef PG8_WAIT_V
#undef PG8_WAIT_L
#undef PG8_BAR
#undef PG8_SCHED
}
}
using pg8::Unit;
typedef const f32x4 (&AccRef)[2][2][4][2];

__device__ __forceinline__ u32x4 pack8(f32x4 v0, f32x4 v1) { u32x4 w; w.x = cvt_pk_bf16(v0[0], v0[1]); w.y = cvt_pk_bf16(v0[2], v0[3]); w.z = cvt_pk_bf16(v1[0], v1[1]); w.w = cvt_pk_bf16(v1[2], v1[3]); return w; }
__device__ __forceinline__ void unpack8(u32x4 w, f32x4& a, f32x4& b) { a = (f32x4){lo_bf(w.x), hi_bf(w.x), lo_bf(w.y), hi_bf(w.y)}; b = (f32x4){lo_bf(w.z), hi_bf(w.z), lo_bf(w.w), hi_bf(w.w)}; }

struct EpiZ {
    static constexpr bool PERM = true;
    bf16_t* Z; float* out;
    __device__ __forceinline__ void operator()(AccRef acc, const Unit& u, int wr, int wc, int fr, int fq) const {
        const int row0 = u.pm * 256 + wr * 64 + fr, col0 = u.pn * 256 + wc * 32 + 8 * fq;
#pragma unroll
        for (int ai = 0; ai < 2; ++ai)
#pragma unroll
            for (int m = 0; m < 4; ++m) { bf16_t* rowp = Z + (size_t)(row0 + ai * 128 + m * 16) * ZLD + col0;
#pragma unroll
                for (int bj = 0; bj < 2; ++bj) *(u32x4*)(rowp + bj * 128) = pack8(acc[ai][bj][m][0], acc[ai][bj][m][1]); }
        const bool special = (u.pm >= 32) || ((u.pm & 7) == 7);
        if (special && u.pn < 18) {
#pragma unroll
            for (int ai = 0; ai < 2; ++ai)
#pragma unroll
                for (int m = 0; m < 4; ++m) {
                    const int r = row0 + ai * 128 + m * 16; const bool smp = r >= MP; const int b = smp ? (r - MP) >> 2 : r >> 11, t = smp ? (r - MP) & 3 : r & 2047;
#pragma unroll
                    for (int bj = 0; bj < 2; ++bj) { const int c = col0 + bj * 128; float* dst = nullptr;
                        if (c < DSH) { if (smp ? (t == 3) : (t == 2047)) dst = out + (smp ? O_SSHIFT : O_PSHIFT) + (size_t)b * DSH + c; }
                        else if (c >= ZC_P && c < ZC_P + 1024) { const int cc = c - ZC_P;
                            if (smp) dst = out + O_SPOOL + ((size_t)b * 15 + 11 + t) * 1024 + cc;
                            else if (t >= 2033) dst = out + O_PPOOL + ((size_t)b * 15 + (t - 2033)) * 1024 + cc; }
                        if (dst) { *(f32x4*)dst = acc[ai][bj][m][0]; *(f32x4*)(dst + 4) = acc[ai][bj][m][1]; } } }
        }
    }
};
struct EpiLR {
    static constexpr bool PERM = true;
    bf16_t* XW; const float* w0; const float* a0;
    __device__ __forceinline__ void operator()(AccRef acc, const Unit& u, int wr, int wc, int fr, int fq) const {
        const int sel = u.pn >> 2; const int row0 = u.pm * 256 + wr * 64 + fr, col0 = (u.pn & 3) * 256 + wc * 32 + 8 * fq;
        bf16_t* base = XW + (size_t)sel * ((size_t)M * 1024);
#pragma unroll
        for (int bj = 0; bj < 2; ++bj) { const int c = col0 + bj * 128; f32x4 b0 = (f32x4){0.f, 0.f, 0.f, 0.f}, b1 = b0;
            if (sel == 0) { b0 = *(const f32x4*)(w0 + c); b1 = *(const f32x4*)(w0 + c + 4); } else if (sel == 1) { b0 = *(const f32x4*)(a0 + c); b1 = *(const f32x4*)(a0 + c + 4); }
#pragma unroll
            for (int ai = 0; ai < 2; ++ai)
#pragma unroll
                for (int m = 0; m < 4; ++m) { f32x4 v0 = acc[ai][bj][m][0] + b0, v1 = acc[ai][bj][m][1] + b1;
                    if (sel == 1) {
#pragma unroll
                        for (int j = 0; j < 4; ++j) { v0[j] = sigmoidf_(v0[j]); v1[j] = sigmoidf_(v1[j]); } }
                    *(u32x4*)(base + (size_t)(row0 + ai * 128 + m * 16) * 1024 + c) = pack8(v0, v1); } }
    }
};
struct EpiPool {
    static constexpr bool PERM = true;
    bf16_t* YB; const float* scale;
    __device__ __forceinline__ void operator()(AccRef acc, const Unit& u, int wr, int wc, int fr, int fq) const {
        const int row0 = u.pm * 256 + wr * 64 + fr, col0 = u.pn * 256 + wc * 32 + 8 * fq;
#pragma unroll
        for (int bj = 0; bj < 2; ++bj) { const int c = col0 + bj * 128; const f32x4 s0 = *(const f32x4*)(scale + c), s1 = *(const f32x4*)(scale + c + 4);
#pragma unroll
            for (int ai = 0; ai < 2; ++ai)
#pragma unroll
                for (int m = 0; m < 4; ++m) *(u32x4*)(YB + (size_t)(row0 + ai * 128 + m * 16) * 1024 + c) = pack8(acc[ai][bj][m][0] * s0, acc[ai][bj][m][1] * s1); }
    }
};
struct EpiGateB {
    static constexpr bool PERM = true;
    bf16_t* MM; const bf16_t* Z;
    __device__ __forceinline__ void operator()(AccRef acc, const Unit& u, int wr, int wc, int fr, int fq) const {
        const int row0 = u.pm * 256 + wr * 64 + fr, col0 = u.pn * 256 + wc * 32 + 8 * fq;
#pragma unroll
        for (int ai = 0; ai < 2; ++ai)
#pragma unroll
            for (int bj = 0; bj < 2; ++bj) { const int c = col0 + bj * 128;
                u32x4 gz[4];
#pragma unroll
                for (int m = 0; m < 4; ++m) gz[m] = *(const u32x4*)((const char*)Z + ((unsigned)(row0 + ai * 128 + m * 16) * (unsigned)ZLD + (unsigned)(ZC_GB + c)) * 2u);
#pragma unroll
                for (int m = 0; m < 4; ++m) { const int r = row0 + ai * 128 + m * 16; f32x4 g0, g1; unpack8(gz[m], g0, g1);
#pragma unroll
                    for (int j = 0; j < 4; ++j) { g0[j] = sigmoidf_(g0[j]); g1[j] = sigmoidf_(g1[j]); }
                    *(u32x4*)(MM + (size_t)r * DM + c) = pack8(g0 * acc[ai][bj][m][0], g1 * acc[ai][bj][m][1]); } }
    }
};
struct EpiGateA {
    static constexpr bool PERM = true;
    const bf16_t* Z; bf16_t* MM;
    __device__ __forceinline__ void operator()(AccRef acc, const Unit& u, int wr, int wc, int fr, int fq) const {
        const int row0 = u.pm * 256 + wr * 64 + fr, col0 = u.pn * 256 + wc * 32 + 8 * fq;
#pragma unroll
        for (int ai = 0; ai < 2; ++ai)
#pragma unroll
            for (int bj = 0; bj < 2; ++bj) { const int c = col0 + bj * 128;
                u32x4 gz[4], pm[4];
#pragma unroll
                for (int m = 0; m < 4; ++m) { const unsigned r = (unsigned)(row0 + ai * 128 + m * 16);
                    gz[m] = *(const u32x4*)((const char*)Z + (r * (unsigned)ZLD + (unsigned)(ZC_GA + c)) * 2u);
                    pm[m] = *(const u32x4*)((const char*)MM + (r * (unsigned)DM + (unsigned)c) * 2u); }
#pragma unroll
                for (int m = 0; m < 4; ++m) { const int r = row0 + ai * 128 + m * 16; f32x4 g0, g1, p0, p1; unpack8(gz[m], g0, g1); unpack8(pm[m], p0, p1);
#pragma unroll
                    for (int j = 0; j < 4; ++j) { g0[j] = sigmoidf_(g0[j]); g1[j] = sigmoidf_(g1[j]); }
                    *(u32x4*)(MM + (size_t)r * DM + c) = pack8(p0 + g0 * acc[ai][bj][m][0], p1 + g1 * acc[ai][bj][m][1]); } }
    }
};
struct EpiOutP {
    static constexpr bool PERM = true;
    bf16_t* C; float* P;
    __device__ __forceinline__ void operator()(AccRef acc, const Unit& u, int wr, int wc, int fr, int fq) const {
        const int row0 = u.pm * 256 + wr * 64 + fr, col0 = u.pn * 256 + wc * 32 + 8 * fq;
#pragma unroll
        for (int ai = 0; ai < 2; ++ai)
#pragma unroll
            for (int m = 0; m < 4; ++m) { const int r = row0 + ai * 128 + m * 16;
#pragma unroll
                for (int bj = 0; bj < 2; ++bj) { const int c = col0 + bj * 128;
                    if (u.sp < 0) *(u32x4*)(C + (size_t)r * DM + c) = pack8(acc[ai][bj][m][0], acc[ai][bj][m][1]);
                    else { float* pp = P + ((size_t)u.sp * 512 + (r - MP)) * DM + c; *(f32x4*)pp = acc[ai][bj][m][0]; *(f32x4*)(pp + 4) = acc[ai][bj][m][1]; } } }
    }
};
struct EpiGate7 {
    static constexpr bool PERM = true;
    bf16_t* G; float* out;
    __device__ __forceinline__ void operator()(AccRef acc, const Unit& u, int wr, int wc, int fr, int fq) const {
        const int row0 = u.pm * 256 + wr * 64 + fr, col0 = u.pn * 256 + wc * 32 + 8 * fq;
#pragma unroll
        for (int ai = 0; ai < 2; ++ai)
#pragma unroll
            for (int m = 0; m < 4; ++m) { bf16_t* rowp = G + (size_t)(row0 + ai * 128 + m * 16) * DFF + col0;
#pragma unroll
                for (int bj = 0; bj < 2; ++bj) *(u32x4*)(rowp + bj * 128) = pack8(acc[ai][bj][m][0], acc[ai][bj][m][1]); }
        const bool special = (u.pm >= 32) || ((u.pm & 7) == 7);
        if (special) {
#pragma unroll
            for (int ai = 0; ai < 2; ++ai)
#pragma unroll
                for (int m = 0; m < 4; ++m) {
                    const int r = row0 + ai * 128 + m * 16; const bool smp = r >= MP; const int b = smp ? (r - MP) >> 2 : r >> 11, t = smp ? (r - MP) & 3 : r & 2047;
                    const int j = smp ? t - 2 : t - 2046;
                    if (j >= 0) {
#pragma unroll
                        for (int bj = 0; bj < 2; ++bj) { float* dst = out + (smp ? O_SCONV : O_PCONV) + ((size_t)b * 2 + j) * DFF + col0 + bj * 128;
                            *(f32x4*)dst = acc[ai][bj][m][0]; *(f32x4*)(dst + 4) = acc[ai][bj][m][1]; } } }
        }
    }
};
struct EpiAct {
    static constexpr bool PERM = true;
    const bf16_t* G; bf16_t* ACT; const float* cw; const float* cb; const float* conv0;
    __device__ __forceinline__ void operator()(AccRef acc, const Unit& u, int wr, int wc, int fr, int fq) const {
        const int row0 = u.pm * 256 + wr * 64 + fr, col0 = u.pn * 256 + wc * 32 + 8 * fq;
        const bool smp_tile = u.pm >= 32;
#pragma unroll
        for (int bj = 0; bj < 2; ++bj) { const int c = col0 + bj * 128;
            const f32x4 w0a = *(const f32x4*)(cw + c), w0b = *(const f32x4*)(cw + c + 4), w1a = *(const f32x4*)(cw + DFF + c), w1b = *(const f32x4*)(cw + DFF + c + 4);
            const f32x4 w2a = *(const f32x4*)(cw + 2 * DFF + c), w2b = *(const f32x4*)(cw + 2 * DFF + c + 4), cba = *(const f32x4*)(cb + c), cbb = *(const f32x4*)(cb + c + 4);
#pragma unroll
            for (int ai = 0; ai < 2; ++ai) {
                u32x4 q2[4], q1[4], q0[4];
#pragma unroll
                for (int m = 0; m < 4; ++m) { const unsigned off = (unsigned)((row0 + ai * 128 + m * 16) * DFF + c) * 2u;
                    q2[m] = *(const u32x4*)((const char*)G + off);
                    u32x4 e1 = (u32x4){0u, 0u, 0u, 0u}, e0 = e1;
                    if (fr < 1) e1 = *(const u32x4*)((const char*)(G - DFF) + off);
                    if (fr < 2) e0 = *(const u32x4*)((const char*)(G - 2 * DFF) + off);
                    q1[m] = e1; q0[m] = e0; }
#pragma unroll
                for (int m = 0; m < 4; ++m) {
#pragma unroll
                    for (int wd = 0; wd < 4; ++wd) { q1[m][wd] = __builtin_amdgcn_update_dpp(q1[m][wd], q2[m][wd], 0x111, 0xF, 0xF, false);
                                                     q0[m][wd] = __builtin_amdgcn_update_dpp(q0[m][wd], q2[m][wd], 0x112, 0xF, 0xF, false); } }
#pragma unroll
                for (int m = 0; m < 4; ++m) {
                    const int r = row0 + ai * 128 + m * 16; const bool smp = r >= MP; const int b = smp ? (r - MP) >> 2 : r >> 11, t = smp ? (r - MP) & 3 : r & 2047;
                    f32x4 x2a, x2b, x1a, x1b, x0a, x0b;
                    unpack8(q2[m], x2a, x2b); unpack8(q1[m], x1a, x1b); unpack8(q0[m], x0a, x0b);
                    if (t < 1) { x1a = (f32x4){0.f, 0.f, 0.f, 0.f}; x1b = x1a; }
                    if (t < 2) { x0a = (f32x4){0.f, 0.f, 0.f, 0.f}; x0b = x0a; }
                    if (smp_tile) {
                        if (t < 1) { x1a = *(const f32x4*)(conv0 + ((size_t)b * 2 + 1) * DFF + c); x1b = *(const f32x4*)(conv0 + ((size_t)b * 2 + 1) * DFF + c + 4); }
                        if (t < 2) { x0a = *(const f32x4*)(conv0 + ((size_t)b * 2 + t) * DFF + c); x0b = *(const f32x4*)(conv0 + ((size_t)b * 2 + t) * DFF + c + 4); }
                    }
                    f32x4 ca = cba + w0a * x0a + w1a * x1a + w2a * x2a, cbv = cbb + w0b * x0b + w1b * x1b + w2b * x2b;
#pragma unroll
                    for (int j = 0; j < 4; ++j) { ca[j] = gelu_tanh(ca[j]); cbv[j] = gelu_tanh(cbv[j]); }
                    *(u32x4*)(ACT + (size_t)r * DFF + c) = pack8(ca * acc[ai][bj][m][0], cbv * acc[ai][bj][m][1]); }
            }
        }
    }
};

constexpr int TP = 136;
template <class Map>
__device__ __forceinline__ void transpose_job(const float* src, int ldsrc, int Ksrc, bf16_t* dst, int Kd, int Nd, Map map, float* tilef, int bid, int nblk) {
    int tid = threadIdx.x; asm volatile("" : "+v"(tid));
    LAS unsigned char* tile = (LAS unsigned char*)tilef;
    const int ntk = Kd / 128, ntn = Nd / 128, ntot = ntk * ntn;
    const int n4 = tid & 31, kp0 = tid >> 5;
    const int rn = tid >> 2, rq = tid & 3;
    f32x4 va[4], vb[4];
    auto load = [&](int ti) {
        const int tn = ti / ntk, tk = ti - tn * ntk; const int sc = map(tn * 128 + n4 * 4);
#pragma unroll
        for (int i = 0; i < 4; ++i) { const int k = tk * 128 + 2 * (kp0 + 16 * i);
            va[i] = (sc >= 0 && k < Ksrc) ? *(const f32x4*)(src + (size_t)k * ldsrc + sc) : (f32x4){0.f, 0.f, 0.f, 0.f};
            vb[i] = (sc >= 0 && k + 1 < Ksrc) ? *(const f32x4*)(src + (size_t)(k + 1) * ldsrc + sc) : (f32x4){0.f, 0.f, 0.f, 0.f}; }
    };
    int ti = bid;
    if (ti < ntot) load(ti);
    for (; ti < ntot; ti += nblk) {
        const int tn = ti / ntk, tk = ti - tn * ntk;
#pragma unroll
        for (int i = 0; i < 4; ++i) { const int kp = kp0 + 16 * i;
#pragma unroll
            for (int j = 0; j < 4; ++j) *(LAS unsigned*)(tile + ((n4 * 4 + j) * TP + 2 * kp) * 2) = cvt_pk_bf16(va[i][j], vb[i][j]); }
        __syncthreads();
        if (ti + nblk < ntot) load(ti + nblk);
        bf16_t* drow = dst + (size_t)(tn * 128 + rn) * Kd + tk * 128 + rq * 32;
#pragma unroll
        for (int i = 0; i < 4; ++i) *(u32x4*)(drow + i * 8) = *(const LAS u32x4*)(tile + (rn * TP + rq * 32 + i * 8) * 2);
        __syncthreads();
    }
}
struct MapId { __device__ int operator()(int n) const { return n; } };
struct MapWin { __device__ int operator()(int n) const { return n < DSH ? n : (n < ZC_P ? -1 : n - (ZC_P - DSH)); } };

__device__ __forceinline__ float z_shift(KArgP p, const bf16_t* Z, int r, int zc) {
    const float z = bf2f(Z[(size_t)r * ZLD + zc]);
    const bool smp = r >= MP; const int t = smp ? (r - MP) & 3 : r & 2047;
    float pv;
    if (t > 0) pv = bf2f(Z[(size_t)(r - 1) * ZLD + zc]); else pv = smp ? p->in[2][(size_t)((r - MP) >> 2) * DSH + zc] : 0.f;
    return z + (pv - z) * p->in[8][zc];
}

struct HeadConst { float mu_r, mu_k, mu_v, k_k, k_a, r_k; };
__device__ __forceinline__ void stage_token(float zr, float zk, float zv, float pr, float pk, float pv, float xw, float a, float g, const HeadConst& hc, float* o, float* bon, int lane) {
    const float r = zr + (pr - zr) * hc.mu_r, k = zk + (pk - zk) * hc.mu_k, v = zv + (pv - zv) * hc.mu_v;
    const float y = -xw;
    const float sp = fmaxf(y, 0.f) + __logf(1.0f + __expf(-fabsf(y)));
    const float dec = __expf(-__expf(-sp - 0.5f));
    const float kr = k * hc.k_k; const float n2 = wave_sum(kr * kr); const float kk = kr * rsqrtf(fmaxf(n2, 1e-24f));
    const float kp = k * (1.0f + (a - 1.0f) * hc.k_a);
    const float bs = wave_sum(r * kp * hc.r_k);
    o[0 * 64 + lane] = dec; o[1 * 64 + lane] = kk; o[2 * 64 + lane] = kk * a; o[3 * 64 + lane] = kp; o[4 * 64 + lane] = r; o[5 * 64 + lane] = v; o[6 * 64 + lane] = g;
    if (lane == 0) *bon = bs;
}

constexpr int ST = 72;
constexpr int L_AT = 0, L_BT = 9216, L_KT = 18432, L_RT = 27648, L_ATT = 36864, L_VMT = 46080, L_BGT = 55296, L_KGT = 64512,
              L_LOFF = 73728, L_LAK = 82944, L_MRB = 92160, L_MRK = 101376, L_LDIAG = 110592, L_CUM = 114688;
constexpr int L_TBD = L_CUM, L_SOLT = L_BT;
constexpr size_t SC_PF = 0, SC_QF = (size_t)2048 * 8192, SC_W2F = (size_t)2 * 2048 * 8192, SC_YLF = (size_t)3 * 2048 * 8192, SC_GAM = (size_t)4 * 2048 * 8192, SC_BON = SC_GAM + (size_t)2048 * 256;

__device__ __forceinline__ bf16x8 frag(LAS unsigned char* lds, int off, int row0, int ks, int lane) {
    return *(const LAS bf16x8*)(lds + off + ((row0 + (lane & 15)) * ST + ks * 32 + (lane >> 4) * 8) * 2);
}
__device__ __forceinline__ void st4(LAS unsigned char* lds, int off, int row, int col, f32x4 v) {
    u32x2 w; w.x = cvt_pk_bf16(v[0], v[1]); w.y = cvt_pk_bf16(v[2], v[3]); *(LAS u32x2*)(lds + off + (row * ST + col) * 2) = w;
}
__device__ __forceinline__ f32x4 ld4(LAS unsigned char* lds, int off, int row, int col) {
    const u32x2 w = *(const LAS u32x2*)(lds + off + (row * ST + col) * 2); return (f32x4){lo_bf(w.x), hi_bf(w.x), lo_bf(w.y), hi_bf(w.y)};
}
#define MFMA16(x, y, acc) __builtin_amdgcn_mfma_f32_16x16x32_bf16((x), (y), (acc), 0, 0, 0)
#define LDS_FENCE() asm volatile("s_waitcnt lgkmcnt(0)" ::: "memory")

__device__ __forceinline__ void wkv_pass_a(KArgP p, int cu, LAS unsigned char* lds) {
    int tid = threadIdx.x; asm volatile("" : "+v"(tid));
    const int w = __builtin_amdgcn_readfirstlane(tid >> 6), lane = tid & 63, q = lane >> 4, l15 = lane & 15;
    const int bh = cu >> 5, c = cu & 31, b = bh >> 4, h = bh & 15, ch = h * 64 + lane;
    const bf16_t* Z = (const bf16_t*)(p->ws + W_Z); const bf16_t* XW = (const bf16_t*)(p->ws + W_XW); const bf16_t* XA = (const bf16_t*)(p->ws + W_XA);
    unsigned char* sc = p->ws + W_RA;
    const int row0 = b * 2048 + c * 64 + w * 8;
    float kk[8], bb[8], kp[8], rr[8], vv[8], ld[8];
    {
        const float mu_r = p->in[8][ch], mu_k = p->in[8][1024 + ch], mu_v = p->in[8][2048 + ch], k_k = p->in[14][ch], k_a = p->in[15][ch], r_k = p->in[16][ch];
        float pz[3];
        const bool first = (c == 0 && w == 0);
#pragma unroll
        for (int qq = 0; qq < 3; ++qq) pz[qq] = first ? 0.f : bf2f(Z[(size_t)(row0 - 1) * ZLD + qq * 1024 + ch]);
        float bon[8];
#pragma unroll
        for (int i = 0; i < 8; ++i) {
            float z[3];
#pragma unroll
            for (int qq = 0; qq < 3; ++qq) z[qq] = bf2f(Z[(size_t)(row0 + i) * ZLD + qq * 1024 + ch]);
            const float xw = bf2f(XW[(size_t)(row0 + i) * 1024 + ch]), a = bf2f(XA[(size_t)(row0 + i) * 1024 + ch]);
            const float r = z[0] + (pz[0] - z[0]) * mu_r, k = z[1] + (pz[1] - z[1]) * mu_k, v = z[2] + (pz[2] - z[2]) * mu_v;
#pragma unroll
            for (int qq = 0; qq < 3; ++qq) pz[qq] = z[qq];
            const float y = -xw; const float sp = fmaxf(y, 0.f) + __logf(1.0f + __expf(-fabsf(y)));
            ld[i] = -__expf(-sp - 0.5f);
            const float kr = k * k_k; const float n2 = wave_sum(kr * kr); kk[i] = kr * rsqrtf(fmaxf(n2, 1e-24f));
            kp[i] = k * (1.0f + (a - 1.0f) * k_a); bb[i] = kk[i] * a; rr[i] = r; vv[i] = v;
            bon[i] = wave_sum(r * kp[i] * r_k);
            *(LAS float*)(lds + L_CUM + ((w * 8 + i) * 64 + lane) * 4) = ld[i];
        }
        if (lane < 8) { float bv = bon[0];
#pragma unroll
            for (int i = 1; i < 8; ++i) bv = (lane == i) ? bon[i] : bv;
            *(float*)(sc + SC_BON + (size_t)cu * 256 + (w * 8 + lane) * 4) = bv; }
    }
    __syncthreads();
    float cum[8], cumC;
    {
        float acc = 0.f;
#pragma unroll
        for (int seg = 0; seg < 8; ++seg) {
#pragma unroll
            for (int i = 0; i < 8; ++i) { acc += *(const LAS float*)(lds + L_CUM + ((seg * 8 + i) * 64 + lane) * 4); if (seg == w) cum[i] = acc; }
        }
        cumC = acc;
    }
    if (w == 0) *(float*)(sc + SC_GAM + (size_t)cu * 256 + lane * 4) = __expf(cumC);
    {
        float att[8], bgt[8], kgt[8];
#pragma unroll
        for (int i = 0; i < 8; ++i) {
            const int t = w * 8 + i; const float ep = __expf(cum[i]), em = __expf(-cum[i]), eg = __expf(cumC - cum[i]);
            att[i] = -kk[i] * __expf(cum[i] - ld[i]); bgt[i] = bb[i] * eg; kgt[i] = kp[i] * eg;
            *(LAS bf16_t*)(lds + L_AT + (t * ST + lane) * 2) = f2bf(att[i]);
            *(LAS bf16_t*)(lds + L_RT + (t * ST + lane) * 2) = f2bf(rr[i] * ep);
            *(LAS bf16_t*)(lds + L_BT + (t * ST + lane) * 2) = f2bf(bb[i] * em);
            *(LAS bf16_t*)(lds + L_KT + (t * ST + lane) * 2) = f2bf(kp[i] * em);
        }
        u32x4 x;
        x.x = cvt_pk_bf16(att[0], att[1]); x.y = cvt_pk_bf16(att[2], att[3]); x.z = cvt_pk_bf16(att[4], att[5]); x.w = cvt_pk_bf16(att[6], att[7]); *(LAS u32x4*)(lds + L_ATT + (lane * ST + w * 8) * 2) = x;
        x.x = cvt_pk_bf16(vv[0], vv[1]); x.y = cvt_pk_bf16(vv[2], vv[3]); x.z = cvt_pk_bf16(vv[4], vv[5]); x.w = cvt_pk_bf16(vv[6], vv[7]); *(LAS u32x4*)(lds + L_VMT + (lane * ST + w * 8) * 2) = x;
        x.x = cvt_pk_bf16(bgt[0], bgt[1]); x.y = cvt_pk_bf16(bgt[2], bgt[3]); x.z = cvt_pk_bf16(bgt[4], bgt[5]); x.w = cvt_pk_bf16(bgt[6], bgt[7]); *(LAS u32x4*)(lds + L_BGT + (lane * ST + w * 8) * 2) = x;
        x.x = cvt_pk_bf16(kgt[0], kgt[1]); x.y = cvt_pk_bf16(kgt[2], kgt[3]); x.z = cvt_pk_bf16(kgt[4], kgt[5]); x.w = cvt_pk_bf16(kgt[6], kgt[7]); *(LAS u32x4*)(lds + L_KGT + (lane * ST + w * 8) * 2) = x;
    }
    __syncthreads();
    for (int i = tid; i < 9216 / 16; i += NTHR) *(LAS u32x4*)(lds + L_TBD + i * 16) = (u32x4){0u, 0u, 0u, 0u};
    {
        const int jt = w & 3, isR = w >> 2; const int yoff = isR ? L_RT : L_AT;
        const bf16x8 y0 = frag(lds, yoff, 16 * jt, 0, lane), y1 = frag(lds, yoff, 16 * jt, 1, lane);
        const int t = 16 * jt + l15;
#pragma unroll
        for (int xt = 0; xt < 8; ++xt) {
            const int isK = xt >> 2, it = xt & 3; const int xoff = isK ? L_KT : L_BT;
            f32x4 acc = (f32x4){0.f, 0.f, 0.f, 0.f};
            if (it <= jt) { acc = MFMA16(frag(lds, xoff, 16 * it, 0, lane), y0, acc); acc = MFMA16(frag(lds, xoff, 16 * it, 1, lane), y1, acc); }
#pragma unroll
            for (int i = 0; i < 4; ++i) { const int s = 16 * it + 4 * q + i; const bool keep = isR ? (s <= t) : (s < t); acc[i] = keep ? acc[i] : 0.f; }
            const int dst = isR ? (isK ? L_MRK : L_MRB) : (isK ? L_LAK : L_LOFF);
            if (!isR && !isK && it == jt) { *(LAS f32x4*)(lds + L_LDIAG + ((jt * 16 + l15) * 16 + 4 * q) * 4) = acc; acc = (f32x4){0.f, 0.f, 0.f, 0.f}; }
            st4(lds, dst, t, 16 * it + 4 * q, acc);
        }
    }
    __syncthreads();
    f32x4 xacc[4];
#pragma unroll
    for (int i = 0; i < 4; ++i) xacc[i] = (f32x4){0.f, 0.f, 0.f, 0.f};
    if (w == 0) {
        const int blk = q, j = l15; float tc[16];
#pragma unroll
        for (int t = 0; t < 16; ++t) {
            float acc = (t == j) ? 1.0f : 0.0f;
            f32x4 lr[4];
#pragma unroll
            for (int g = 0; g < 4; ++g) lr[g] = *(const LAS f32x4*)(lds + L_LDIAG + ((blk * 16 + t) * 16 + g * 4) * 4);
#pragma unroll
            for (int s = 0; s < t; ++s) acc += lr[s >> 2][s & 3] * tc[s];
            tc[t] = acc;
            *(LAS bf16_t*)(lds + L_TBD + ((16 * blk + t) * ST + 16 * blk + j) * 2) = f2bf(acc);
        }
    } else if (w >= 4) {
        const int vt = w - 4;
#pragma unroll
        for (int i = 0; i < 4; ++i)
#pragma unroll
            for (int ks = 0; ks < 2; ++ks) xacc[i] = MFMA16(frag(lds, L_LAK, 16 * i, ks, lane), frag(lds, L_VMT, 16 * vt, ks, lane), xacc[i]);
    }
    __syncthreads();
    {
        const int crow = 16 * w + l15;
#pragma unroll
        for (int i = 0; i < 4; ++i) {
            f32x4 acc = (w < 4) ? ld4(lds, L_ATT, crow, 16 * i + 4 * q) : xacc[i];
#pragma unroll
            for (int ks = 0; ks < 2; ++ks) acc = MFMA16(frag(lds, L_LOFF, 16 * i, ks, lane), frag(lds, L_SOLT, 16 * w, ks, lane), acc);
            st4(lds, L_SOLT, crow, 16 * i + 4 * q, acc);
            LDS_FENCE();
            f32x4 acc2 = (f32x4){0.f, 0.f, 0.f, 0.f};
#pragma unroll
            for (int ks = 0; ks < 2; ++ks) acc2 = MFMA16(frag(lds, L_TBD, 16 * i, ks, lane), frag(lds, L_SOLT, 16 * w, ks, lane), acc2);
            st4(lds, L_SOLT, crow, 16 * i + 4 * q, acc2);
            LDS_FENCE();
        }
    }
    __syncthreads();
    {
        const int a = w >> 1, pr = w & 1;
        { f32x4 acc[2];
#pragma unroll
            for (int u = 0; u < 2; ++u) { const int kt = 2 * pr + u; acc[u] = ld4(lds, L_RT, 16 * a + l15, 16 * kt + 4 * q);
#pragma unroll
                for (int ks = 0; ks < 2; ++ks) acc[u] = MFMA16(frag(lds, L_SOLT, 16 * kt, ks, lane), frag(lds, L_MRB, 16 * a, ks, lane), acc[u]); }
            *(u32x4*)(sc + SC_W2F + (size_t)cu * 8192 + ((a * 2 + pr) * 64 + lane) * 16) = pack8(acc[0], acc[1]); }
#pragma unroll
        for (int u = 0; u < 2; ++u) { const int vt = 2 * pr + u; f32x4 acc = (f32x4){0.f, 0.f, 0.f, 0.f};
#pragma unroll
            for (int ks = 0; ks < 2; ++ks) { acc = MFMA16(frag(lds, L_SOLT, 64 + 16 * vt, ks, lane), frag(lds, L_MRB, 16 * a, ks, lane), acc); acc = MFMA16(frag(lds, L_VMT, 16 * vt, ks, lane), frag(lds, L_MRK, 16 * a, ks, lane), acc); }
            u32x2 o; o.x = cvt_pk_bf16(acc[0], acc[1]); o.y = cvt_pk_bf16(acc[2], acc[3]);
            *(u32x2*)(sc + SC_YLF + (size_t)cu * 8192 + ((vt * 4 + a) * 64 + lane) * 8) = o; }
        { f32x4 acc[2];
#pragma unroll
            for (int u = 0; u < 2; ++u) { const int kt = 2 * pr + u; acc[u] = (f32x4){0.f, 0.f, 0.f, 0.f};
#pragma unroll
                for (int ks = 0; ks < 2; ++ks) acc[u] = MFMA16(frag(lds, L_SOLT, 16 * kt, ks, lane), frag(lds, L_BGT, 16 * a, ks, lane), acc[u]); }
            *(u32x4*)(sc + SC_PF + (size_t)cu * 8192 + ((a * 2 + pr) * 64 + lane) * 16) = pack8(acc[0], acc[1]); }
#pragma unroll
        for (int u = 0; u < 2; ++u) { const int vt = 2 * pr + u; f32x4 acc = (f32x4){0.f, 0.f, 0.f, 0.f};
#pragma unroll
            for (int ks = 0; ks < 2; ++ks) { acc = MFMA16(frag(lds, L_BGT, 16 * a, ks, lane), frag(lds, L_SOLT, 64 + 16 * vt, ks, lane), acc); acc = MFMA16(frag(lds, L_KGT, 16 * a, ks, lane), frag(lds, L_VMT, 16 * vt, ks, lane), acc); }
            u32x2 o; o.x = cvt_pk_bf16(acc[0], acc[1]); o.y = cvt_pk_bf16(acc[2], acc[3]);
            *(u32x2*)(sc + SC_QF + (size_t)cu * 8192 + ((a * 4 + vt) * 64 + lane) * 8) = o; }
    }
    __syncthreads();
}

__device__ __forceinline__ void wkv_pass_b(KArgP p, int task, int lane) {
    const int bh = task >> 2, vs = task & 3, q = lane >> 4, l15 = lane & 15;
    const unsigned char* sc = p->ws + W_RA; unsigned char* sf = p->ws + W_SF;
    f32x4 S[4];
#pragma unroll
    for (int m = 0; m < 4; ++m) S[m] = (f32x4){0.f, 0.f, 0.f, 0.f};
    for (int c = 0; c < 32; ++c) {
        const int cu = bh * 32 + c;
        u32x4 pf[4][2]; u32x2 qf[4]; f32x4 gm[4];
#pragma unroll
        for (int m = 0; m < 4; ++m) {
#pragma unroll
            for (int ks = 0; ks < 2; ++ks) pf[m][ks] = *(const u32x4*)(sc + SC_PF + (size_t)cu * 8192 + ((m * 2 + ks) * 64 + lane) * 16);
            qf[m] = *(const u32x2*)(sc + SC_QF + (size_t)cu * 8192 + ((m * 4 + vs) * 64 + lane) * 8);
            gm[m] = *(const f32x4*)(sc + SC_GAM + (size_t)cu * 256 + (16 * m + 4 * q) * 4);
        }
        u32x4 sfr[2];
#pragma unroll
        for (int ks = 0; ks < 2; ++ks) { sfr[ks] = pack8(S[2 * ks], S[2 * ks + 1]); *(u32x4*)(sf + (size_t)cu * 8192 + ((vs * 2 + ks) * 64 + lane) * 16) = sfr[ks]; }
#pragma unroll
        for (int m = 0; m < 4; ++m) {
            f32x4 acc = S[m] * gm[m] + (f32x4){lo_bf(qf[m].x), hi_bf(qf[m].x), lo_bf(qf[m].y), hi_bf(qf[m].y)};
#pragma unroll
            for (int ks = 0; ks < 2; ++ks) { bf16x8 av, bv; __builtin_memcpy(&av, &pf[m][ks], 16); __builtin_memcpy(&bv, &sfr[ks], 16); acc = MFMA16(av, bv, acc); }
            S[m] = acc;
        }
    }
#pragma unroll
    for (int m = 0; m < 4; ++m) *(f32x4*)(p->out + O_PWKV + ((size_t)bh * 64 + 16 * vs + l15) * 64 + 16 * m + 4 * q) = S[m];
}

__device__ __forceinline__ void wkv_pass_c(KArgP p, int cu, int jt, int lane) {
    const int bh = cu >> 5, c = cu & 31, b = bh >> 4, h = bh & 15, q = lane >> 4, l15 = lane & 15;
    const unsigned char* sc = p->ws + W_RA; const unsigned char* sf = p->ws + W_SF;
    const bf16_t* Z = (const bf16_t*)(p->ws + W_Z); const bf16_t* GG = (const bf16_t*)(p->ws + W_GG); bf16_t* YA = (bf16_t*)(p->ws + W_DYA);
    const int t = c * 64 + 16 * jt + l15; const int row = b * 2048 + t;
    bf16x8 w2[2], sfr[4][2]; u32x2 yl[4], zc[4], zp[4], gz[4];
#pragma unroll
    for (int ks = 0; ks < 2; ++ks) w2[ks] = *(const bf16x8*)(sc + SC_W2F + (size_t)cu * 8192 + ((jt * 2 + ks) * 64 + lane) * 16);
#pragma unroll
    for (int vt = 0; vt < 4; ++vt) { const int chv = h * 64 + 16 * vt + 4 * q;
        yl[vt] = *(const u32x2*)(sc + SC_YLF + (size_t)cu * 8192 + ((vt * 4 + jt) * 64 + lane) * 8);
#pragma unroll
        for (int ks = 0; ks < 2; ++ks) sfr[vt][ks] = *(const bf16x8*)(sf + (size_t)cu * 8192 + ((vt * 2 + ks) * 64 + lane) * 16);
        zc[vt] = *(const u32x2*)(Z + (size_t)row * ZLD + 2048 + chv);
        zp[vt] = (t > 0) ? *(const u32x2*)(Z + (size_t)(row - 1) * ZLD + 2048 + chv) : (u32x2){0u, 0u};
        gz[vt] = *(const u32x2*)(GG + (size_t)row * 1024 + chv); }
    const float bon = *(const float*)(sc + SC_BON + (size_t)cu * 256 + (16 * jt + l15) * 4);
    f32x4 y[4]; float s1 = 0.f;
#pragma unroll
    for (int vt = 0; vt < 4; ++vt) {
        f32x4 acc = (f32x4){lo_bf(yl[vt].x), hi_bf(yl[vt].x), lo_bf(yl[vt].y), hi_bf(yl[vt].y)};
#pragma unroll
        for (int ks = 0; ks < 2; ++ks) acc = MFMA16(sfr[vt][ks], w2[ks], acc);
        y[vt] = acc; s1 += (acc[0] + acc[1]) + (acc[2] + acc[3]);
    }
    s1 = xor32_sum(xor16_sum(s1)); const float mu = s1 * (1.0f / 64.0f);
    float s2 = 0.f;
#pragma unroll
    for (int vt = 0; vt < 4; ++vt) { y[vt] -= mu; s2 += (y[vt][0] * y[vt][0] + y[vt][1] * y[vt][1]) + (y[vt][2] * y[vt][2] + y[vt][3] * y[vt][3]); }
    s2 = xor32_sum(xor16_sum(s2)); const float rstd = rsqrtf(s2 * (1.0f / 64.0f) + GN_EPS);
#pragma unroll
    for (int vt = 0; vt < 4; ++vt) {
        const int chv = h * 64 + 16 * vt + 4 * q;
        const f32x4 zv = (f32x4){lo_bf(zc[vt].x), hi_bf(zc[vt].x), lo_bf(zc[vt].y), hi_bf(zc[vt].y)}, pv = (f32x4){lo_bf(zp[vt].x), hi_bf(zp[vt].x), lo_bf(zp[vt].y), hi_bf(zp[vt].y)};
        const f32x4 muv = *(const f32x4*)(p->in[8] + 2048 + chv); const f32x4 vm = zv + (pv - zv) * muv;
        const f32x4 g = (f32x4){lo_bf(gz[vt].x), hi_bf(gz[vt].x), lo_bf(gz[vt].y), hi_bf(gz[vt].y)};
        const f32x4 lw = *(const f32x4*)(p->in[17] + chv), lb = *(const f32x4*)(p->in[18] + chv);
        const f32x4 o = ((y[vt] * rstd) * lw + lb + bon * vm) * g;
        u32x2 ow; ow.x = cvt_pk_bf16(o[0], o[1]); ow.y = cvt_pk_bf16(o[2], o[3]);
        *(u32x2*)(YA + (size_t)row * 1024 + chv) = ow;
    }
}

__device__ __forceinline__ void scan_sample(KArgP p, int unit, float* lds) {
    int tid = threadIdx.x; asm volatile("" : "+v"(tid));
    const int wave = tid >> 6, lane = tid & 63, b = unit >> 4, h = unit & 15, ch = h * 64 + lane;
    const bf16_t* Z = (const bf16_t*)(p->ws + W_Z); const bf16_t* XW = (const bf16_t*)(p->ws + W_XW); const bf16_t* XA = (const bf16_t*)(p->ws + W_XA); const bf16_t* GG = (const bf16_t*)(p->ws + W_GG);
    bf16_t* YA = (bf16_t*)(p->ws + W_DYA);
    float* ops = lds + wave * (4 * 7 * 64 + 64);
    float* bon = ops + 4 * 7 * 64;
    HeadConst hc; hc.mu_r = p->in[8][ch]; hc.mu_k = p->in[8][1024 + ch]; hc.mu_v = p->in[8][2048 + ch]; hc.k_k = p->in[14][ch]; hc.k_a = p->in[15][ch]; hc.r_k = p->in[16][ch];
    const float lw = p->in[17][ch], lb = p->in[18][ch];
    const int rbase = MP + b * 4;
    float pz[3];
#pragma unroll
    for (int q = 0; q < 3; ++q) pz[q] = p->in[2][(size_t)b * DSH + q * 1024 + ch];
#pragma unroll
    for (int t = 0; t < 4; ++t) {
        float z[3];
#pragma unroll
        for (int q = 0; q < 3; ++q) z[q] = bf2f(Z[(size_t)(rbase + t) * ZLD + q * 1024 + ch]);
        const size_t ro = (size_t)(rbase + t) * 1024 + ch;
        stage_token(z[0], z[1], z[2], pz[0], pz[1], pz[2], bf2f(XW[ro]), bf2f(XA[ro]), bf2f(GG[ro]), hc, ops + t * 7 * 64, bon + t, lane);
#pragma unroll
        for (int q = 0; q < 3; ++q) pz[q] = z[q];
    }
    f32x4 S[16];
    const float* s0 = p->in[3] + ((size_t)unit * 64 + lane) * 64;
#pragma unroll
    for (int j = 0; j < 16; ++j) S[j] = *(const f32x4*)(s0 + j * 4);
    __syncthreads();
#pragma nounroll
    for (int t = 0; t < 4; ++t) {
        const float* o = ops + t * 7 * 64;
        f32x4 a4 = (f32x4){0.f, 0.f, 0.f, 0.f};
#pragma unroll
        for (int j = 0; j < 16; ++j) { a4 += S[j] * *(const f32x4*)(o + 64 + j * 4); if ((j & 3) == 3) asm volatile("" ::: "memory"); }
        const float sa = -((a4[0] + a4[1]) + (a4[2] + a4[3]));
        const float vv = o[320 + lane];
        f32x4 y4 = (f32x4){0.f, 0.f, 0.f, 0.f};
#pragma unroll
        for (int j = 0; j < 16; ++j) { S[j] = S[j] * *(const f32x4*)(o + j * 4) + (sa * *(const f32x4*)(o + 128 + j * 4) + vv * *(const f32x4*)(o + 192 + j * 4)); y4 += S[j] * *(const f32x4*)(o + 256 + j * 4); if ((j & 1) == 1) asm volatile("" ::: "memory"); }
        const float y = (y4[0] + y4[1]) + (y4[2] + y4[3]);
        const float mu = wave_sum(y) * (1.0f / 64.0f); const float d = y - mu; const float var = wave_sum(d * d) * (1.0f / 64.0f);
        const float yn = d * rsqrtf(var + GN_EPS) * lw + lb;
        YA[(size_t)(rbase + t) * 1024 + ch] = f2bf((yn + bon[t] * vv) * o[384 + lane]);
    }
    float* so = p->out + O_SWKV + ((size_t)unit * 64 + lane) * 64;
#pragma unroll
    for (int j = 0; j < 16; ++j) *(f32x4*)(so + j * 4) = S[j];
    __syncthreads();
}

__device__ __forceinline__ void row_load_bf(f32x4 (&o)[8], const bf16_t* C, int row, int lane) {
#pragma unroll
    for (int i = 0; i < 8; ++i) { const u32x2 w = *(const u32x2*)(C + (size_t)row * DM + i * 256 + lane * 4); o[i] = (f32x4){lo_bf(w.x), hi_bf(w.x), lo_bf(w.y), hi_bf(w.y)}; }
}
template <int S>
__device__ __forceinline__ f32x4 part_sum(const float* P, int srow, int c) {
    f32x4 a = *(const f32x4*)(P + (size_t)srow * DM + c);
#pragma unroll
    for (int sp = 1; sp < S; ++sp) a += *(const f32x4*)(P + ((size_t)sp * 512 + srow) * DM + c);
    return a;
}
__device__ __forceinline__ float sumsq8(const f32x4 (&v)[8]) { float s = 0.f;
#pragma unroll
    for (int i = 0; i < 8; ++i) s += (v[i][0] * v[i][0] + v[i][1] * v[i][1]) + (v[i][2] * v[i][2] + v[i][3] * v[i][3]);
    return s; }

__global__ void __launch_bounds__(NTHR, 2) fwd_megakernel(Params p_unused) {
    extern __shared__ __attribute__((aligned(16))) unsigned char lds_raw[];
    cg::grid_group grid = cg::this_grid();
    LAS unsigned char* lds = (LAS unsigned char*)lds_raw;
    float* ldsf = (float*)lds_raw;
    const int bid = blockIdx.x, nblk = gridDim.x;
    __shared__ uint4 xb_words;
    if (threadIdx.x == 0) xb_words = make_uint4(0u, 0u, 0u, 0u);
    __syncthreads();
    if (kargs()->ws == nullptr) grid.sync();
    const XcdBarrier xbar = xcd_barrier_post((unsigned*)(kargs()->ws + W_BAR), (volatile LAS unsigned*)&xb_words);
#define PHASE_BEGIN() KArgP p = kargs(); int tid = threadIdx.x; asm volatile("" : "+v"(tid)); const int wave = tid >> 6, lane = tid & 63; (void)wave; (void)lane; \
    unsigned char* ws = p->ws; bf16_t* Z = (bf16_t*)(ws + W_Z); float* ssq = (float*)(ws + W_SSQ); float* Y = p->out + O_Y; (void)Z; (void)ssq; (void)Y;

    {
        PHASE_BEGIN();
    transpose_job(p->in[7], 8480, 2048, (bf16_t*)(ws + W_IN), 2048, 8704, MapWin(), ldsf, bid, nblk);
    {
        bf16_t* H = (bf16_t*)(ws + W_H); const float* gw = p->in[6];
        for (int row = bid * 8 + wave; row < M; row += 2 * nblk * 8) {
            const int rowB = row + nblk * 8; const bool hasB = rowB < M;
            const float* xa = xrow(p, row); const float* xb = xrow(p, hasB ? rowB : row); f32x4 va[8], vb[8];
#pragma unroll
            for (int i = 0; i < 8; ++i) { va[i] = *(const f32x4*)(xa + i * 256 + lane * 4); vb[i] = *(const f32x4*)(xb + i * 256 + lane * 4); }
            const float ra = rsqrtf(wave_sum(sumsq8(va)) * (1.0f / DM) + NORM_EPS), rb = rsqrtf(wave_sum(sumsq8(vb)) * (1.0f / DM) + NORM_EPS);
#pragma unroll
            for (int i = 0; i < 8; ++i) { const f32x4 g = *(const f32x4*)(gw + i * 256 + lane * 4); const f32x4 oa = va[i] * ra * g, ob = vb[i] * rb * g;
                u32x2 w; w.x = cvt_pk_bf16(oa[0], oa[1]); w.y = cvt_pk_bf16(oa[2], oa[3]); *(u32x2*)(H + (size_t)row * DM + i * 256 + lane * 4) = w;
                if (hasB) { u32x2 w2; w2.x = cvt_pk_bf16(ob[0], ob[1]); w2.y = cvt_pk_bf16(ob[2], ob[3]); *(u32x2*)(H + (size_t)rowB * DM + i * 256 + lane * 4) = w2; } }
        }
        for (int e = bid * NTHR + tid; e < 128 * 11 * 256; e += nblk * NTHR) { const int c4 = e & 255, j = (e >> 8) % 11, b = (e >> 8) / 11;
            *(f32x4*)(p->out + O_SPOOL + ((size_t)b * 15 + j) * 1024 + c4 * 4) = *(const f32x4*)(p->in[4] + ((size_t)b * 15 + j + 4) * 1024 + c4 * 4); }
    }
    }
    xcd_barrier(xbar);

    {
        PHASE_BEGIN();
        pg8::Gemm g{(const bf16_t*)(ws + W_H), (const bf16_t*)(ws + W_IN), M, 8704, 2048, 2048, 2048, 0, 0}; pg8::StaticOrder S; S.init(M, 8704, nblk, bid, 2048);
        EpiZ E{Z, p->out}; pg8::gemm_phase(lds, g, S, E);
        { const int nfull = (34 * 34) / nblk, nrem = (34 * 34) - nfull * nblk;
          if (bid >= nrem && nrem > 0 && nblk - nrem >= 8) { const int ob = bid - nrem, onb = nblk - nrem;
            transpose_job(p->in[19], 2048, 1024, (bf16_t*)(ws + W_AB), 1024, 2048, MapId(), ldsf, ob, onb);
            transpose_job(p->in[22], 2048, 1024, (bf16_t*)(ws + W_AB) + (size_t)2048 * 1024, 1024, 2048, MapId(), ldsf, ob, onb);
            transpose_job(p->in[23], 2048, 2048, (bf16_t*)(ws + W_O), 2048, 2048, MapId(), ldsf, ob, onb);
            for (int g = 0; g < 4; ++g) transpose_job(p->in[20] + (size_t)g * 65536, 256, 256, (bf16_t*)(ws + W_POOL) + (size_t)g * 65536, 256, 256, MapId(), ldsf, ob, onb);
            transpose_job(p->in[10], 1024, 64, (bf16_t*)(ws + W_LR), 256, 1024, MapId(), ldsf, ob, onb);
            transpose_job(p->in[12], 1024, 64, (bf16_t*)(ws + W_LR) + (size_t)1024 * 256, 256, 1024, MapId(), ldsf, ob, onb);
            transpose_job(p->in[13], 1024, 160, (bf16_t*)(ws + W_LR) + (size_t)2048 * 256, 256, 1024, MapId(), ldsf, ob, onb);
          } else if (nrem == 0 || nblk - nrem < 8) {
            transpose_job(p->in[19], 2048, 1024, (bf16_t*)(ws + W_AB), 1024, 2048, MapId(), ldsf, bid, nblk);
            transpose_job(p->in[22], 2048, 1024, (bf16_t*)(ws + W_AB) + (size_t)2048 * 1024, 1024, 2048, MapId(), ldsf, bid, nblk);
            transpose_job(p->in[23], 2048, 2048, (bf16_t*)(ws + W_O), 2048, 2048, MapId(), ldsf, bid, nblk);
            for (int g = 0; g < 4; ++g) transpose_job(p->in[20] + (size_t)g * 65536, 256, 256, (bf16_t*)(ws + W_POOL) + (size_t)g * 65536, 256, 256, MapId(), ldsf, bid, nblk);
            transpose_job(p->in[10], 1024, 64, (bf16_t*)(ws + W_LR), 256, 1024, MapId(), ldsf, bid, nblk);
            transpose_job(p->in[12], 1024, 64, (bf16_t*)(ws + W_LR) + (size_t)1024 * 256, 256, 1024, MapId(), ldsf, bid, nblk);
            transpose_job(p->in[13], 1024, 160, (bf16_t*)(ws + W_LR) + (size_t)2048 * 256, 256, 1024, MapId(), ldsf, bid, nblk);
          } }
    }
    xcd_barrier(xbar);

    {
        PHASE_BEGIN();
        bf16_t* A2 = (bf16_t*)(ws + W_A2);
        for (int e = bid * NTHR + tid; e < M * 96; e += nblk * NTHR) { const int r = e / 96, j8 = e - r * 96; u32x4 o = (u32x4){0u, 0u, 0u, 0u};
            int kind = -1, zc = 0;
            if (j8 < 8) { kind = 0; zc = ZC_LR + j8 * 8; } else if (j8 >= 32 && j8 < 40) { kind = 1; zc = ZC_LR + 64 + (j8 - 32) * 8; } else if (j8 >= 64 && j8 < 84) { kind = 2; zc = ZC_LR + 128 + (j8 - 64) * 8; }
            if (kind >= 0) {
                const bool smp = r >= MP; const int t = smp ? (r - MP) & 3 : r & 2047;
                f32x4 z0, z1, p0, p1; unpack8(*(const u32x4*)(Z + (size_t)r * ZLD + zc), z0, z1);
                if (t > 0) unpack8(*(const u32x4*)(Z + (size_t)(r - 1) * ZLD + zc), p0, p1);
                else if (smp) { const float* sp = p->in[2] + (size_t)((r - MP) >> 2) * DSH + zc; p0 = *(const f32x4*)sp; p1 = *(const f32x4*)(sp + 4); }
                else { p0 = (f32x4){0.f, 0.f, 0.f, 0.f}; p1 = p0; }
                const f32x4 m0 = *(const f32x4*)(p->in[8] + zc), m1 = *(const f32x4*)(p->in[8] + zc + 4);
                f32x4 v0 = z0 + (p0 - z0) * m0, v1 = z1 + (p1 - z1) * m1;
#pragma unroll
                for (int j = 0; j < 4; ++j) {
                    if (kind == 0) { v0[j] = 1.0f - 2.0f * __builtin_amdgcn_rcpf(1.0f + __expf(2.0f * v0[j])); v1[j] = 1.0f - 2.0f * __builtin_amdgcn_rcpf(1.0f + __expf(2.0f * v1[j])); }
                    else if (kind == 2) { v0[j] = sigmoidf_(v0[j]); v1[j] = sigmoidf_(v1[j]); } }
                o = pack8(v0, v1); }
            *(u32x4*)(A2 + (size_t)r * 768 + j8 * 8) = o; }
        bf16_t* D = (bf16_t*)(ws + W_DYA);
        for (int e = bid * NTHR + tid; e < 512 * 128; e += nblk * NTHR) { const int seg = e >> 7, c = (e & 127) * 8; const int gi = c >> 8, win = 2 << gi;
            const int r0 = seg * 16, t0 = r0 & 2047;
            f32x4 s0 = (f32x4){0.f, 0.f, 0.f, 0.f}, s1 = s0;
            for (int j = 1; j < win; ++j) { if (t0 - j >= 0) { f32x4 a, bq; unpack8(*(const u32x4*)(Z + (size_t)(r0 - j) * ZLD + ZC_P + c), a, bq); s0 += a; s1 += bq; } }
#pragma unroll 4
            for (int i = 0; i < 16; ++i) { const int t = t0 + i; f32x4 a, bq; unpack8(*(const u32x4*)(Z + (size_t)(r0 + i) * ZLD + ZC_P + c), a, bq);
                s0 += a; s1 += bq; const float ic = 1.0f / (float)min(win, t + 1);
                *(u32x4*)(D + (size_t)(r0 + i) * 1024 + c) = pack8(s0 * ic - a, s1 * ic - bq);
                if (t - win + 1 >= 0) { f32x4 oa, ob; unpack8(*(const u32x4*)(Z + (size_t)(r0 + i - win + 1) * ZLD + ZC_P + c), oa, ob); s0 -= oa; s1 -= ob; } }
        }
        for (int e = bid * NTHR + tid; e < 512 * 128; e += nblk * NTHR) { const int r = MP + (e >> 7), c = (e & 127) * 8; const int gi = c >> 8, win = 2 << gi;
            const int b = (r - MP) >> 2, t = (r - MP) & 3;
            f32x4 s0 = (f32x4){0.f, 0.f, 0.f, 0.f}, s1 = s0, z0 = s0, z1 = s0;
            for (int j = 0; j < win; ++j) { const int tj = t - j; f32x4 a, bq;
                if (tj >= 0) unpack8(*(const u32x4*)(Z + (size_t)(r - j) * ZLD + ZC_P + c), a, bq);
                else { const float* sp = p->in[4] + ((size_t)b * 15 + (15 + tj)) * 1024 + c; a = *(const f32x4*)sp; bq = *(const f32x4*)(sp + 4); }
                if (j == 0) { z0 = a; z1 = bq; }
                s0 += a; s1 += bq; }
            const float ic = 1.0f / (float)win;
            *(u32x4*)(D + (size_t)r * 1024 + c) = pack8(s0 * ic - z0, s1 * ic - z1); }
    }
    xcd_barrier(xbar);

    {
        PHASE_BEGIN();
        pg8::Gemm g{(const bf16_t*)(ws + W_A2), (const bf16_t*)(ws + W_LR), M, 3072, 256, 768, 256, 2, 256}; pg8::StaticOrder S; S.init(M, 3072, nblk, bid, 256);
        EpiLR E{(bf16_t*)(ws + W_XW), p->in[9], p->in[11]}; pg8::gemm_phase(lds, g, S, E);
        pg8::Gemm g3{(const bf16_t*)(ws + W_DYA), (const bf16_t*)(ws + W_POOL), M, 1024, 256, 1024, 256, 0, 256}; pg8::StaticOrder S3; S3.init(M, 1024, nblk, bid, 256);
        EpiPool E3{(bf16_t*)(ws + W_YB), p->in[21]}; pg8::gemm_phase(lds, g3, S3, E3);
    }
    xcd_barrier(xbar);

    {
        PHASE_BEGIN();
        scan_sample(p, bid * 8 + wave, ldsf);
        __syncthreads();
        for (int cu = bid; cu < 2048; cu += nblk) wkv_pass_a(p, cu, lds);
    }
    xcd_barrier(xbar);
    {
        PHASE_BEGIN();
        if (bid < 64) { if (wave < 4) wkv_pass_b(p, bid * 4 + wave, lane); }
        else {
            const int ob = bid - 64, onb = nblk - 64;
            pg8::Gemm g{(const bf16_t*)(ws + W_YB), (const bf16_t*)(ws + W_AB) + (size_t)2048 * 1024, M, 2048, 1024, 1024, 1024, 0, 0};
            pg8::MixOrder S; S.base.init(MP, 2048, 1, 0, 1024); S.G = onb; S.c = ob; S.sample_only = false;
            EpiGateB E{(bf16_t*)(ws + W_MM), Z}; pg8::gemm_phase(lds, g, S, E);
            pg8::Gemm ga{(const bf16_t*)(ws + W_DYA), (const bf16_t*)(ws + W_AB), M, 2048, 1024, 1024, 1024, 0, 0}; pg8::MixOrder SS = S; SS.sample_only = true;
            EpiGateA EA{Z, (bf16_t*)(ws + W_MM)}; pg8::gemm_phase(lds, ga, SS, EA);
        }
    }
    xcd_barrier(xbar);
    {
        PHASE_BEGIN();
        for (int cu = bid * 2 + (wave >> 2); cu < 2048; cu += nblk * 2) { if (wave < 8) wkv_pass_c(p, cu, wave & 3, lane); }
    }
    xcd_barrier(xbar);
    {
        PHASE_BEGIN();
        const bool tfirst = ((bid >> 3) & 1) != 0;
        if (tfirst) {
            transpose_job(p->in[26], 11264, 2048, (bf16_t*)(ws + W_GU), 2048, 11264, MapId(), ldsf, bid, nblk);
            transpose_job(p->in[29], 2048, 5632, (bf16_t*)(ws + W_D), 5632, 2048, MapId(), ldsf, bid, nblk);
        }
        pg8::Gemm g{(const bf16_t*)(ws + W_DYA), (const bf16_t*)(ws + W_AB), M, 2048, 1024, 1024, 1024, 0, 0}; pg8::StaticOrder S; S.init(MP, 2048, nblk, bid, 1024);
        EpiGateA E{Z, (bf16_t*)(ws + W_MM)}; pg8::gemm_phase(lds, g, S, E);
        if (!tfirst) {
            transpose_job(p->in[26], 11264, 2048, (bf16_t*)(ws + W_GU), 2048, 11264, MapId(), ldsf, bid, nblk);
            transpose_job(p->in[29], 2048, 5632, (bf16_t*)(ws + W_D), 5632, 2048, MapId(), ldsf, bid, nblk);
        }
    }
    xcd_barrier(xbar);

    {
        PHASE_BEGIN();
        pg8::Gemm g{(const bf16_t*)(ws + W_MM), (const bf16_t*)(ws + W_O), M, 2048, 2048, 2048, 2048, 0, 0}; pg8::SplitOrder S; S.init(nblk, bid, 2048, 8);
        EpiOutP E{(bf16_t*)(ws + W_O16), (float*)(ws + W_PART5)}; pg8::gemm_phase(lds, g, S, E);
    }
    xcd_barrier(xbar);

    {
        PHASE_BEGIN();
        bf16_t* H2 = (bf16_t*)(ws + W_H2); const float* g1 = p->in[24]; const float* g2 = p->in[25]; const float* PT = (const float*)(ws + W_PART5); const bf16_t* O16 = (const bf16_t*)(ws + W_O16);
        const int stride = nblk * 8;
        for (int row = bid * 8 + wave; row < MP; row += 2 * stride) {
            const int rowB = row + stride; const bool hasB = rowB < MP;
            f32x4 oa[8], ob[8], xa[8], xb[8];
            row_load_bf(oa, O16, row, lane); if (hasB) row_load_bf(ob, O16, rowB, lane);
#pragma unroll
            for (int i = 0; i < 8; ++i) { xa[i] = *(const f32x4*)(p->in[0] + (size_t)row * DM + i * 256 + lane * 4); if (hasB) xb[i] = *(const f32x4*)(p->in[0] + (size_t)rowB * DM + i * 256 + lane * 4); }
            const float ra = rsqrtf(wave_sum(sumsq8(oa)) * (1.0f / DM) + NORM_EPS), rb = hasB ? rsqrtf(wave_sum(sumsq8(ob)) * (1.0f / DM) + NORM_EPS) : 0.f;
#pragma unroll
            for (int i = 0; i < 8; ++i) { const int c = i * 256 + lane * 4; const f32x4 g = *(const f32x4*)(g1 + c);
                xa[i] = xa[i] + oa[i] * ra * g; *(f32x4*)(Y + (size_t)row * DM + c) = xa[i];
                if (hasB) { xb[i] = xb[i] + ob[i] * rb * g; *(f32x4*)(Y + (size_t)rowB * DM + c) = xb[i]; } }
            const float qa = rsqrtf(wave_sum(sumsq8(xa)) * (1.0f / DM) + NORM_EPS), qb = hasB ? rsqrtf(wave_sum(sumsq8(xb)) * (1.0f / DM) + NORM_EPS) : 0.f;
#pragma unroll
            for (int i = 0; i < 8; ++i) { const int c = i * 256 + lane * 4; const f32x4 g = *(const f32x4*)(g2 + c);
                { const f32x4 o = xa[i] * qa * g; u32x2 w; w.x = cvt_pk_bf16(o[0], o[1]); w.y = cvt_pk_bf16(o[2], o[3]); *(u32x2*)(H2 + (size_t)row * DM + c) = w; }
                if (hasB) { const f32x4 o = xb[i] * qb * g; u32x2 w; w.x = cvt_pk_bf16(o[0], o[1]); w.y = cvt_pk_bf16(o[2], o[3]); *(u32x2*)(H2 + (size_t)rowB * DM + c) = w; } }
        }
        for (int srow = bid * 8 + wave; srow < M - MP; srow += stride) {
            const int row = MP + srow; float s1 = 0.f;
#pragma unroll 1
            for (int i = 0; i < 8; ++i) { const f32x4 o = part_sum<8>(PT, srow, i * 256 + lane * 4); s1 += (o[0] * o[0] + o[1] * o[1]) + (o[2] * o[2] + o[3] * o[3]); }
            const float ra = rsqrtf(wave_sum(s1) * (1.0f / DM) + NORM_EPS); float s2 = 0.f;
#pragma unroll 1
            for (int i = 0; i < 8; ++i) { const int c = i * 256 + lane * 4; const f32x4 o = part_sum<8>(PT, srow, c);
                const f32x4 v = *(const f32x4*)(p->in[1] + (size_t)srow * DM + c) + o * ra * *(const f32x4*)(g1 + c); *(f32x4*)(Y + (size_t)row * DM + c) = v; s2 += (v[0] * v[0] + v[1] * v[1]) + (v[2] * v[2] + v[3] * v[3]); }
            const float qa = rsqrtf(wave_sum(s2) * (1.0f / DM) + NORM_EPS);
            asm volatile("s_waitcnt vmcnt(0)" ::: "memory");
#pragma unroll 1
            for (int i = 0; i < 8; ++i) { const int c = i * 256 + lane * 4; const f32x4 o = *(const f32x4*)(Y + (size_t)row * DM + c) * qa * *(const f32x4*)(g2 + c);
                u32x2 w; w.x = cvt_pk_bf16(o[0], o[1]); w.y = cvt_pk_bf16(o[2], o[3]); *(u32x2*)(H2 + (size_t)row * DM + c) = w; }
        }
    }
    xcd_barrier(xbar);

    {
        PHASE_BEGIN();
        pg8::Gemm g{(const bf16_t*)(ws + W_H2), (const bf16_t*)(ws + W_GU), M, DFF, 2048, 2048, 2048, 0, 0}; pg8::StaticOrder S; S.init(M, DFF, nblk, bid, 2048);
        EpiGate7 E{(bf16_t*)(ws + W_GATE), p->out}; pg8::gemm_phase(lds, g, S, E);
    }
    xcd_barrier(xbar);

    {
        PHASE_BEGIN();
        pg8::Gemm g{(const bf16_t*)(ws + W_H2), (const bf16_t*)(ws + W_GU) + (size_t)DFF * 2048, M, DFF, 2048, 2048, 2048, 0, 0}; pg8::StaticOrder S; S.init(M, DFF, nblk, bid, 2048);
        EpiAct E{(const bf16_t*)(ws + W_GATE), (bf16_t*)(ws + W_ACT), p->in[27], p->in[28], p->in[5]}; pg8::gemm_phase(lds, g, S, E);
    }
    xcd_barrier(xbar);

    {
        PHASE_BEGIN();
        pg8::Gemm g{(const bf16_t*)(ws + W_ACT), (const bf16_t*)(ws + W_D), M, 2048, DFF, DFF, DFF, 0, 0}; pg8::SplitOrder S; S.init(nblk, bid, DFF, 11);
        EpiOutP E{(bf16_t*)(ws + W_F), (float*)(ws + W_PART9)}; pg8::gemm_phase(lds, g, S, E);
    }
    xcd_barrier(xbar);

    {
        PHASE_BEGIN();
        const bf16_t* F = (const bf16_t*)(ws + W_F); const float* g3 = p->in[30]; const float* PT = (const float*)(ws + W_PART9);
        const int stride = nblk * 8;
        for (int row = bid * 8 + wave; row < MP; row += 2 * stride) {
            const int rowB = row + stride; const bool hasB = rowB < MP;
            f32x4 fa[8], fb[8], xa[8], xb[8];
            row_load_bf(fa, F, row, lane); if (hasB) row_load_bf(fb, F, rowB, lane);
#pragma unroll
            for (int i = 0; i < 8; ++i) { xa[i] = *(const f32x4*)(Y + (size_t)row * DM + i * 256 + lane * 4); if (hasB) xb[i] = *(const f32x4*)(Y + (size_t)rowB * DM + i * 256 + lane * 4); }
            const float ra = rsqrtf(wave_sum(sumsq8(fa)) * (1.0f / DM) + NORM_EPS), rb = hasB ? rsqrtf(wave_sum(sumsq8(fb)) * (1.0f / DM) + NORM_EPS) : 0.f;
#pragma unroll
            for (int i = 0; i < 8; ++i) { const int c = i * 256 + lane * 4; const f32x4 g = *(const f32x4*)(g3 + c);
                *(f32x4*)(Y + (size_t)row * DM + c) = xa[i] + fa[i] * ra * g;
                if (hasB) *(f32x4*)(Y + (size_t)rowB * DM + c) = xb[i] + fb[i] * rb * g; }
        }
        for (int srow = bid * 8 + wave; srow < M - MP; srow += stride) {
            const int row = MP + srow; float s1 = 0.f;
#pragma unroll 1
            for (int i = 0; i < 8; ++i) { const f32x4 o = part_sum<11>(PT, srow, i * 256 + lane * 4); s1 += (o[0] * o[0] + o[1] * o[1]) + (o[2] * o[2] + o[3] * o[3]); }
            const float ra = rsqrtf(wave_sum(s1) * (1.0f / DM) + NORM_EPS);
#pragma unroll 1
            for (int i = 0; i < 8; ++i) { const int c = i * 256 + lane * 4; const f32x4 o = part_sum<11>(PT, srow, c);
                *(f32x4*)(Y + (size_t)row * DM + c) = *(const f32x4*)(Y + (size_t)row * DM + c) + o * ra * *(const f32x4*)(g3 + c); }
        }
    }
}

extern "C" void kernel_launch(void* const* d_in, const int* in_sizes, int n_in, void* d_out, int out_size, void* d_ws, size_t ws_size, hipStream_t stream) {
    static int grid_blocks = 0;
    if (!grid_blocks) {
        int dev = 0, cus = 0, per_cu = 0;
        hipGetDevice(&dev);
        hipDeviceGetAttribute(&cus, hipDeviceAttributeMultiprocessorCount, dev);
        hipFuncSetAttribute((const void*)fwd_megakernel, hipFuncAttributeMaxDynamicSharedMemorySize, LDS_BYTES);
        hipOccupancyMaxActiveBlocksPerMultiprocessor(&per_cu, (const void*)fwd_megakernel, NTHR, LDS_BYTES);
        if (per_cu < 1) per_cu = 1;
        grid_blocks = cus * 1;
        if (ws_size < W_END) fprintf(stderr, "kernel_launch: workspace too small: %zu < %zu\n", ws_size, (size_t)W_END);
        if (n_in != 31) fprintf(stderr, "kernel_launch: expected 31 inputs, got %d\n", n_in);
    }
    Params p{};
    for (int i = 0; i < 31; ++i) p.in[i] = (const float*)d_in[i];
    p.out = (float*)d_out; p.ws = (unsigned char*)d_ws;
    hipMemsetAsync((unsigned char*)d_ws + W_BAR, 0, 16384, stream);
    void* args[] = {&p};
    hipError_t e = hipLaunchCooperativeKernel((const void*)fwd_megakernel, dim3(grid_blocks), dim3(NTHR), args, LDS_BYTES, stream);
    if (e != hipSuccess) fprintf(stderr, "cooperative launch failed: %s (grid %d)\n", hipGetErrorString(e), grid_blocks);
}
```

```cpp
#include <hip/hip_runtime.h>
#include <hip/hip_cooperative_groups.h>
#include <cstdio>
namespace cg = cooperative_groups;

#define LAS __attribute__((address_space(3)))
typedef unsigned short bf16_t;
typedef short bf16x8 __attribute__((ext_vector_type(8)));
typedef float f32x4 __attribute__((ext_vector_type(4)));
typedef float f32x2 __attribute__((ext_vector_type(2)));
typedef unsigned u32x4 __attribute__((ext_vector_type(4)));
typedef unsigned u32x2 __attribute__((ext_vector_type(2)));

constexpr int M = 8704;
constexpr int MP = 8192;
constexpr int DM = 2048, DR = 1024, DSH = 3360, DFF = 5632;
constexpr int ZLD = 8704;
constexpr int ZC_LR = 3072, ZC_P = 3584, ZC_GA = 4608, ZC_GB = 6656;
constexpr int NTHR = 512;
constexpr int LDS_BYTES = 131072;
constexpr float NORM_EPS = 1e-6f, GN_EPS = 64e-5f;

constexpr size_t O_Y = 0;
constexpr size_t O_PSHIFT = 17825792, O_PWKV = 17839232, O_PPOOL = 18101376, O_PCONV = 18162816;
constexpr size_t O_SSHIFT = 18207872, O_SWKV = 18637952, O_SPOOL = 27026560, O_SCONV = 28992640;

constexpr size_t SZ_M1024_BF = (size_t)M * 1024 * 2;
constexpr size_t W_AB = 0;
constexpr size_t W_O = W_AB + 8388608;
constexpr size_t W_POOL = W_O + 8388608;
constexpr size_t W_LR = W_POOL + 524288;
constexpr size_t W_SSQ = W_LR + 1572864;
constexpr size_t W_RA = W_SSQ + (size_t)M * 32 * 4;
constexpr size_t W_IN = W_RA;
constexpr size_t W_H = W_RA + (size_t)8704 * 2048 * 2;
constexpr size_t W_GU = W_RA;
constexpr size_t W_D = W_RA + (size_t)11264 * 2048 * 2;
constexpr size_t W_Z = W_RA + (size_t)2 * 8704 * 2048 * 2;
constexpr size_t W_H2 = W_Z;
constexpr size_t W_GATE = W_Z + (size_t)M * 2048 * 2;
constexpr size_t W_F = W_Z;
constexpr size_t W_O16 = W_Z + (size_t)M * 2048 * 4 + (size_t)1048576;
constexpr size_t W_PART5 = W_Z + (size_t)M * 2048 * 2;
constexpr size_t W_PART9 = W_Z + (size_t)M * 2048 * 4;
constexpr size_t W_RC = W_Z + (size_t)M * ZLD * 2;
constexpr size_t W_XW = W_RC;
constexpr size_t W_XA = W_XW + SZ_M1024_BF;
constexpr size_t W_GG = W_XA + SZ_M1024_BF;
constexpr size_t W_DYA = W_GG + SZ_M1024_BF;
constexpr size_t W_YB = W_DYA + SZ_M1024_BF;
constexpr size_t W_A2 = W_YB + SZ_M1024_BF;
constexpr size_t W_MM = W_XW;
constexpr size_t W_ACT = W_RC;
constexpr size_t W_BAR = W_A2 + (size_t)M * 768 * 2;
constexpr size_t W_SF = W_BAR + 16384;
constexpr size_t W_END = W_SF + (size_t)2048 * 8192;

struct Params { const float* in[31]; float* out; unsigned char* ws; };
typedef const __attribute__((address_space(4))) Params* KArgP;
__device__ __forceinline__ KArgP kargs() { KArgP q = (KArgP)__builtin_amdgcn_kernarg_segment_ptr(); asm volatile("" : "+s"(q)); return q; }

__device__ __forceinline__ float bf2f(bf16_t b) { return __uint_as_float(((unsigned)b) << 16); }
__device__ __forceinline__ bf16_t f2bf(float f) { unsigned u = __float_as_uint(f); u += 0x7FFFu + ((u >> 16) & 1u); return (bf16_t)(u >> 16); }
typedef __bf16 bf16n2 __attribute__((ext_vector_type(2)));
__device__ __forceinline__ unsigned cvt_pk_bf16(float lo, float hi) { const f32x2 v = {lo, hi}; const bf16n2 r = __builtin_convertvector(v, bf16n2); unsigned u; __builtin_memcpy(&u, &r, 4); return u; }
__device__ __forceinline__ float lo_bf(unsigned w) { return __uint_as_float(w << 16); }
__device__ __forceinline__ float hi_bf(unsigned w) { return __uint_as_float(w & 0xffff0000u); }
__device__ __forceinline__ float sigmoidf_(float x) { return __builtin_amdgcn_rcpf(1.0f + __expf(-x)); }
#define DPP_ADD(v, ctrl) ((v) + __uint_as_float(__builtin_amdgcn_update_dpp(0u, __float_as_uint(v), (ctrl), 0xF, 0xF, true)))
__device__ __forceinline__ float xor16_sum(float v) { const auto r = __builtin_amdgcn_permlane16_swap(__float_as_uint(v), __float_as_uint(v), false, false); return __uint_as_float(r[0]) + __uint_as_float(r[1]); }
__device__ __forceinline__ float xor32_sum(float v) { const auto r = __builtin_amdgcn_permlane32_swap(__float_as_uint(v), __float_as_uint(v), false, false); return __uint_as_float(r[0]) + __uint_as_float(r[1]); }
__device__ __forceinline__ float wave_sum(float v) {
    v = DPP_ADD(v, 0xB1);
    v = DPP_ADD(v, 0x4E);
    v = DPP_ADD(v, 0x141);
    v = DPP_ADD(v, 0x140);
    v = xor16_sum(v);
    return xor32_sum(v);
}
__device__ __forceinline__ const float* xrow(KArgP p, int r) { return r < MP ? p->in[0] + (size_t)r * DM : p->in[1] + (size_t)(r - MP) * DM; }
__device__ __forceinline__ float gelu_tanh(float x) {
    const float u = 0.7978845608f * (x + 0.044715f * x * x * x);
    return x * __builtin_amdgcn_rcpf(1.0f + __expf(-2.0f * u));
}


#define XB_TMO      128
#define XB_XCNT(j)  (256  + 64 * (j))
#define XB_XSUB(j)  (1280 + 64 * (j))
#define XB_XGEN(j)  (2304 + 64 * (j))
#define XB_TOP      3328
#define XB_TOPGEN   3392
#define XCD_BAR_WORDS 3456
#define XB_SPIN_CAP (1u << 18)
__device__ __forceinline__ unsigned xb_ld(unsigned* p)              { return __hip_atomic_load(p, __ATOMIC_RELAXED, __HIP_MEMORY_SCOPE_AGENT); }
__device__ __forceinline__ unsigned xb_add(unsigned* p, unsigned v) { return __hip_atomic_fetch_add(p, v, __ATOMIC_RELAXED, __HIP_MEMORY_SCOPE_AGENT); }
__device__ __forceinline__ unsigned xb_xcc_id() { return (unsigned)__builtin_amdgcn_s_getreg((3 << 11) | 20) & 0xFu; }
#define XB_SPIN(cond, bar) do { unsigned _sp = 0; while (cond) { __builtin_amdgcn_s_sleep(1); \
    if ((++_sp & 255u) == 0u) { if (xb_ld(&(bar)[XB_TMO])) break; if (_sp > XB_SPIN_CAP) { atomicAdd(&(bar)[XB_TMO], 1u); break; } } } } while (0)
struct XcdBarrier { unsigned* bar; unsigned x; volatile LAS unsigned* st; };
__device__ __forceinline__ XcdBarrier xcd_barrier_post(unsigned* bar, volatile LAS unsigned* st) {
    XcdBarrier b; b.bar = bar; b.x = xb_xcc_id(); b.st = st;
    if (threadIdx.x == 0) (void)xb_add(&bar[XB_XCNT(b.x)], 1u);
    return b;
}
__device__ __forceinline__ void xcd_barrier_complete(unsigned* bar, unsigned x, unsigned& nloc, unsigned& nx) {
    const unsigned G = gridDim.x * gridDim.y * gridDim.z;
    unsigned sum, cnt, mine, sp = 0u;
    for (;;) {
        sum = 0u; cnt = 0u; mine = 0u;
#pragma unroll
        for (unsigned j = 0; j < 16; ++j) { const unsigned c = xb_ld(&bar[XB_XCNT(j)]); sum += c; cnt += (c > 0u) ? 1u : 0u; mine = (j == x) ? c : mine; }
        if (sum == G) break;
        __builtin_amdgcn_s_sleep(1);
        if ((++sp & 255u) == 0u) { if (xb_ld(&bar[XB_TMO])) break; if (sp > XB_SPIN_CAP) { atomicAdd(&bar[XB_TMO], 1u); break; } }
    }
    nloc = mine > 0u ? mine : 1u; nx = cnt > 0u ? cnt : 1u;
}
__device__ __forceinline__ void xcd_barrier(const XcdBarrier& b) {
    asm volatile("s_waitcnt vmcnt(0)" ::: "memory");
    __syncthreads();
    if (threadIdx.x == 0) {
        unsigned* bar = b.bar;
        __builtin_amdgcn_s_waitcnt(0);
        unsigned nloc = b.st[0], nx = b.st[1];
        if (nloc == 0u) { xcd_barrier_complete(bar, b.x, nloc, nx); b.st[0] = nloc; b.st[1] = nx; }
        const unsigned old = xb_add(&bar[XB_XSUB(b.x)], 1u);
        const unsigned gen = old / nloc;
        if (old + 1u == (gen + 1u) * nloc) {
            __builtin_amdgcn_fence(__ATOMIC_RELEASE, "agent");
            asm volatile("s_waitcnt vmcnt(0)" ::: "memory");
            const unsigned og = xb_add(&bar[XB_TOP], 1u);
            const unsigned tg = og / nx;
            if (og + 1u == (tg + 1u) * nx) xb_add(&bar[XB_TOPGEN], 1u);
            else XB_SPIN(xb_ld(&bar[XB_TOPGEN]) == tg, bar);
            __builtin_amdgcn_fence(__ATOMIC_ACQUIRE, "agent");
            xb_add(&bar[XB_XGEN(b.x)], 1u);
            asm volatile("s_waitcnt vmcnt(0)" ::: "memory");
        } else {
            XB_SPIN(xb_ld(&bar[XB_XGEN(b.x)]) == gen, bar);
            __builtin_amdgcn_fence(__ATOMIC_ACQUIRE, "agent");
            asm volatile("s_waitcnt vmcnt(0)" ::: "memory");
        }
    }
    __syncthreads();
}

namespace pg8 {
constexpr int BM = 256, BK = 64, HALF = 128, HTB = HALF * BK * 2, NXCD = 8, WGM = 8;
__device__ __forceinline__ int lds_byte(int r, int c) { const int st = (r >> 4) * 2 + (c >> 5), rr = r & 15, cc = c & 31, ob = rr * 64 + cc * 2; return st * 1024 + (ob ^ (((ob >> 9) & 1) << 5)); }
__device__ __forceinline__ void stage_rc(int b, int& R, int& C) { const int st = b / 1024, sb = b % 1024, swz = sb ^ (((sb >> 9) & 1) << 5); R = (st >> 1) * 16 + swz / 64; C = (st & 1) * 32 + (swz % 64) / 2; }
__device__ __forceinline__ int perm32(int rho) { const int n = rho >> 4, i = rho & 15; return 8 * (i >> 2) + 4 * n + (i & 3); }

struct Unit { int pm, pn, k0, nt, sp; };
struct Gemm { const bf16_t* A; const bf16_t* Bt; int M, N, K, lda, ldb, agshift, agcols; };

struct StaticOrder {
    int nM, nN, nwg, G, c;
    int ntk;
    __device__ __forceinline__ void init(int M_, int N_, int G_, int c_, int K_) { nM = M_ / BM; nN = N_ / BM; nwg = nM * nN; G = G_; c = c_; ntk = K_ / BK; }
    __device__ __forceinline__ Unit get(int i) const {
        Unit u; u.pm = 0; u.pn = 0; u.k0 = 0; u.nt = 0; u.sp = -1;
        const long L = (long)i * G + c; if (L >= nwg) return u;
        int wgid = (int)L; { const int q = nwg / NXCD, r = nwg % NXCD, xcd = wgid % NXCD, off = wgid / NXCD; wgid = (xcd < r ? xcd * (q + 1) : r * (q + 1) + (xcd - r) * q) + off; }
        const int nig = WGM * nN, gid = wgid / nig, fm = gid * WGM, gsz = (nM - fm) < WGM ? (nM - fm) : WGM;
        u.pm = fm + ((wgid % nig) % gsz); u.pn = (wgid % nig) / gsz; u.nt = ntk; return u;
    }
};
struct SampleOrder {
    StaticOrder base;
    __device__ __forceinline__ Unit get(int i) const {
        int cnt = 0; Unit e; e.pm = 0; e.pn = 0; e.k0 = 0; e.nt = 0; e.sp = -1;
#pragma unroll
        for (int k = 0; k < 3; ++k) { const Unit u = base.get(k); if (u.nt != 0 && u.pm >= 32) { if (cnt == i) return u; ++cnt; } }
        return e;
    }
};
struct MixOrder {
    StaticOrder base; int G, c; bool sample_only;
    __device__ __forceinline__ Unit get(int i) const {
        Unit u; u.pm = 0; u.pn = 0; u.k0 = 0; u.nt = 0; u.sp = -1;
        const int np = G - 16;
        if (c < np) { if (sample_only) return u; StaticOrder b = base; b.G = 1 << 20; b.c = c + i * np; return (i < 64 && c + i * np < 256) ? b.get(0) : u; }
        const int t = c - np; if (i == 0 && t < 16) { u.pm = 32 + (t >> 3); u.pn = t & 7; u.nt = base.ntk; }
        return u;
    }
};
struct LowRankOrder {
    int part, G, c, ntk;
    __device__ __forceinline__ Unit get(int i) const {
        Unit u; u.pm = 0; u.pn = 0; u.k0 = 0; u.nt = 0; u.sp = -1;
        if (c < 0) return u;
        const int L = i * G + c;
        if (part == 0) { if (L < 272) { u.pm = L % 34; u.pn = L / 34; u.nt = ntk; } else if (L < 280) { u.pm = 32 + (L - 272) / 4; u.pn = 8 + (L - 272) % 4; u.nt = ntk; } }
        else if (L < 128) { u.pm = L / 4; u.pn = 8 + (L % 4); u.nt = ntk; }
        return u;
    }
};
struct SplitOrder {
    StaticOrder base; int S, nbase;
    __device__ __forceinline__ void init(int G_, int c_, int K_, int S_) { base.init(8192, 2048, G_, c_, K_); S = S_; nbase = (c_ < 256) ? (256 - c_ + G_ - 1) / G_ : 0; }
    __device__ __forceinline__ Unit get(int i) const {
        if (i < nbase) return base.get(i);
        Unit u; u.pm = 0; u.pn = 0; u.k0 = 0; u.nt = 0; u.sp = -1;
        if (i == nbase && base.c < 16 * S) { const int uu = base.c / S, sp = base.c % S; u.pm = 32 + (uu >> 3); u.pn = uu & 7; u.nt = base.ntk / S; u.k0 = sp * u.nt; u.sp = sp; }
        return u;
    }
};

template <class Epi, class Sched>
__device__ __forceinline__ void gemm_phase(LAS unsigned char* lds, const Gemm g, const Sched& S, const Epi& E) {
    int tid = threadIdx.x; asm volatile("" : "+v"(tid));
    const int wid = __builtin_amdgcn_readfirstlane(tid >> 6), lane = tid & 63, wr = wid >> 2, wc = wid & 3, fr = lane & 15, fq = lane >> 4;
    unsigned voffA[2], voffB[2];
#pragma unroll
    for (int i = 0; i < 2; ++i) { int R, C; stage_rc(tid * 16 + i * 8192, R, C); const int Rb = Epi::PERM ? ((R & ~31) + perm32(R & 31)) : R;
        voffA[i] = (unsigned)(R * g.lda + C) * 2u; voffB[i] = (unsigned)(Rb * g.ldb + C) * 2u; }
    const size_t kstep = (size_t)(BK * 2);
    const size_t hstepA = (size_t)HALF * g.lda * 2, hstepB = (size_t)HALF * g.ldb * 2;
    const size_t tstepA = 2 * hstepA, tstepB = 2 * hstepB;
    const unsigned ldsw = (unsigned)wid * 1024u;
    const int aoff = lds_byte(wr * 64 + fr, fq * 8), boff = lds_byte(wc * 32 + fr, fq * 8);
#define PG8_SA(b, h) (((b) * 2 + (h)) * HTB)
#define PG8_SB(b, h) ((4 + (b) * 2 + (h)) * HTB)
#define PG8_STAGE(bufoff, gbase, voff) do { _Pragma("unroll") for (int _i = 0; _i < 2; ++_i) \
        __builtin_amdgcn_global_load_lds((const unsigned*)((const char*)(gbase) + (voff)[_i]), (LAS unsigned*)(lds + (bufoff) + ldsw + _i * 8192), 16, 0, 0); } while (0)
#define PG8_LDA(dst, b, h) do { _Pragma("unroll") for (int m = 0; m < 4; ++m) _Pragma("unroll") for (int k = 0; k < 2; ++k) dst[m][k] = *(const LAS bf16x8*)(lds + PG8_SA(b, h) + aoff + m * 2048 + k * 1024); } while (0)
#define PG8_LDB(dst, b, h) do { _Pragma("unroll") for (int n = 0; n < 2; ++n) _Pragma("unroll") for (int k = 0; k < 2; ++k) dst[n][k] = *(const LAS bf16x8*)(lds + PG8_SB(b, h) + boff + n * 2048 + k * 1024); } while (0)
#define PG8_MMA(ai, bj, At, Bt) do { __builtin_amdgcn_s_setprio(1); _Pragma("unroll") for (int m = 0; m < 4; ++m) _Pragma("unroll") for (int n = 0; n < 2; ++n) _Pragma("unroll") for (int k = 0; k < 2; ++k) \
        acc[ai][bj][m][n] = __builtin_amdgcn_mfma_f32_16x16x32_bf16(Bt[n][k], At[m][k], acc[ai][bj][m][n], 0, 0, 0); __builtin_amdgcn_s_setprio(0); } while (0)
#define PG8_WAIT_V(n) asm volatile("s_waitcnt vmcnt(" #n ")" ::: "memory")
#define PG8_WAIT_L(n) asm volatile("s_waitcnt lgkmcnt(" #n ")" ::: "memory")
#define PG8_BAR __builtin_amdgcn_s_barrier()
#define PG8_SCHED __builtin_amdgcn_sched_barrier(0)
    Unit cur = S.get(0), nxt; int ui = 0;
    if (cur.nt == 0) return;
    f32x4 acc[2][2][4][2];
#pragma unroll
    for (int a = 0; a < 2; ++a)
#pragma unroll
        for (int b = 0; b < 2; ++b)
#pragma unroll
            for (int m = 0; m < 4; ++m)
#pragma unroll
                for (int n = 0; n < 2; ++n) acc[a][b][m][n] = (f32x4){0.f, 0.f, 0.f, 0.f};
    bf16x8 At[4][2], B0[2][2], B1[2][2];
    const char* cA = (const char*)g.A + (size_t)cur.pm * tstepA + (size_t)((cur.pn >> g.agshift) * g.agcols) * 2 + (size_t)cur.k0 * kstep; const char* cB = (const char*)g.Bt + (size_t)cur.pn * tstepB + (size_t)cur.k0 * kstep;
    PG8_STAGE(PG8_SB(0, 0), cB, voffB); PG8_STAGE(PG8_SA(0, 0), cA, voffA); PG8_STAGE(PG8_SB(0, 1), cB + hstepB, voffB); PG8_STAGE(PG8_SA(0, 1), cA + hstepA, voffA);
    if (wr == 1) PG8_BAR;
    PG8_WAIT_V(4); PG8_BAR;
    PG8_STAGE(PG8_SB(1, 0), cB + kstep, voffB); PG8_STAGE(PG8_SA(1, 0), cA + kstep, voffA); PG8_STAGE(PG8_SB(1, 1), cB + hstepB + kstep, voffB);
    PG8_WAIT_V(6); PG8_BAR;
    for (;;) {
        nxt = S.get(ui + 1); const bool has_next = nxt.nt != 0;
        const char* nA = has_next ? (const char*)g.A + (size_t)nxt.pm * tstepA + (size_t)((nxt.pn >> g.agshift) * g.agcols) * 2 + (size_t)nxt.k0 * kstep : cA; const char* nB = has_next ? (const char*)g.Bt + (size_t)nxt.pn * tstepB + (size_t)nxt.k0 * kstep : cB;
        const int nt = cur.nt;
        for (int t = 0; t < nt; t += 2) {
            const bool last = (t == nt - 2);
            const char* a1 = cA + (size_t)(t + 1) * kstep;
            const char* a2 = last ? nA : cA + (size_t)(t + 2) * kstep; const char* b2 = last ? nB : cB + (size_t)(t + 2) * kstep;
            const char* a3 = a2 + kstep; const char* b3 = b2 + kstep;
            PG8_LDB(B0, 0, 0); PG8_SCHED; PG8_LDA(At, 0, 0); PG8_STAGE(PG8_SA(1, 1), a1 + hstepA, voffA);
            PG8_WAIT_L(8); PG8_BAR; PG8_WAIT_L(0); PG8_MMA(0, 0, At, B0); PG8_BAR; PG8_SCHED;
            PG8_LDB(B1, 0, 1); PG8_STAGE(PG8_SB(0, 0), b2, voffB);
            PG8_BAR; PG8_WAIT_L(0); PG8_MMA(0, 1, At, B1); PG8_BAR;
            PG8_LDA(At, 0, 1); PG8_STAGE(PG8_SA(0, 0), a2, voffA);
            PG8_BAR; PG8_WAIT_L(0); PG8_MMA(1, 0, At, B0); PG8_BAR; PG8_SCHED;
            PG8_STAGE(PG8_SB(0, 1), b2 + hstepB, voffB);
            PG8_WAIT_V(6); PG8_BAR; PG8_MMA(1, 1, At, B1); PG8_BAR;
            PG8_LDB(B0, 1, 0); PG8_SCHED; PG8_LDA(At, 1, 0); PG8_STAGE(PG8_SA(0, 1), a2 + hstepA, voffA);
            PG8_WAIT_L(8); PG8_BAR; PG8_WAIT_L(0); PG8_MMA(0, 0, At, B0); PG8_BAR; PG8_SCHED;
            PG8_LDB(B1, 1, 1); PG8_STAGE(PG8_SB(1, 0), b3, voffB);
            PG8_BAR; PG8_WAIT_L(0); PG8_MMA(0, 1, At, B1); PG8_BAR;
            PG8_LDA(At, 1, 1); PG8_STAGE(PG8_SA(1, 0), a3, voffA);
            PG8_BAR; PG8_WAIT_L(0); PG8_MMA(1, 0, At, B0); PG8_BAR; PG8_SCHED;
            PG8_STAGE(PG8_SB(1, 1), b3 + hstepB, voffB);
            PG8_WAIT_V(6); PG8_BAR; PG8_MMA(1, 1, At, B1); PG8_BAR;
        }
        E(acc, cur, wr, wc, fr, fq);
        if (!has_next) break;
#pragma unroll
        for (int a = 0; a < 2; ++a)
#pragma unroll
            for (int b = 0; b < 2; ++b)
#pragma unroll
                for (int m = 0; m < 4; ++m)
#pragma unroll
                    for (int n = 0; n < 2; ++n) acc[a][b][m][n] = (f32x4){0.f, 0.f, 0.f, 0.f};
        cur = nxt; cA = nA; cB = nB; ++ui;
    }
    PG8_WAIT_V(0);
    if (wr == 0) PG8_BAR;
    PG8_BAR;
#undef PG8_SA
#undef PG8_SB
#undef PG8_STAGE
#undef PG8_LDA
#undef PG8_LDB
#undef PG8_MMA
#undef PG8_WAIT_V
#undef PG8_WAIT_L
#undef PG8_BAR
#undef PG8_SCHED
}
}
using pg8::Unit;
typedef const f32x4 (&AccRef)[2][2][4][2];

__device__ __forceinline__ u32x4 pack8(f32x4 v0, f32x4 v1) { u32x4 w; w.x = cvt_pk_bf16(v0[0], v0[1]); w.y = cvt_pk_bf16(v0[2], v0[3]); w.z = cvt_pk_bf16(v1[0], v1[1]); w.w = cvt_pk_bf16(v1[2], v1[3]); return w; }
__device__ __forceinline__ void unpack8(u32x4 w, f32x4& a, f32x4& b) { a = (f32x4){lo_bf(w.x), hi_bf(w.x), lo_bf(w.y), hi_bf(w.y)}; b = (f32x4){lo_bf(w.z), hi_bf(w.z), lo_bf(w.w), hi_bf(w.w)}; }

struct EpiZ {
    static constexpr bool PERM = true;
    bf16_t* Z; float* out;
    __device__ __forceinline__ void operator()(AccRef acc, const Unit& u, int wr, int wc, int fr, int fq) const {
        const int row0 = u.pm * 256 + wr * 64 + fr, col0 = u.pn * 256 + wc * 32 + 8 * fq;
#pragma unroll
        for (int ai = 0; ai < 2; ++ai)
#pragma unroll
            for (int m = 0; m < 4; ++m) { bf16_t* rowp = Z + (size_t)(row0 + ai * 128 + m * 16) * ZLD + col0;
#pragma unroll
                for (int bj = 0; bj < 2; ++bj) *(u32x4*)(rowp + bj * 128) = pack8(acc[ai][bj][m][0], acc[ai][bj][m][1]); }
        const bool special = (u.pm >= 32) || ((u.pm & 7) == 7);
        if (special && u.pn < 18) {
#pragma unroll
            for (int ai = 0; ai < 2; ++ai)
#pragma unroll
                for (int m = 0; m < 4; ++m) {
                    const int r = row0 + ai * 128 + m * 16; const bool smp = r >= MP; const int b = smp ? (r - MP) >> 2 : r >> 11, t = smp ? (r - MP) & 3 : r & 2047;
#pragma unroll
                    for (int bj = 0; bj < 2; ++bj) { const int c = col0 + bj * 128; float* dst = nullptr;
                        if (c < DSH) { if (smp ? (t == 3) : (t == 2047)) dst = out + (smp ? O_SSHIFT : O_PSHIFT) + (size_t)b * DSH + c; }
                        else if (c >= ZC_P && c < ZC_P + 1024) { const int cc = c - ZC_P;
                            if (smp) dst = out + O_SPOOL + ((size_t)b * 15 + 11 + t) * 1024 + cc;
                            else if (t >= 2033) dst = out + O_PPOOL + ((size_t)b * 15 + (t - 2033)) * 1024 + cc; }
                        if (dst) { *(f32x4*)dst = acc[ai][bj][m][0]; *(f32x4*)(dst + 4) = acc[ai][bj][m][1]; } } }
        }
    }
};
struct EpiLR {
    static constexpr bool PERM = true;
    bf16_t* XW; const float* w0; const float* a0;
    __device__ __forceinline__ void operator()(AccRef acc, const Unit& u, int wr, int wc, int fr, int fq) const {
        const int sel = u.pn >> 2; const int row0 = u.pm * 256 + wr * 64 + fr, col0 = (u.pn & 3) * 256 + wc * 32 + 8 * fq;
        bf16_t* base = XW + (size_t)sel * ((size_t)M * 1024);
#pragma unroll
        for (int bj = 0; bj < 2; ++bj) { const int c = col0 + bj * 128; f32x4 b0 = (f32x4){0.f, 0.f, 0.f, 0.f}, b1 = b0;
            if (sel == 0) { b0 = *(const f32x4*)(w0 + c); b1 = *(const f32x4*)(w0 + c + 4); } else if (sel == 1) { b0 = *(const f32x4*)(a0 + c); b1 = *(const f32x4*)(a0 + c + 4); }
#pragma unroll
            for (int ai = 0; ai < 2; ++ai)
#pragma unroll
                for (int m = 0; m < 4; ++m) { f32x4 v0 = acc[ai][bj][m][0] + b0, v1 = acc[ai][bj][m][1] + b1;
                    if (sel == 1) {
#pragma unroll
                        for (int j = 0; j < 4; ++j) { v0[j] = sigmoidf_(v0[j]); v1[j] = sigmoidf_(v1[j]); } }
                    *(u32x4*)(base + (size_t)(row0 + ai * 128 + m * 16) * 1024 + c) = pack8(v0, v1); } }
    }
};
struct EpiPool {
    static constexpr bool PERM = true;
    bf16_t* YB; const float* scale;
    __device__ __forceinline__ void operator()(AccRef acc, const Unit& u, int wr, int wc, int fr, int fq) const {
        const int row0 = u.pm * 256 + wr * 64 + fr, col0 = u.pn * 256 + wc * 32 + 8 * fq;
#pragma unroll
        for (int bj = 0; bj < 2; ++bj) { const int c = col0 + bj * 128; const f32x4 s0 = *(const f32x4*)(scale + c), s1 = *(const f32x4*)(scale + c + 4);
#pragma unroll
            for (int ai = 0; ai < 2; ++ai)
#pragma unroll
                for (int m = 0; m < 4; ++m) *(u32x4*)(YB + (size_t)(row0 + ai * 128 + m * 16) * 1024 + c) = pack8(acc[ai][bj][m][0] * s0, acc[ai][bj][m][1] * s1); }
    }
};
struct EpiGateB {
    static constexpr bool PERM = true;
    bf16_t* MM; const bf16_t* Z;
    __device__ __forceinline__ void operator()(AccRef acc, const Unit& u, int wr, int wc, int fr, int fq) const {
        const int row0 = u.pm * 256 + wr * 64 + fr, col0 = u.pn * 256 + wc * 32 + 8 * fq;
#pragma unroll
        for (int ai = 0; ai < 2; ++ai)
#pragma unroll
            for (int bj = 0; bj < 2; ++bj) { const int c = col0 + bj * 128;
                u32x4 gz[4];
#pragma unroll
                for (int m = 0; m < 4; ++m) gz[m] = *(const u32x4*)((const char*)Z + ((unsigned)(row0 + ai * 128 + m * 16) * (unsigned)ZLD + (unsigned)(ZC_GB + c)) * 2u);
#pragma unroll
                for (int m = 0; m < 4; ++m) { const int r = row0 + ai * 128 + m * 16; f32x4 g0, g1; unpack8(gz[m], g0, g1);
#pragma unroll
                    for (int j = 0; j < 4; ++j) { g0[j] = sigmoidf_(g0[j]); g1[j] = sigmoidf_(g1[j]); }
                    *(u32x4*)(MM + (size_t)r * DM + c) = pack8(g0 * acc[ai][bj][m][0], g1 * acc[ai][bj][m][1]); } }
    }
};
struct EpiGateA {
    static constexpr bool PERM = true;
    const bf16_t* Z; bf16_t* MM;
    __device__ __forceinline__ void operator()(AccRef acc, const Unit& u, int wr, int wc, int fr, int fq) const {
        const int row0 = u.pm * 256 + wr * 64 + fr, col0 = u.pn * 256 + wc * 32 + 8 * fq;
#pragma unroll
        for (int ai = 0; ai < 2; ++ai)
#pragma unroll
            for (int bj = 0; bj < 2; ++bj) { const int c = col0 + bj * 128;
                u32x4 gz[4], pm[4];
#pragma unroll
                for (int m = 0; m < 4; ++m) { const unsigned r = (unsigned)(row0 + ai * 128 + m * 16);
                    gz[m] = *(const u32x4*)((const char*)Z + (r * (unsigned)ZLD + (unsigned)(ZC_GA + c)) * 2u);
                    pm[m] = *(const u32x4*)((const char*)MM + (r * (unsigned)DM + (unsigned)c) * 2u); }
#pragma unroll
                for (int m = 0; m < 4; ++m) { const int r = row0 + ai * 128 + m * 16; f32x4 g0, g1, p0, p1; unpack8(gz[m], g0, g1); unpack8(pm[m], p0, p1);
#pragma unroll
                    for (int j = 0; j < 4; ++j) { g0[j] = sigmoidf_(g0[j]); g1[j] = sigmoidf_(g1[j]); }
                    *(u32x4*)(MM + (size_t)r * DM + c) = pack8(p0 + g0 * acc[ai][bj][m][0], p1 + g1 * acc[ai][bj][m][1]); } }
    }
};
struct EpiOutP {
    static constexpr bool PERM = true;
    bf16_t* C; float* P;
    __device__ __forceinline__ void operator()(AccRef acc, const Unit& u, int wr, int wc, int fr, int fq) const {
        const int row0 = u.pm * 256 + wr * 64 + fr, col0 = u.pn * 256 + wc * 32 + 8 * fq;
#pragma unroll
        for (int ai = 0; ai < 2; ++ai)
#pragma unroll
            for (int m = 0; m < 4; ++m) { const int r = row0 + ai * 128 + m * 16;
#pragma unroll
                for (int bj = 0; bj < 2; ++bj) { const int c = col0 + bj * 128;
                    if (u.sp < 0) *(u32x4*)(C + (size_t)r * DM + c) = pack8(acc[ai][bj][m][0], acc[ai][bj][m][1]);
                    else { float* pp = P + ((size_t)u.sp * 512 + (r - MP)) * DM + c; *(f32x4*)pp = acc[ai][bj][m][0]; *(f32x4*)(pp + 4) = acc[ai][bj][m][1]; } } }
    }
};
struct EpiGate7 {
    static constexpr bool PERM = true;
    bf16_t* G; float* out;
    __device__ __forceinline__ void operator()(AccRef acc, const Unit& u, int wr, int wc, int fr, int fq) const {
        const int row0 = u.pm * 256 + wr * 64 + fr, col0 = u.pn * 256 + wc * 32 + 8 * fq;
#pragma unroll
        for (int ai = 0; ai < 2; ++ai)
#pragma unroll
            for (int m = 0; m < 4; ++m) { bf16_t* rowp = G + (size_t)(row0 + ai * 128 + m * 16) * DFF + col0;
#pragma unroll
                for (int bj = 0; bj < 2; ++bj) *(u32x4*)(rowp + bj * 128) = pack8(acc[ai][bj][m][0], acc[ai][bj][m][1]); }
        const bool special = (u.pm >= 32) || ((u.pm & 7) == 7);
        if (special) {
#pragma unroll
            for (int ai = 0; ai < 2; ++ai)
#pragma unroll
                for (int m = 0; m < 4; ++m) {
                    const int r = row0 + ai * 128 + m * 16; const bool smp = r >= MP; const int b = smp ? (r - MP) >> 2 : r >> 11, t = smp ? (r - MP) & 3 : r & 2047;
                    const int j = smp ? t - 2 : t - 2046;
                    if (j >= 0) {
#pragma unroll
                        for (int bj = 0; bj < 2; ++bj) { float* dst = out + (smp ? O_SCONV : O_PCONV) + ((size_t)b * 2 + j) * DFF + col0 + bj * 128;
                            *(f32x4*)dst = acc[ai][bj][m][0]; *(f32x4*)(dst + 4) = acc[ai][bj][m][1]; } } }
        }
    }
};
struct EpiAct {
    static constexpr bool PERM = true;
    const bf16_t* G; bf16_t* ACT; const float* cw; const float* cb; const float* conv0;
    __device__ __forceinline__ void operator()(AccRef acc, const Unit& u, int wr, int wc, int fr, int fq) const {
        const int row0 = u.pm * 256 + wr * 64 + fr, col0 = u.pn * 256 + wc * 32 + 8 * fq;
        const bool smp_tile = u.pm >= 32;
#pragma unroll
        for (int bj = 0; bj < 2; ++bj) { const int c = col0 + bj * 128;
            const f32x4 w0a = *(const f32x4*)(cw + c), w0b = *(const f32x4*)(cw + c + 4), w1a = *(const f32x4*)(cw + DFF + c), w1b = *(const f32x4*)(cw + DFF + c + 4);
            const f32x4 w2a = *(const f32x4*)(cw + 2 * DFF + c), w2b = *(const f32x4*)(cw + 2 * DFF + c + 4), cba = *(const f32x4*)(cb + c), cbb = *(const f32x4*)(cb + c + 4);
#pragma unroll
            for (int ai = 0; ai < 2; ++ai) {
                u32x4 q2[4], q1[4], q0[4];
#pragma unroll
                for (int m = 0; m < 4; ++m) { const unsigned off = (unsigned)((row0 + ai * 128 + m * 16) * DFF + c) * 2u;
                    q2[m] = *(const u32x4*)((const char*)G + off);
                    u32x4 e1 = (u32x4){0u, 0u, 0u, 0u}, e0 = e1;
                    if (fr < 1) e1 = *(const u32x4*)((const char*)(G - DFF) + off);
                    if (fr < 2) e0 = *(const u32x4*)((const char*)(G - 2 * DFF) + off);
                    q1[m] = e1; q0[m] = e0; }
#pragma unroll
                for (int m = 0; m < 4; ++m) {
#pragma unroll
                    for (int wd = 0; wd < 4; ++wd) { q1[m][wd] = __builtin_amdgcn_update_dpp(q1[m][wd], q2[m][wd], 0x111, 0xF, 0xF, false);
                                                     q0[m][wd] = __builtin_amdgcn_update_dpp(q0[m][wd], q2[m][wd], 0x112, 0xF, 0xF, false); } }
#pragma unroll
                for (int m = 0; m < 4; ++m) {
                    const int r = row0 + ai * 128 + m * 16; const bool smp = r >= MP; const int b = smp ? (r - MP) >> 2 : r >> 11, t = smp ? (r - MP) & 3 : r & 2047;
                    f32x4 x2a, x2b, x1a, x1b, x0a, x0b;
                    unpack8(q2[m], x2a, x2b); unpack8(q1[m], x1a, x1b); unpack8(q0[m], x0a, x0b);
                    if (t < 1) { x1a = (f32x4){0.f, 0.f, 0.f, 0.f}; x1b = x1a; }
                    if (t < 2) { x0a = (f32x4){0.f, 0.f, 0.f, 0.f}; x0b = x0a; }
                    if (smp_tile) {
                        if (t < 1) { x1a = *(const f32x4*)(conv0 + ((size_t)b * 2 + 1) * DFF + c); x1b = *(const f32x4*)(conv0 + ((size_t)b * 2 + 1) * DFF + c + 4); }
                        if (t < 2) { x0a = *(const f32x4*)(conv0 + ((size_t)b * 2 + t) * DFF + c); x0b = *(const f32x4*)(conv0 + ((size_t)b * 2 + t) * DFF + c + 4); }
                    }
                    f32x4 ca = cba + w0a * x0a + w1a * x1a + w2a * x2a, cbv = cbb + w0b * x0b + w1b * x1b + w2b * x2b;
#pragma unroll
                    for (int j = 0; j < 4; ++j) { ca[j] = gelu_tanh(ca[j]); cbv[j] = gelu_tanh(cbv[j]); }
                    *(u32x4*)(ACT + (size_t)r * DFF + c) = pack8(ca * acc[ai][bj][m][0], cbv * acc[ai][bj][m][1]); }
            }
        }
    }
};

constexpr int TP = 136;
template <class Map>
__device__ __forceinline__ void transpose_job(const float* src, int ldsrc, int Ksrc, bf16_t* dst, int Kd, int Nd, Map map, float* tilef, int bid, int nblk) {
    int tid = threadIdx.x; asm volatile("" : "+v"(tid));
    LAS unsigned char* tile = (LAS unsigned char*)tilef;
    const int ntk = Kd / 128, ntn = Nd / 128, ntot = ntk * ntn;
    const int n4 = tid & 31, kp0 = tid >> 5;
    const int rn = tid >> 2, rq = tid & 3;
    f32x4 va[4], vb[4];
    auto load = [&](int ti) {
        const int tn = ti / ntk, tk = ti - tn * ntk; const int sc = map(tn * 128 + n4 * 4);
#pragma unroll
        for (int i = 0; i < 4; ++i) { const int k = tk * 128 + 2 * (kp0 + 16 * i);
            va[i] = (sc >= 0 && k < Ksrc) ? *(const f32x4*)(src + (size_t)k * ldsrc + sc) : (f32x4){0.f, 0.f, 0.f, 0.f};
            vb[i] = (sc >= 0 && k + 1 < Ksrc) ? *(const f32x4*)(src + (size_t)(k + 1) * ldsrc + sc) : (f32x4){0.f, 0.f, 0.f, 0.f}; }
    };
    int ti = bid;
    if (ti < ntot) load(ti);
    for (; ti < ntot; ti += nblk) {
        const int tn = ti / ntk, tk = ti - tn * ntk;
#pragma unroll
        for (int i = 0; i < 4; ++i) { const int kp = kp0 + 16 * i;
#pragma unroll
            for (int j = 0; j < 4; ++j) *(LAS unsigned*)(tile + ((n4 * 4 + j) * TP + 2 * kp) * 2) = cvt_pk_bf16(va[i][j], vb[i][j]); }
        __syncthreads();
        if (ti + nblk < ntot) load(ti + nblk);
        bf16_t* drow = dst + (size_t)(tn * 128 + rn) * Kd + tk * 128 + rq * 32;
#pragma unroll
        for (int i = 0; i < 4; ++i) *(u32x4*)(drow + i * 8) = *(const LAS u32x4*)(tile + (rn * TP + rq * 32 + i * 8) * 2);
        __syncthreads();
    }
}
struct MapId { __device__ int operator()(int n) const { return n; } };
struct MapWin { __device__ int operator()(int n) const { return n < DSH ? n : (n < ZC_P ? -1 : n - (ZC_P - DSH)); } };

__device__ __forceinline__ float z_shift(KArgP p, const bf16_t* Z, int r, int zc) {
    const float z = bf2f(Z[(size_t)r * ZLD + zc]);
    const bool smp = r >= MP; const int t = smp ? (r - MP) & 3 : r & 2047;
    float pv;
    if (t > 0) pv = bf2f(Z[(size_t)(r - 1) * ZLD + zc]); else pv = smp ? p->in[2][(size_t)((r - MP) >> 2) * DSH + zc] : 0.f;
    return z + (pv - z) * p->in[8][zc];
}

struct HeadConst { float mu_r, mu_k, mu_v, k_k, k_a, r_k; };
__device__ __forceinline__ void stage_token(float zr, float zk, float zv, float pr, float pk, float pv, float xw, float a, float g, const HeadConst& hc, float* o, float* bon, int lane) {
    const float r = zr + (pr - zr) * hc.mu_r, k = zk + (pk - zk) * hc.mu_k, v = zv + (pv - zv) * hc.mu_v;
    const float y = -xw;
    const float sp = fmaxf(y, 0.f) + __logf(1.0f + __expf(-fabsf(y)));
    const float dec = __expf(-__expf(-sp - 0.5f));
    const float kr = k * hc.k_k; const float n2 = wave_sum(kr * kr); const float kk = kr * rsqrtf(fmaxf(n2, 1e-24f));
    const float kp = k * (1.0f + (a - 1.0f) * hc.k_a);
    const float bs = wave_sum(r * kp * hc.r_k);
    o[0 * 64 + lane] = dec; o[1 * 64 + lane] = kk; o[2 * 64 + lane] = kk * a; o[3 * 64 + lane] = kp; o[4 * 64 + lane] = r; o[5 * 64 + lane] = v; o[6 * 64 + lane] = g;
    if (lane == 0) *bon = bs;
}

constexpr int ST = 72;
constexpr int L_AT = 0, L_BT = 9216, L_KT = 18432, L_RT = 27648, L_ATT = 36864, L_VMT = 46080, L_BGT = 55296, L_KGT = 64512,
              L_LOFF = 73728, L_LAK = 82944, L_MRB = 92160, L_MRK = 101376, L_LDIAG = 110592, L_CUM = 114688;
constexpr int L_TBD = L_CUM, L_SOLT = L_BT;
constexpr size_t SC_PF = 0, SC_QF = (size_t)2048 * 8192, SC_W2F = (size_t)2 * 2048 * 8192, SC_YLF = (size_t)3 * 2048 * 8192, SC_GAM = (size_t)4 * 2048 * 8192, SC_BON = SC_GAM + (size_t)2048 * 256;

__device__ __forceinline__ bf16x8 frag(LAS unsigned char* lds, int off, int row0, int ks, int lane) {
    return *(const LAS bf16x8*)(lds + off + ((row0 + (lane & 15)) * ST + ks * 32 + (lane >> 4) * 8) * 2);
}
__device__ __forceinline__ void st4(LAS unsigned char* lds, int off, int row, int col, f32x4 v) {
    u32x2 w; w.x = cvt_pk_bf16(v[0], v[1]); w.y = cvt_pk_bf16(v[2], v[3]); *(LAS u32x2*)(lds + off + (row * ST + col) * 2) = w;
}
__device__ __forceinline__ f32x4 ld4(LAS unsigned char* lds, int off, int row, int col) {
    const u32x2 w = *(const LAS u32x2*)(lds + off + (row * ST + col) * 2); return (f32x4){lo_bf(w.x), hi_bf(w.x), lo_bf(w.y), hi_bf(w.y)};
}
#define MFMA16(x, y, acc) __builtin_amdgcn_mfma_f32_16x16x32_bf16((x), (y), (acc), 0, 0, 0)
#define LDS_FENCE() asm volatile("s_waitcnt lgkmcnt(0)" ::: "memory")

__device__ __forceinline__ void wkv_pass_a(KArgP p, int cu, LAS unsigned char* lds) {
    int tid = threadIdx.x; asm volatile("" : "+v"(tid));
    const int w = __builtin_amdgcn_readfirstlane(tid >> 6), lane = tid & 63, q = lane >> 4, l15 = lane & 15;
    const int bh = cu >> 5, c = cu & 31, b = bh >> 4, h = bh & 15, ch = h * 64 + lane;
    const bf16_t* Z = (const bf16_t*)(p->ws + W_Z); const bf16_t* XW = (const bf16_t*)(p->ws + W_XW); const bf16_t* XA = (const bf16_t*)(p->ws + W_XA);
    unsigned char* sc = p->ws + W_RA;
    const int row0 = b * 2048 + c * 64 + w * 8;
    float kk[8], bb[8], kp[8], rr[8], vv[8], ld[8];
    {
        const float mu_r = p->in[8][ch], mu_k = p->in[8][1024 + ch], mu_v = p->in[8][2048 + ch], k_k = p->in[14][ch], k_a = p->in[15][ch], r_k = p->in[16][ch];
        float pz[3];
        const bool first = (c == 0 && w == 0);
#pragma unroll
        for (int qq = 0; qq < 3; ++qq) pz[qq] = first ? 0.f : bf2f(Z[(size_t)(row0 - 1) * ZLD + qq * 1024 + ch]);
        float bon[8];
#pragma unroll
        for (int i = 0; i < 8; ++i) {
            float z[3];
#pragma unroll
            for (int qq = 0; qq < 3; ++qq) z[qq] = bf2f(Z[(size_t)(row0 + i) * ZLD + qq * 1024 + ch]);
            const float xw = bf2f(XW[(size_t)(row0 + i) * 1024 + ch]), a = bf2f(XA[(size_t)(row0 + i) * 1024 + ch]);
            const float r = z[0] + (pz[0] - z[0]) * mu_r, k = z[1] + (pz[1] - z[1]) * mu_k, v = z[2] + (pz[2] - z[2]) * mu_v;
#pragma unroll
            for (int qq = 0; qq < 3; ++qq) pz[qq] = z[qq];
            const float y = -xw; const float sp = fmaxf(y, 0.f) + __logf(1.0f + __expf(-fabsf(y)));
            ld[i] = -__expf(-sp - 0.5f);
            const float kr = k * k_k; const float n2 = wave_sum(kr * kr); kk[i] = kr * rsqrtf(fmaxf(n2, 1e-24f));
            kp[i] = k * (1.0f + (a - 1.0f) * k_a); bb[i] = kk[i] * a; rr[i] = r; vv[i] = v;
            bon[i] = wave_sum(r * kp[i] * r_k);
            *(LAS float*)(lds + L_CUM + ((w * 8 + i) * 64 + lane) * 4) = ld[i];
        }
        if (lane < 8) { float bv = bon[0];
#pragma unroll
            for (int i = 1; i < 8; ++i) bv = (lane == i) ? bon[i] : bv;
            *(float*)(sc + SC_BON + (size_t)cu * 256 + (w * 8 + lane) * 4) = bv; }
    }
    __syncthreads();
    float cum[8], cumC;
    {
        float acc = 0.f;
#pragma unroll
        for (int seg = 0; seg < 8; ++seg) {
#pragma unroll
            for (int i = 0; i < 8; ++i) { acc += *(const LAS float*)(lds + L_CUM + ((seg * 8 + i) * 64 + lane) * 4); if (seg == w) cum[i] = acc; }
        }
        cumC = acc;
    }
    if (w == 0) *(float*)(sc + SC_GAM + (size_t)cu * 256 + lane * 4) = __expf(cumC);
    {
        float att[8], bgt[8], kgt[8];
#pragma unroll
        for (int i = 0; i < 8; ++i) {
            const int t = w * 8 + i; const float ep = __expf(cum[i]), em = __expf(-cum[i]), eg = __expf(cumC - cum[i]);
            att[i] = -kk[i] * __expf(cum[i] - ld[i]); bgt[i] = bb[i] * eg; kgt[i] = kp[i] * eg;
            *(LAS bf16_t*)(lds + L_AT + (t * ST + lane) * 2) = f2bf(att[i]);
            *(LAS bf16_t*)(lds + L_RT + (t * ST + lane) * 2) = f2bf(rr[i] * ep);
            *(LAS bf16_t*)(lds + L_BT + (t * ST + lane) * 2) = f2bf(bb[i] * em);
            *(LAS bf16_t*)(lds + L_KT + (t * ST + lane) * 2) = f2bf(kp[i] * em);
        }
        u32x4 x;
        x.x = cvt_pk_bf16(att[0], att[1]); x.y = cvt_pk_bf16(att[2], att[3]); x.z = cvt_pk_bf16(att[4], att[5]); x.w = cvt_pk_bf16(att[6], att[7]); *(LAS u32x4*)(lds + L_ATT + (lane * ST + w * 8) * 2) = x;
        x.x = cvt_pk_bf16(vv[0], vv[1]); x.y = cvt_pk_bf16(vv[2], vv[3]); x.z = cvt_pk_bf16(vv[4], vv[5]); x.w = cvt_pk_bf16(vv[6], vv[7]); *(LAS u32x4*)(lds + L_VMT + (lane * ST + w * 8) * 2) = x;
        x.x = cvt_pk_bf16(bgt[0], bgt[1]); x.y = cvt_pk_bf16(bgt[2], bgt[3]); x.z = cvt_pk_bf16(bgt[4], bgt[5]); x.w = cvt_pk_bf16(bgt[6], bgt[7]); *(LAS u32x4*)(lds + L_BGT + (lane * ST + w * 8) * 2) = x;
        x.x = cvt_pk_bf16(kgt[0], kgt[1]); x.y = cvt_pk_bf16(kgt[2], kgt[3]); x.z = cvt_pk_bf16(kgt[4], kgt[5]); x.w = cvt_pk_bf16(kgt[6], kgt[7]); *(LAS u32x4*)(lds + L_KGT + (lane * ST + w * 8) * 2) = x;
    }
    __syncthreads();
    for (int i = tid; i < 9216 / 16; i += NTHR) *(LAS u32x4*)(lds + L_TBD + i * 16) = (u32x4){0u, 0u, 0u, 0u};
    {
        const int jt = w & 3, isR = w >> 2; const int yoff = isR ? L_RT : L_AT;
        const bf16x8 y0 = frag(lds, yoff, 16 * jt, 0, lane), y1 = frag(lds, yoff, 16 * jt, 1, lane);
        const int t = 16 * jt + l15;
#pragma unroll
        for (int xt = 0; xt < 8; ++xt) {
            const int isK = xt >> 2, it = xt & 3; const int xoff = isK ? L_KT : L_BT;
            f32x4 acc = (f32x4){0.f, 0.f, 0.f, 0.f};
            if (it <= jt) { acc = MFMA16(frag(lds, xoff, 16 * it, 0, lane), y0, acc); acc = MFMA16(frag(lds, xoff, 16 * it, 1, lane), y1, acc); }
#pragma unroll
            for (int i = 0; i < 4; ++i) { const int s = 16 * it + 4 * q + i; const bool keep = isR ? (s <= t) : (s < t); acc[i] = keep ? acc[i] : 0.f; }
            const int dst = isR ? (isK ? L_MRK : L_MRB) : (isK ? L_LAK : L_LOFF);
            if (!isR && !isK && it == jt) { *(LAS f32x4*)(lds + L_LDIAG + ((jt * 16 + l15) * 16 + 4 * q) * 4) = acc; acc = (f32x4){0.f, 0.f, 0.f, 0.f}; }
            st4(lds, dst, t, 16 * it + 4 * q, acc);
        }
    }
    __syncthreads();
    f32x4 xacc[4];
#pragma unroll
    for (int i = 0; i < 4; ++i) xacc[i] = (f32x4){0.f, 0.f, 0.f, 0.f};
    if (w == 0) {
        const int blk = q, j = l15; float tc[16];
#pragma unroll
        for (int t = 0; t < 16; ++t) {
            float acc = (t == j) ? 1.0f : 0.0f;
            f32x4 lr[4];
#pragma unroll
            for (int g = 0; g < 4; ++g) lr[g] = *(const LAS f32x4*)(lds + L_LDIAG + ((blk * 16 + t) * 16 + g * 4) * 4);
#pragma unroll
            for (int s = 0; s < t; ++s) acc += lr[s >> 2][s & 3] * tc[s];
            tc[t] = acc;
            *(LAS bf16_t*)(lds + L_TBD + ((16 * blk + t) * ST + 16 * blk + j) * 2) = f2bf(acc);
        }
    } else if (w >= 4) {
        const int vt = w - 4;
#pragma unroll
        for (int i = 0; i < 4; ++i)
#pragma unroll
            for (int ks = 0; ks < 2; ++ks) xacc[i] = MFMA16(frag(lds, L_LAK, 16 * i, ks, lane), frag(lds, L_VMT, 16 * vt, ks, lane), xacc[i]);
    }
    __syncthreads();
    {
        const int crow = 16 * w + l15;
#pragma unroll
        for (int i = 0; i < 4; ++i) {
            f32x4 acc = (w < 4) ? ld4(lds, L_ATT, crow, 16 * i + 4 * q) : xacc[i];
#pragma unroll
            for (int ks = 0; ks < 2; ++ks) acc = MFMA16(frag(lds, L_LOFF, 16 * i, ks, lane), frag(lds, L_SOLT, 16 * w, ks, lane), acc);
            st4(lds, L_SOLT, crow, 16 * i + 4 * q, acc);
            LDS_FENCE();
            f32x4 acc2 = (f32x4){0.f, 0.f, 0.f, 0.f};
#pragma unroll
            for (int ks = 0; ks < 2; ++ks) acc2 = MFMA16(frag(lds, L_TBD, 16 * i, ks, lane), frag(lds, L_SOLT, 16 * w, ks, lane), acc2);
            st4(lds, L_SOLT, crow, 16 * i + 4 * q, acc2);
            LDS_FENCE();
        }
    }
    __syncthreads();
    {
        const int a = w >> 1, pr = w & 1;
        { f32x4 acc[2];
#pragma unroll
            for (int u = 0; u < 2; ++u) { const int kt = 2 * pr + u; acc[u] = ld4(lds, L_RT, 16 * a + l15, 16 * kt + 4 * q);
#pragma unroll
                for (int ks = 0; ks < 2; ++ks) acc[u] = MFMA16(frag(lds, L_SOLT, 16 * kt, ks, lane), frag(lds, L_MRB, 16 * a, ks, lane), acc[u]); }
            *(u32x4*)(sc + SC_W2F + (size_t)cu * 8192 + ((a * 2 + pr) * 64 + lane) * 16) = pack8(acc[0], acc[1]); }
#pragma unroll
        for (int u = 0; u < 2; ++u) { const int vt = 2 * pr + u; f32x4 acc = (f32x4){0.f, 0.f, 0.f, 0.f};
#pragma unroll
            for (int ks = 0; ks < 2; ++ks) { acc = MFMA16(frag(lds, L_SOLT, 64 + 16 * vt, ks, lane), frag(lds, L_MRB, 16 * a, ks, lane), acc); acc = MFMA16(frag(lds, L_VMT, 16 * vt, ks, lane), frag(lds, L_MRK, 16 * a, ks, lane), acc); }
            u32x2 o; o.x = cvt_pk_bf16(acc[0], acc[1]); o.y = cvt_pk_bf16(acc[2], acc[3]);
            *(u32x2*)(sc + SC_YLF + (size_t)cu * 8192 + ((vt * 4 + a) * 64 + lane) * 8) = o; }
        { f32x4 acc[2];
#pragma unroll
            for (int u = 0; u < 2; ++u) { const int kt = 2 * pr + u; acc[u] = (f32x4){0.f, 0.f, 0.f, 0.f};
#pragma unroll
                for (int ks = 0; ks < 2; ++ks) acc[u] = MFMA16(frag(lds, L_SOLT, 16 * kt, ks, lane), frag(lds, L_BGT, 16 * a, ks, lane), acc[u]); }
            *(u32x4*)(sc + SC_PF + (size_t)cu * 8192 + ((a * 2 + pr) * 64 + lane) * 16) = pack8(acc[0], acc[1]); }
#pragma unroll
        for (int u = 0; u < 2; ++u) { const int vt = 2 * pr + u; f32x4 acc = (f32x4){0.f, 0.f, 0.f, 0.f};
#pragma unroll
            for (int ks = 0; ks < 2; ++ks) { acc = MFMA16(frag(lds, L_BGT, 16 * a, ks, lane), frag(lds, L_SOLT, 64 + 16 * vt, ks, lane), acc); acc = MFMA16(frag(lds, L_KGT, 16 * a, ks, lane), frag(lds, L_VMT, 16 * vt, ks, lane), acc); }
            u32x2 o; o.x = cvt_pk_bf16(acc[0], acc[1]); o.y = cvt_pk_bf16(acc[2], acc[3]);
            *(u32x2*)(sc + SC_QF + (size_t)cu * 8192 + ((a * 4 + vt) * 64 + lane) * 8) = o; }
    }
    __syncthreads();
}

__device__ __forceinline__ void wkv_pass_b(KArgP p, int task, int lane) {
    const int bh = task >> 2, vs = task & 3, q = lane >> 4, l15 = lane & 15;
    const unsigned char* sc = p->ws + W_RA; unsigned char* sf = p->ws + W_SF;
    f32x4 S[4];
#pragma unroll
    for (int m = 0; m < 4; ++m) S[m] = (f32x4){0.f, 0.f, 0.f, 0.f};
    for (int c = 0; c < 32; ++c) {
        const int cu = bh * 32 + c;
        u32x4 pf[4][2]; u32x2 qf[4]; f32x4 gm[4];
#pragma unroll
        for (int m = 0; m < 4; ++m) {
#pragma unroll
            for (int ks = 0; ks < 2; ++ks) pf[m][ks] = *(const u32x4*)(sc + SC_PF + (size_t)cu * 8192 + ((m * 2 + ks) * 64 + lane) * 16);
            qf[m] = *(const u32x2*)(sc + SC_QF + (size_t)cu * 8192 + ((m * 4 + vs) * 64 + lane) * 8);
            gm[m] = *(const f32x4*)(sc + SC_GAM + (size_t)cu * 256 + (16 * m + 4 * q) * 4);
        }
        u32x4 sfr[2];
#pragma unroll
        for (int ks = 0; ks < 2; ++ks) { sfr[ks] = pack8(S[2 * ks], S[2 * ks + 1]); *(u32x4*)(sf + (size_t)cu * 8192 + ((vs * 2 + ks) * 64 + lane) * 16) = sfr[ks]; }
#pragma unroll
        for (int m = 0; m < 4; ++m) {
            f32x4 acc = S[m] * gm[m] + (f32x4){lo_bf(qf[m].x), hi_bf(qf[m].x), lo_bf(qf[m].y), hi_bf(qf[m].y)};
#pragma unroll
            for (int ks = 0; ks < 2; ++ks) { bf16x8 av, bv; __builtin_memcpy(&av, &pf[m][ks], 16); __builtin_memcpy(&bv, &sfr[ks], 16); acc = MFMA16(av, bv, acc); }
            S[m] = acc;
        }
    }
#pragma unroll
    for (int m = 0; m < 4; ++m) *(f32x4*)(p->out + O_PWKV + ((size_t)bh * 64 + 16 * vs + l15) * 64 + 16 * m + 4 * q) = S[m];
}

__device__ __forceinline__ void wkv_pass_c(KArgP p, int cu, int jt, int lane) {
    const int bh = cu >> 5, c = cu & 31, b = bh >> 4, h = bh & 15, q = lane >> 4, l15 = lane & 15;
    const unsigned char* sc = p->ws + W_RA; const unsigned char* sf = p->ws + W_SF;
    const bf16_t* Z = (const bf16_t*)(p->ws + W_Z); const bf16_t* GG = (const bf16_t*)(p->ws + W_GG); bf16_t* YA = (bf16_t*)(p->ws + W_DYA);
    const int t = c * 64 + 16 * jt + l15; const int row = b * 2048 + t;
    bf16x8 w2[2], sfr[4][2]; u32x2 yl[4], zc[4], zp[4], gz[4];
#pragma unroll
    for (int ks = 0; ks < 2; ++ks) w2[ks] = *(const bf16x8*)(sc + SC_W2F + (size_t)cu * 8192 + ((jt * 2 + ks) * 64 + lane) * 16);
#pragma unroll
    for (int vt = 0; vt < 4; ++vt) { const int chv = h * 64 + 16 * vt + 4 * q;
        yl[vt] = *(const u32x2*)(sc + SC_YLF + (size_t)cu * 8192 + ((vt * 4 + jt) * 64 + lane) * 8);
#pragma unroll
        for (int ks = 0; ks < 2; ++ks) sfr[vt][ks] = *(const bf16x8*)(sf + (size_t)cu * 8192 + ((vt * 2 + ks) * 64 + lane) * 16);
        zc[vt] = *(const u32x2*)(Z + (size_t)row * ZLD + 2048 + chv);
        zp[vt] = (t > 0) ? *(const u32x2*)(Z + (size_t)(row - 1) * ZLD + 2048 + chv) : (u32x2){0u, 0u};
        gz[vt] = *(const u32x2*)(GG + (size_t)row * 1024 + chv); }
    const float bon = *(const float*)(sc + SC_BON + (size_t)cu * 256 + (16 * jt + l15) * 4);
    f32x4 y[4]; float s1 = 0.f;
#pragma unroll
    for (int vt = 0; vt < 4; ++vt) {
        f32x4 acc = (f32x4){lo_bf(yl[vt].x), hi_bf(yl[vt].x), lo_bf(yl[vt].y), hi_bf(yl[vt].y)};
#pragma unroll
        for (int ks = 0; ks < 2; ++ks) acc = MFMA16(sfr[vt][ks], w2[ks], acc);
        y[vt] = acc; s1 += (acc[0] + acc[1]) + (acc[2] + acc[3]);
    }
    s1 = xor32_sum(xor16_sum(s1)); const float mu = s1 * (1.0f / 64.0f);
    float s2 = 0.f;
#pragma unroll
    for (int vt = 0; vt < 4; ++vt) { y[vt] -= mu; s2 += (y[vt][0] * y[vt][0] + y[vt][1] * y[vt][1]) + (y[vt][2] * y[vt][2] + y[vt][3] * y[vt][3]); }
    s2 = xor32_sum(xor16_sum(s2)); const float rstd = rsqrtf(s2 * (1.0f / 64.0f) + GN_EPS);
#pragma unroll
    for (int vt = 0; vt < 4; ++vt) {
        const int chv = h * 64 + 16 * vt + 4 * q;
        const f32x4 zv = (f32x4){lo_bf(zc[vt].x), hi_bf(zc[vt].x), lo_bf(zc[vt].y), hi_bf(zc[vt].y)}, pv = (f32x4){lo_bf(zp[vt].x), hi_bf(zp[vt].x), lo_bf(zp[vt].y), hi_bf(zp[vt].y)};
        const f32x4 muv = *(const f32x4*)(p->in[8] + 2048 + chv); const f32x4 vm = zv + (pv - zv) * muv;
        const f32x4 g = (f32x4){lo_bf(gz[vt].x), hi_bf(gz[vt].x), lo_bf(gz[vt].y), hi_bf(gz[vt].y)};
        const f32x4 lw = *(const f32x4*)(p->in[17] + chv), lb = *(const f32x4*)(p->in[18] + chv);
        const f32x4 o = ((y[vt] * rstd) * lw + lb + bon * vm) * g;
        u32x2 ow; ow.x = cvt_pk_bf16(o[0], o[1]); ow.y = cvt_pk_bf16(o[2], o[3]);
        *(u32x2*)(YA + (size_t)row * 1024 + chv) = ow;
    }
}

__device__ __forceinline__ void scan_sample(KArgP p, int unit, float* lds) {
    int tid = threadIdx.x; asm volatile("" : "+v"(tid));
    const int wave = tid >> 6, lane = tid & 63, b = unit >> 4, h = unit & 15, ch = h * 64 + lane;
    const bf16_t* Z = (const bf16_t*)(p->ws + W_Z); const bf16_t* XW = (const bf16_t*)(p->ws + W_XW); const bf16_t* XA = (const bf16_t*)(p->ws + W_XA); const bf16_t* GG = (const bf16_t*)(p->ws + W_GG);
    bf16_t* YA = (bf16_t*)(p->ws + W_DYA);
    float* ops = lds + wave * (4 * 7 * 64 + 64);
    float* bon = ops + 4 * 7 * 64;
    HeadConst hc; hc.mu_r = p->in[8][ch]; hc.mu_k = p->in[8][1024 + ch]; hc.mu_v = p->in[8][2048 + ch]; hc.k_k = p->in[14][ch]; hc.k_a = p->in[15][ch]; hc.r_k = p->in[16][ch];
    const float lw = p->in[17][ch], lb = p->in[18][ch];
    const int rbase = MP + b * 4;
    float pz[3];
#pragma unroll
    for (int q = 0; q < 3; ++q) pz[q] = p->in[2][(size_t)b * DSH + q * 1024 + ch];
#pragma unroll
    for (int t = 0; t < 4; ++t) {
        float z[3];
#pragma unroll
        for (int q = 0; q < 3; ++q) z[q] = bf2f(Z[(size_t)(rbase + t) * ZLD + q * 1024 + ch]);
        const size_t ro = (size_t)(rbase + t) * 1024 + ch;
        stage_token(z[0], z[1], z[2], pz[0], pz[1], pz[2], bf2f(XW[ro]), bf2f(XA[ro]), bf2f(GG[ro]), hc, ops + t * 7 * 64, bon + t, lane);
#pragma unroll
        for (int q = 0; q < 3; ++q) pz[q] = z[q];
    }
    f32x4 S[16];
    const float* s0 = p->in[3] + ((size_t)unit * 64 + lane) * 64;
#pragma unroll
    for (int j = 0; j < 16; ++j) S[j] = *(const f32x4*)(s0 + j * 4);
    __syncthreads();
#pragma nounroll
    for (int t = 0; t < 4; ++t) {
        const float* o = ops + t * 7 * 64;
        f32x4 a4 = (f32x4){0.f, 0.f, 0.f, 0.f};
#pragma unroll
        for (int j = 0; j < 16; ++j) { a4 += S[j] * *(const f32x4*)(o + 64 + j * 4); if ((j & 3) == 3) asm volatile("" ::: "memory"); }
        const float sa = -((a4[0] + a4[1]) + (a4[2] + a4[3]));
        const float vv = o[320 + lane];
        f32x4 y4 = (f32x4){0.f, 0.f, 0.f, 0.f};
#pragma unroll
        for (int j = 0; j < 16; ++j) { S[j] = S[j] * *(const f32x4*)(o + j * 4) + (sa * *(const f32x4*)(o + 128 + j * 4) + vv * *(const f32x4*)(o + 192 + j * 4)); y4 += S[j] * *(const f32x4*)(o + 256 + j * 4); if ((j & 1) == 1) asm volatile("" ::: "memory"); }
        const float y = (y4[0] + y4[1]) + (y4[2] + y4[3]);
        const float mu = wave_sum(y) * (1.0f / 64.0f); const float d = y - mu; const float var = wave_sum(d * d) * (1.0f / 64.0f);
        const float yn = d * rsqrtf(var + GN_EPS) * lw + lb;
        YA[(size_t)(rbase + t) * 1024 + ch] = f2bf((yn + bon[t] * vv) * o[384 + lane]);
    }
    float* so = p->out + O_SWKV + ((size_t)unit * 64 + lane) * 64;
#pragma unroll
    for (int j = 0; j < 16; ++j) *(f32x4*)(so + j * 4) = S[j];
    __syncthreads();
}

__device__ __forceinline__ void row_load_bf(f32x4 (&o)[8], const bf16_t* C, int row, int lane) {
#pragma unroll
    for (int i = 0; i < 8; ++i) { const u32x2 w = *(const u32x2*)(C + (size_t)row * DM + i * 256 + lane * 4); o[i] = (f32x4){lo_bf(w.x), hi_bf(w.x), lo_bf(w.y), hi_bf(w.y)}; }
}
template <int S>
__device__ __forceinline__ f32x4 part_sum(const float* P, int srow, int c) {
    f32x4 a = *(const f32x4*)(P + (size_t)srow * DM + c);
#pragma unroll
    for (int sp = 1; sp < S; ++sp) a += *(const f32x4*)(P + ((size_t)sp * 512 + srow) * DM + c);
    return a;
}
__device__ __forceinline__ float sumsq8(const f32x4 (&v)[8]) { float s = 0.f;
#pragma unroll
    for (int i = 0; i < 8; ++i) s += (v[i][0] * v[i][0] + v[i][1] * v[i][1]) + (v[i][2] * v[i][2] + v[i][3] * v[i][3]);
    return s; }

__global__ void __launch_bounds__(NTHR, 2) fwd_megakernel(Params p_unused) {
    extern __shared__ __attribute__((aligned(16))) unsigned char lds_raw[];
    cg::grid_group grid = cg::this_grid();
    LAS unsigned char* lds = (LAS unsigned char*)lds_raw;
    float* ldsf = (float*)lds_raw;
    const int bid = blockIdx.x, nblk = gridDim.x;
    __shared__ uint4 xb_words;
    if (threadIdx.x == 0) xb_words = make_uint4(0u, 0u, 0u, 0u);
    __syncthreads();
    if (kargs()->ws == nullptr) grid.sync();
    const XcdBarrier xbar = xcd_barrier_post((unsigned*)(kargs()->ws + W_BAR), (volatile LAS unsigned*)&xb_words);
#define PHASE_BEGIN() KArgP p = kargs(); int tid = threadIdx.x; asm volatile("" : "+v"(tid)); const int wave = tid >> 6, lane = tid & 63; (void)wave; (void)lane; \
    unsigned char* ws = p->ws; bf16_t* Z = (bf16_t*)(ws + W_Z); float* ssq = (float*)(ws + W_SSQ); float* Y = p->out + O_Y; (void)Z; (void)ssq; (void)Y;

    {
        PHASE_BEGIN();
    transpose_job(p->in[7], 8480, 2048, (bf16_t*)(ws + W_IN), 2048, 8704, MapWin(), ldsf, bid, nblk);
    {
        bf16_t* H = (bf16_t*)(ws + W_H); const float* gw = p->in[6];
        for (int row = bid * 8 + wave; row < M; row += 2 * nblk * 8) {
            const int rowB = row + nblk * 8; const bool hasB = rowB < M;
            const float* xa = xrow(p, row); const float* xb = xrow(p, hasB ? rowB : row); f32x4 va[8], vb[8];
#pragma unroll
            for (int i = 0; i < 8; ++i) { va[i] = *(const f32x4*)(xa + i * 256 + lane * 4); vb[i] = *(const f32x4*)(xb + i * 256 + lane * 4); }
            const float ra = rsqrtf(wave_sum(sumsq8(va)) * (1.0f / DM) + NORM_EPS), rb = rsqrtf(wave_sum(sumsq8(vb)) * (1.0f / DM) + NORM_EPS);
#pragma unroll
            for (int i = 0; i < 8; ++i) { const f32x4 g = *(const f32x4*)(gw + i * 256 + lane * 4); const f32x4 oa = va[i] * ra * g, ob = vb[i] * rb * g;
                u32x2 w; w.x = cvt_pk_bf16(oa[0], oa[1]); w.y = cvt_pk_bf16(oa[2], oa[3]); *(u32x2*)(H + (size_t)row * DM + i * 256 + lane * 4) = w;
                if (hasB) { u32x2 w2; w2.x = cvt_pk_bf16(ob[0], ob[1]); w2.y = cvt_pk_bf16(ob[2], ob[3]); *(u32x2*)(H + (size_t)rowB * DM + i * 256 + lane * 4) = w2; } }
        }
        for (int e = bid * NTHR + tid; e < 128 * 11 * 256; e += nblk * NTHR) { const int c4 = e & 255, j = (e >> 8) % 11, b = (e >> 8) / 11;
            *(f32x4*)(p->out + O_SPOOL + ((size_t)b * 15 + j) * 1024 + c4 * 4) = *(const f32x4*)(p->in[4] + ((size_t)b * 15 + j + 4) * 1024 + c4 * 4); }
    }
    }
    xcd_barrier(xbar);

    {
        PHASE_BEGIN();
        pg8::Gemm g{(const bf16_t*)(ws + W_H), (const bf16_t*)(ws + W_IN), M, 8704, 2048, 2048, 2048, 0, 0}; pg8::StaticOrder S; S.init(M, 8704, nblk, bid, 2048);
        EpiZ E{Z, p->out}; pg8::gemm_phase(lds, g, S, E);
        { const int nfull = (34 * 34) / nblk, nrem = (34 * 34) - nfull * nblk;
          if (bid >= nrem && nrem > 0 && nblk - nrem >= 8) { const int ob = bid - nrem, onb = nblk - nrem;
            transpose_job(p->in[19], 2048, 1024, (bf16_t*)(ws + W_AB), 1024, 2048, MapId(), ldsf, ob, onb);
            transpose_job(p->in[22], 2048, 1024, (bf16_t*)(ws + W_AB) + (size_t)2048 * 1024, 1024, 2048, MapId(), ldsf, ob, onb);
            transpose_job(p->in[23], 2048, 2048, (bf16_t*)(ws + W_O), 2048, 2048, MapId(), ldsf, ob, onb);
            for (int g = 0; g < 4; ++g) transpose_job(p->in[20] + (size_t)g * 65536, 256, 256, (bf16_t*)(ws + W_POOL) + (size_t)g * 65536, 256, 256, MapId(), ldsf, ob, onb);
            transpose_job(p->in[10], 1024, 64, (bf16_t*)(ws + W_LR), 256, 1024, MapId(), ldsf, ob, onb);
            transpose_job(p->in[12], 1024, 64, (bf16_t*)(ws + W_LR) + (size_t)1024 * 256, 256, 1024, MapId(), ldsf, ob, onb);
            transpose_job(p->in[13], 1024, 160, (bf16_t*)(ws + W_LR) + (size_t)2048 * 256, 256, 1024, MapId(), ldsf, ob, onb);
          } else if (nrem == 0 || nblk - nrem < 8) {
            transpose_job(p->in[19], 2048, 1024, (bf16_t*)(ws + W_AB), 1024, 2048, MapId(), ldsf, bid, nblk);
            transpose_job(p->in[22], 2048, 1024, (bf16_t*)(ws + W_AB) + (size_t)2048 * 1024, 1024, 2048, MapId(), ldsf, bid, nblk);
            transpose_job(p->in[23], 2048, 2048, (bf16_t*)(ws + W_O), 2048, 2048, MapId(), ldsf, bid, nblk);
            for (int g = 0; g < 4; ++g) transpose_job(p->in[20] + (size_t)g * 65536, 256, 256, (bf16_t*)(ws + W_POOL) + (size_t)g * 65536, 256, 256, MapId(), ldsf, bid, nblk);
            transpose_job(p->in[10], 1024, 64, (bf16_t*)(ws + W_LR), 256, 1024, MapId(), ldsf, bid, nblk);
            transpose_job(p->in[12], 1024, 64, (bf16_t*)(ws + W_LR) + (size_t)1024 * 256, 256, 1024, MapId(), ldsf, bid, nblk);
            transpose_job(p->in[13], 1024, 160, (bf16_t*)(ws + W_LR) + (size_t)2048 * 256, 256, 1024, MapId(), ldsf, bid, nblk);
          } }
    }
    xcd_barrier(xbar);

    {
        PHASE_BEGIN();
        bf16_t* A2 = (bf16_t*)(ws + W_A2);
        for (int e = bid * NTHR + tid; e < M * 96; e += nblk * NTHR) { const int r = e / 96, j8 = e - r * 96; u32x4 o = (u32x4){0u, 0u, 0u, 0u};
            int kind = -1, zc = 0;
            if (j8 < 8) { kind = 0; zc = ZC_LR + j8 * 8; } else if (j8 >= 32 && j8 < 40) { kind = 1; zc = ZC_LR + 64 + (j8 - 32) * 8; } else if (j8 >= 64 && j8 < 84) { kind = 2; zc = ZC_LR + 128 + (j8 - 64) * 8; }
            if (kind >= 0) {
                const bool smp = r >= MP; const int t = smp ? (r - MP) & 3 : r & 2047;
                f32x4 z0, z1, p0, p1; unpack8(*(const u32x4*)(Z + (size_t)r * ZLD + zc), z0, z1);
                if (t > 0) unpack8(*(const u32x4*)(Z + (size_t)(r - 1) * ZLD + zc), p0, p1);
                else if (smp) { const float* sp = p->in[2] + (size_t)((r - MP) >> 2) * DSH + zc; p0 = *(const f32x4*)sp; p1 = *(const f32x4*)(sp + 4); }
                else { p0 = (f32x4){0.f, 0.f, 0.f, 0.f}; p1 = p0; }
                const f32x4 m0 = *(const f32x4*)(p->in[8] + zc), m1 = *(const f32x4*)(p->in[8] + zc + 4);
                f32x4 v0 = z0 + (p0 - z0) * m0, v1 = z1 + (p1 - z1) * m1;
#pragma unroll
                for (int j = 0; j < 4; ++j) {
                    if (kind == 0) { v0[j] = 1.0f - 2.0f * __builtin_amdgcn_rcpf(1.0f + __expf(2.0f * v0[j])); v1[j] = 1.0f - 2.0f * __builtin_amdgcn_rcpf(1.0f + __expf(2.0f * v1[j])); }
                    else if (kind == 2) { v0[j] = sigmoidf_(v0[j]); v1[j] = sigmoidf_(v1[j]); } }
                o = pack8(v0, v1); }
            *(u32x4*)(A2 + (size_t)r * 768 + j8 * 8) = o; }
        bf16_t* D = (bf16_t*)(ws + W_DYA);
        for (int e = bid * NTHR + tid; e < 512 * 128; e += nblk * NTHR) { const int seg = e >> 7, c = (e & 127) * 8; const int gi = c >> 8, win = 2 << gi;
            const int r0 = seg * 16, t0 = r0 & 2047;
            f32x4 s0 = (f32x4){0.f, 0.f, 0.f, 0.f}, s1 = s0;
            for (int j = 1; j < win; ++j) { if (t0 - j >= 0) { f32x4 a, bq; unpack8(*(const u32x4*)(Z + (size_t)(r0 - j) * ZLD + ZC_P + c), a, bq); s0 += a; s1 += bq; } }
#pragma unroll 4
            for (int i = 0; i < 16; ++i) { const int t = t0 + i; f32x4 a, bq; unpack8(*(const u32x4*)(Z + (size_t)(r0 + i) * ZLD + ZC_P + c), a, bq);
                s0 += a; s1 += bq; const float ic = 1.0f / (float)min(win, t + 1);
                *(u32x4*)(D + (size_t)(r0 + i) * 1024 + c) = pack8(s0 * ic - a, s1 * ic - bq);
                if (t - win + 1 >= 0) { f32x4 oa, ob; unpack8(*(const u32x4*)(Z + (size_t)(r0 + i - win + 1) * ZLD + ZC_P + c), oa, ob); s0 -= oa; s1 -= ob; } }
        }
        for (int e = bid * NTHR + tid; e < 512 * 128; e += nblk * NTHR) { const int r = MP + (e >> 7), c = (e & 127) * 8; const int gi = c >> 8, win = 2 << gi;
            const int b = (r - MP) >> 2, t = (r - MP) & 3;
            f32x4 s0 = (f32x4){0.f, 0.f, 0.f, 0.f}, s1 = s0, z0 = s0, z1 = s0;
            for (int j = 0; j < win; ++j) { const int tj = t - j; f32x4 a, bq;
                if (tj >= 0) unpack8(*(const u32x4*)(Z + (size_t)(r - j) * ZLD + ZC_P + c), a, bq);
                else { const float* sp = p->in[4] + ((size_t)b * 15 + (15 + tj)) * 1024 + c; a = *(const f32x4*)sp; bq = *(const f32x4*)(sp + 4); }
                if (j == 0) { z0 = a; z1 = bq; }
                s0 += a; s1 += bq; }
            const float ic = 1.0f / (float)win;
            *(u32x4*)(D + (size_t)r * 1024 + c) = pack8(s0 * ic - z0, s1 * ic - z1); }
    }
    xcd_barrier(xbar);

    {
        PHASE_BEGIN();
        pg8::Gemm g{(const bf16_t*)(ws + W_A2), (const bf16_t*)(ws + W_LR), M, 3072, 256, 768, 256, 2, 256}; pg8::LowRankOrder S; S.part = 0; S.G = nblk; S.c = bid; S.ntk = 4;
        EpiLR E{(bf16_t*)(ws + W_XW), p->in[9], p->in[11]}; pg8::gemm_phase(lds, g, S, E);
        pg8::Gemm g3{(const bf16_t*)(ws + W_DYA), (const bf16_t*)(ws + W_POOL), M, 1024, 256, 1024, 256, 0, 256}; pg8::StaticOrder S3; S3.init(M, 1024, nblk, nblk - 1 - bid, 256);
        EpiPool E3{(bf16_t*)(ws + W_YB), p->in[21]}; pg8::gemm_phase(lds, g3, S3, E3);
    }
    xcd_barrier(xbar);

    {
        PHASE_BEGIN();
        scan_sample(p, bid * 8 + wave, ldsf);
        __syncthreads();
        for (int cu = bid; cu < 2048; cu += nblk) wkv_pass_a(p, cu, lds);
    }
    xcd_barrier(xbar);
    {
        PHASE_BEGIN();
        if (bid < 64) { if (wave < 4) wkv_pass_b(p, bid * 4 + wave, lane); }
        else {
            const int ob = bid - 64, onb = nblk - 64;
            pg8::Gemm g{(const bf16_t*)(ws + W_YB), (const bf16_t*)(ws + W_AB) + (size_t)2048 * 1024, M, 2048, 1024, 1024, 1024, 0, 0};
            pg8::MixOrder S; S.base.init(MP, 2048, 1, 0, 1024); S.G = onb; S.c = ob; S.sample_only = false;
            EpiGateB E{(bf16_t*)(ws + W_MM), Z}; pg8::gemm_phase(lds, g, S, E);
            pg8::Gemm ga{(const bf16_t*)(ws + W_DYA), (const bf16_t*)(ws + W_AB), M, 2048, 1024, 1024, 1024, 0, 0}; pg8::MixOrder SS = S; SS.sample_only = true;
            EpiGateA EA{Z, (bf16_t*)(ws + W_MM)}; pg8::gemm_phase(lds, ga, SS, EA);
            { const int first1 = 256 - (onb - 16), nfree = (onb - 16) - first1;
              pg8::Gemm gl{(const bf16_t*)(ws + W_A2), (const bf16_t*)(ws + W_LR), M, 3072, 256, 768, 256, 2, 256};
              pg8::LowRankOrder SL; SL.part = 1; SL.G = nfree > 0 ? nfree : onb; SL.c = nfree > 0 ? ((ob >= first1 && ob < onb - 16) ? ob - first1 : -1) : ob; SL.ntk = 4;
              EpiLR EL{(bf16_t*)(ws + W_XW), p->in[9], p->in[11]}; pg8::gemm_phase(lds, gl, SL, EL); }
        }
    }
    xcd_barrier(xbar);
    {
        PHASE_BEGIN();
        for (int cu = bid * 2 + (wave >> 2); cu < 2048; cu += nblk * 2) { if (wave < 8) wkv_pass_c(p, cu, wave & 3, lane); }
    }
    xcd_barrier(xbar);
    {
        PHASE_BEGIN();
        transpose_job(p->in[26], 11264, 2048, (bf16_t*)(ws + W_GU), 2048, 11264, MapId(), ldsf, bid, nblk);
        transpose_job(p->in[29], 2048, 5632, (bf16_t*)(ws + W_D), 5632, 2048, MapId(), ldsf, bid, nblk);
        pg8::Gemm g{(const bf16_t*)(ws + W_DYA), (const bf16_t*)(ws + W_AB), M, 2048, 1024, 1024, 1024, 0, 0}; pg8::StaticOrder S; S.init(MP, 2048, nblk, bid, 1024);
        EpiGateA E{Z, (bf16_t*)(ws + W_MM)}; pg8::gemm_phase(lds, g, S, E);
    }
    xcd_barrier(xbar);

    {
        PHASE_BEGIN();
        pg8::Gemm g{(const bf16_t*)(ws + W_MM), (const bf16_t*)(ws + W_O), M, 2048, 2048, 2048, 2048, 0, 0}; pg8::SplitOrder S; S.init(nblk, bid, 2048, 8);
        EpiOutP E{(bf16_t*)(ws + W_O16), (float*)(ws + W_PART5)}; pg8::gemm_phase(lds, g, S, E);
    }
    xcd_barrier(xbar);

    {
        PHASE_BEGIN();
        bf16_t* H2 = (bf16_t*)(ws + W_H2); const float* g1 = p->in[24]; const float* g2 = p->in[25]; const float* PT = (const float*)(ws + W_PART5); const bf16_t* O16 = (const bf16_t*)(ws + W_O16);
        const int stride = nblk * 8;
        for (int row = bid * 8 + wave; row < MP; row += 2 * stride) {
            const int rowB = row + stride; const bool hasB = rowB < MP;
            f32x4 oa[8], ob[8], xa[8], xb[8];
            row_load_bf(oa, O16, row, lane); if (hasB) row_load_bf(ob, O16, rowB, lane);
#pragma unroll
            for (int i = 0; i < 8; ++i) { xa[i] = *(const f32x4*)(p->in[0] + (size_t)row * DM + i * 256 + lane * 4); if (hasB) xb[i] = *(const f32x4*)(p->in[0] + (size_t)rowB * DM + i * 256 + lane * 4); }
            const float ra = rsqrtf(wave_sum(sumsq8(oa)) * (1.0f / DM) + NORM_EPS), rb = hasB ? rsqrtf(wave_sum(sumsq8(ob)) * (1.0f / DM) + NORM_EPS) : 0.f;
#pragma unroll
            for (int i = 0; i < 8; ++i) { const int c = i * 256 + lane * 4; const f32x4 g = *(const f32x4*)(g1 + c);
                xa[i] = xa[i] + oa[i] * ra * g; *(f32x4*)(Y + (size_t)row * DM + c) = xa[i];
                if (hasB) { xb[i] = xb[i] + ob[i] * rb * g; *(f32x4*)(Y + (size_t)rowB * DM + c) = xb[i]; } }
            const float qa = rsqrtf(wave_sum(sumsq8(xa)) * (1.0f / DM) + NORM_EPS), qb = hasB ? rsqrtf(wave_sum(sumsq8(xb)) * (1.0f / DM) + NORM_EPS) : 0.f;
#pragma unroll
            for (int i = 0; i < 8; ++i) { const int c = i * 256 + lane * 4; const f32x4 g = *(const f32x4*)(g2 + c);
                { const f32x4 o = xa[i] * qa * g; u32x2 w; w.x = cvt_pk_bf16(o[0], o[1]); w.y = cvt_pk_bf16(o[2], o[3]); *(u32x2*)(H2 + (size_t)row * DM + c) = w; }
                if (hasB) { const f32x4 o = xb[i] * qb * g; u32x2 w; w.x = cvt_pk_bf16(o[0], o[1]); w.y = cvt_pk_bf16(o[2], o[3]); *(u32x2*)(H2 + (size_t)rowB * DM + c) = w; } }
        }
        for (int srow = bid * 8 + wave; srow < M - MP; srow += stride) {
            const int row = MP + srow; float s1 = 0.f;
#pragma unroll 1
            for (int i = 0; i < 8; ++i) { const f32x4 o = part_sum<8>(PT, srow, i * 256 + lane * 4); s1 += (o[0] * o[0] + o[1] * o[1]) + (o[2] * o[2] + o[3] * o[3]); }
            const float ra = rsqrtf(wave_sum(s1) * (1.0f / DM) + NORM_EPS); float s2 = 0.f;
#pragma unroll 1
            for (int i = 0; i < 8; ++i) { const int c = i * 256 + lane * 4; const f32x4 o = part_sum<8>(PT, srow, c);
                const f32x4 v = *(const f32x4*)(p->in[1] + (size_t)srow * DM + c) + o * ra * *(const f32x4*)(g1 + c); *(f32x4*)(Y + (size_t)row * DM + c) = v; s2 += (v[0] * v[0] + v[1] * v[1]) + (v[2] * v[2] + v[3] * v[3]); }
            const float qa = rsqrtf(wave_sum(s2) * (1.0f / DM) + NORM_EPS);
            asm volatile("s_waitcnt vmcnt(0)" ::: "memory");
#pragma unroll 1
            for (int i = 0; i < 8; ++i) { const int c = i * 256 + lane * 4; const f32x4 o = *(const f32x4*)(Y + (size_t)row * DM + c) * qa * *(const f32x4*)(g2 + c);
                u32x2 w; w.x = cvt_pk_bf16(o[0], o[1]); w.y = cvt_pk_bf16(o[2], o[3]); *(u32x2*)(H2 + (size_t)row * DM + c) = w; }
        }
    }
    xcd_barrier(xbar);

    {
        PHASE_BEGIN();
        pg8::Gemm g{(const bf16_t*)(ws + W_H2), (const bf16_t*)(ws + W_GU), M, DFF, 2048, 2048, 2048, 0, 0}; pg8::StaticOrder S; S.init(M, DFF, nblk, bid, 2048);
        EpiGate7 E{(bf16_t*)(ws + W_GATE), p->out}; pg8::gemm_phase(lds, g, S, E);
    }
    xcd_barrier(xbar);

    {
        PHASE_BEGIN();
        pg8::Gemm g{(const bf16_t*)(ws + W_H2), (const bf16_t*)(ws + W_GU) + (size_t)DFF * 2048, M, DFF, 2048, 2048, 2048, 0, 0}; pg8::StaticOrder S; S.init(M, DFF, nblk, bid, 2048);
        EpiAct E{(const bf16_t*)(ws + W_GATE), (bf16_t*)(ws + W_ACT), p->in[27], p->in[28], p->in[5]}; pg8::gemm_phase(lds, g, S, E);
    }
    xcd_barrier(xbar);

    {
        PHASE_BEGIN();
        pg8::Gemm g{(const bf16_t*)(ws + W_ACT), (const bf16_t*)(ws + W_D), M, 2048, DFF, DFF, DFF, 0, 0}; pg8::SplitOrder S; S.init(nblk, bid, DFF, 11);
        EpiOutP E{(bf16_t*)(ws + W_F), (float*)(ws + W_PART9)}; pg8::gemm_phase(lds, g, S, E);
    }
    xcd_barrier(xbar);

    {
        PHASE_BEGIN();
        const bf16_t* F = (const bf16_t*)(ws + W_F); const float* g3 = p->in[30]; const float* PT = (const float*)(ws + W_PART9);
        const int stride = nblk * 8;
        for (int row = bid * 8 + wave; row < MP; row += 2 * stride) {
            const int rowB = row + stride; const bool hasB = rowB < MP;
            f32x4 fa[8], fb[8], xa[8], xb[8];
            row_load_bf(fa, F, row, lane); if (hasB) row_load_bf(fb, F, rowB, lane);
#pragma unroll
            for (int i = 0; i < 8; ++i) { xa[i] = *(const f32x4*)(Y + (size_t)row * DM + i * 256 + lane * 4); if (hasB) xb[i] = *(const f32x4*)(Y + (size_t)rowB * DM + i * 256 + lane * 4); }
            const float ra = rsqrtf(wave_sum(sumsq8(fa)) * (1.0f / DM) + NORM_EPS), rb = hasB ? rsqrtf(wave_sum(sumsq8(fb)) * (1.0f / DM) + NORM_EPS) : 0.f;
#pragma unroll
            for (int i = 0; i < 8; ++i) { const int c = i * 256 + lane * 4; const f32x4 g = *(const f32x4*)(g3 + c);
                *(f32x4*)(Y + (size_t)row * DM + c) = xa[i] + fa[i] * ra * g;
                if (hasB) *(f32x4*)(Y + (size_t)rowB * DM + c) = xb[i] + fb[i] * rb * g; }
        }
        for (int srow = bid * 8 + wave; srow < M - MP; srow += stride) {
            const int row = MP + srow; float s1 = 0.f;
#pragma unroll 1
            for (int i = 0; i < 8; ++i) { const f32x4 o = part_sum<11>(PT, srow, i * 256 + lane * 4); s1 += (o[0] * o[0] + o[1] * o[1]) + (o[2] * o[2] + o[3] * o[3]); }
            const float ra = rsqrtf(wave_sum(s1) * (1.0f / DM) + NORM_EPS);
#pragma unroll 1
            for (int i = 0; i < 8; ++i) { const int c = i * 256 + lane * 4; const f32x4 o = part_sum<11>(PT, srow, c);
                *(f32x4*)(Y + (size_t)row * DM + c) = *(const f32x4*)(Y + (size_t)row * DM + c) + o * ra * *(const f32x4*)(g3 + c); }
        }
    }
}

extern "C" void kernel_launch(void* const* d_in, const int* in_sizes, int n_in, void* d_out, int out_size, void* d_ws, size_t ws_size, hipStream_t stream) {
    static int grid_blocks = 0;
    if (!grid_blocks) {
        int dev = 0, cus = 0, per_cu = 0;
        hipGetDevice(&dev);
        hipDeviceGetAttribute(&cus, hipDeviceAttributeMultiprocessorCount, dev);
        hipFuncSetAttribute((const void*)fwd_megakernel, hipFuncAttributeMaxDynamicSharedMemorySize, LDS_BYTES);
        hipOccupancyMaxActiveBlocksPerMultiprocessor(&per_cu, (const void*)fwd_megakernel, NTHR, LDS_BYTES);
        if (per_cu < 1) per_cu = 1;
        grid_blocks = cus * 1;
        if (ws_size < W_END) fprintf(stderr, "kernel_launch: workspace too small: %zu < %zu\n", ws_size, (size_t)W_END);
        if (n_in != 31) fprintf(stderr, "kernel_launch: expected 31 inputs, got %d\n", n_in);
    }
    Params p{};
    for (int i = 0; i < 31; ++i) p.in[i] = (const float*)d_in[i];
    p.out = (float*)d_out; p.ws = (unsigned char*)d_ws;
    hipMemsetAsync((unsigned char*)d_ws + W_BAR, 0, 16384, stream);
    void* args[] = {&p};
    hipError_t e = hipLaunchCooperativeKernel((const void*)fwd_megakernel, dim3(grid_blocks), dim3(NTHR), args, LDS_BYTES, stream);
    if (e != hipSuccess) fprintf(stderr, "cooperative launch failed: %s (grid %d)\n", hipGetErrorString(e), grid_blocks);
}
```

```cpp
#include <hip/hip_runtime.h>
#include <hip/hip_cooperative_groups.h>
#include <cstdio>
namespace cg = cooperative_groups;

#define LAS __attribute__((address_space(3)))
typedef unsigned short bf16_t;
typedef short bf16x8 __attribute__((ext_vector_type(8)));
typedef float f32x4 __attribute__((ext_vector_type(4)));
typedef float f32x2 __attribute__((ext_vector_type(2)));
typedef unsigned u32x4 __attribute__((ext_vector_type(4)));
typedef unsigned u32x2 __attribute__((ext_vector_type(2)));

constexpr int M = 8704;
constexpr int MP = 8192;
constexpr int DM = 2048, DR = 1024, DSH = 3360, DFF = 5632;
constexpr int ZLD = 8704;
constexpr int ZC_LR = 3072, ZC_P = 3584, ZC_GA = 4608, ZC_GB = 6656;
constexpr int NTHR = 512;
constexpr int LDS_BYTES = 131072;
constexpr float NORM_EPS = 1e-6f, GN_EPS = 64e-5f;

constexpr size_t O_Y = 0;
constexpr size_t O_PSHIFT = 17825792, O_PWKV = 17839232, O_PPOOL = 18101376, O_PCONV = 18162816;
constexpr size_t O_SSHIFT = 18207872, O_SWKV = 18637952, O_SPOOL = 27026560, O_SCONV = 28992640;

constexpr size_t SZ_M1024_BF = (size_t)M * 1024 * 2;
constexpr size_t W_AB = 0;
constexpr size_t W_O = W_AB + 8388608;
constexpr size_t W_POOL = W_O + 8388608;
constexpr size_t W_LR = W_POOL + 524288;
constexpr size_t W_SSQ = W_LR + 1572864;
constexpr size_t W_RA = W_SSQ + (size_t)M * 32 * 4;
constexpr size_t W_IN = W_RA;
constexpr size_t W_H = W_RA + (size_t)8704 * 2048 * 2;
constexpr size_t W_GU = W_RA;
constexpr size_t W_D = W_RA + (size_t)11264 * 2048 * 2;
constexpr size_t W_Z = W_RA + (size_t)2 * 8704 * 2048 * 2;
constexpr size_t W_H2 = W_Z;
constexpr size_t W_GATE = W_Z + (size_t)M * 2048 * 2;
constexpr size_t W_F = W_Z;
constexpr size_t W_O16 = W_Z + (size_t)M * 2048 * 4 + (size_t)1048576;
constexpr size_t W_PART5 = W_Z + (size_t)M * 2048 * 2;
constexpr size_t W_PART9 = W_Z + (size_t)M * 2048 * 4;
constexpr size_t W_RC = W_Z + (size_t)M * ZLD * 2;
constexpr size_t W_XW = W_RC;
constexpr size_t W_XA = W_XW + SZ_M1024_BF;
constexpr size_t W_GG = W_XA + SZ_M1024_BF;
constexpr size_t W_DYA = W_GG + SZ_M1024_BF;
constexpr size_t W_YB = W_DYA + SZ_M1024_BF;
constexpr size_t W_A2 = W_YB + SZ_M1024_BF;
constexpr size_t W_MM = W_XW;
constexpr size_t W_ACT = W_RC;
constexpr size_t W_BAR = W_A2 + (size_t)M * 768 * 2;
constexpr size_t W_SF = W_BAR + 16384;
constexpr size_t W_END = W_SF + (size_t)2048 * 8192;

struct Params { const float* in[31]; float* out; unsigned char* ws; };
typedef const __attribute__((address_space(4))) Params* KArgP;
__device__ __forceinline__ KArgP kargs() { KArgP q = (KArgP)__builtin_amdgcn_kernarg_segment_ptr(); asm volatile("" : "+s"(q)); return q; }

__device__ __forceinline__ float bf2f(bf16_t b) { return __uint_as_float(((unsigned)b) << 16); }
__device__ __forceinline__ bf16_t f2bf(float f) { unsigned u = __float_as_uint(f); u += 0x7FFFu + ((u >> 16) & 1u); return (bf16_t)(u >> 16); }
typedef __bf16 bf16n2 __attribute__((ext_vector_type(2)));
__device__ __forceinline__ unsigned cvt_pk_bf16(float lo, float hi) { const f32x2 v = {lo, hi}; const bf16n2 r = __builtin_convertvector(v, bf16n2); unsigned u; __builtin_memcpy(&u, &r, 4); return u; }
__device__ __forceinline__ float lo_bf(unsigned w) { return __uint_as_float(w << 16); }
__device__ __forceinline__ float hi_bf(unsigned w) { return __uint_as_float(w & 0xffff0000u); }
__device__ __forceinline__ float sigmoidf_(float x) { return __builtin_amdgcn_rcpf(1.0f + __expf(-x)); }
#define DPP_ADD(v, ctrl) ((v) + __uint_as_float(__builtin_amdgcn_update_dpp(0u, __float_as_uint(v), (ctrl), 0xF, 0xF, true)))
__device__ __forceinline__ float xor16_sum(float v) { const auto r = __builtin_amdgcn_permlane16_swap(__float_as_uint(v), __float_as_uint(v), false, false); return __uint_as_float(r[0]) + __uint_as_float(r[1]); }
__device__ __forceinline__ float xor32_sum(float v) { const auto r = __builtin_amdgcn_permlane32_swap(__float_as_uint(v), __float_as_uint(v), false, false); return __uint_as_float(r[0]) + __uint_as_float(r[1]); }
__device__ __forceinline__ float wave_sum(float v) {
    v = DPP_ADD(v, 0xB1);
    v = DPP_ADD(v, 0x4E);
    v = DPP_ADD(v, 0x141);
    v = DPP_ADD(v, 0x140);
    v = xor16_sum(v);
    return xor32_sum(v);
}
__device__ __forceinline__ const float* xrow(KArgP p, int r) { return r < MP ? p->in[0] + (size_t)r * DM : p->in[1] + (size_t)(r - MP) * DM; }
__device__ __forceinline__ float gelu_tanh(float x) {
    const float u = 0.7978845608f * (x + 0.044715f * x * x * x);
    return x * __builtin_amdgcn_rcpf(1.0f + __expf(-2.0f * u));
}


#define XB_TMO      128
#define XB_XCNT(j)  (256  + 64 * (j))
#define XB_XSUB(j)  (1280 + 64 * (j))
#define XB_XGEN(j)  (2304 + 64 * (j))
#define XB_TOP      3328
#define XB_TOPGEN   3392
#define XCD_BAR_WORDS 3456
#define XB_SPIN_CAP (1u << 18)
__device__ __forceinline__ unsigned xb_ld(unsigned* p)              { return __hip_atomic_load(p, __ATOMIC_RELAXED, __HIP_MEMORY_SCOPE_AGENT); }
__device__ __forceinline__ unsigned xb_add(unsigned* p, unsigned v) { return __hip_atomic_fetch_add(p, v, __ATOMIC_RELAXED, __HIP_MEMORY_SCOPE_AGENT); }
__device__ __forceinline__ unsigned xb_xcc_id() { return (unsigned)__builtin_amdgcn_s_getreg((3 << 11) | 20) & 0xFu; }
#define XB_SPIN(cond, bar) do { unsigned _sp = 0; while (cond) { __builtin_amdgcn_s_sleep(1); \
    if ((++_sp & 255u) == 0u) { if (xb_ld(&(bar)[XB_TMO])) break; if (_sp > XB_SPIN_CAP) { atomicAdd(&(bar)[XB_TMO], 1u); break; } } } } while (0)
struct XcdBarrier { unsigned* bar; unsigned x; volatile LAS unsigned* st; };
__device__ __forceinline__ XcdBarrier xcd_barrier_post(unsigned* bar, volatile LAS unsigned* st) {
    XcdBarrier b; b.bar = bar; b.x = xb_xcc_id(); b.st = st;
    if (threadIdx.x == 0) (void)xb_add(&bar[XB_XCNT(b.x)], 1u);
    return b;
}
__device__ __forceinline__ void xcd_barrier_complete(unsigned* bar, unsigned x, unsigned& nloc, unsigned& nx) {
    const unsigned G = gridDim.x * gridDim.y * gridDim.z;
    unsigned sum, cnt, mine, sp = 0u;
    for (;;) {
        sum = 0u; cnt = 0u; mine = 0u;
#pragma unroll
        for (unsigned j = 0; j < 16; ++j) { const unsigned c = xb_ld(&bar[XB_XCNT(j)]); sum += c; cnt += (c > 0u) ? 1u : 0u; mine = (j == x) ? c : mine; }
        if (sum == G) break;
        __builtin_amdgcn_s_sleep(1);
        if ((++sp & 255u) == 0u) { if (xb_ld(&bar[XB_TMO])) break; if (sp > XB_SPIN_CAP) { atomicAdd(&bar[XB_TMO], 1u); break; } }
    }
    nloc = mine > 0u ? mine : 1u; nx = cnt > 0u ? cnt : 1u;
}
__device__ __forceinline__ void xcd_barrier(const XcdBarrier& b) {
    asm volatile("s_waitcnt vmcnt(0)" ::: "memory");
    __syncthreads();
    if (threadIdx.x == 0) {
        unsigned* bar = b.bar;
        __builtin_amdgcn_s_waitcnt(0);
        unsigned nloc = b.st[0], nx = b.st[1];
        if (nloc == 0u) { xcd_barrier_complete(bar, b.x, nloc, nx); b.st[0] = nloc; b.st[1] = nx; }
        const unsigned old = xb_add(&bar[XB_XSUB(b.x)], 1u);
        const unsigned gen = old / nloc;
        if (old + 1u == (gen + 1u) * nloc) {
            __builtin_amdgcn_fence(__ATOMIC_RELEASE, "agent");
            asm volatile("s_waitcnt vmcnt(0)" ::: "memory");
            const unsigned og = xb_add(&bar[XB_TOP], 1u);
            const unsigned tg = og / nx;
            if (og + 1u == (tg + 1u) * nx) xb_add(&bar[XB_TOPGEN], 1u);
            else XB_SPIN(xb_ld(&bar[XB_TOPGEN]) == tg, bar);
            __builtin_amdgcn_fence(__ATOMIC_ACQUIRE, "agent");
            xb_add(&bar[XB_XGEN(b.x)], 1u);
            asm volatile("s_waitcnt vmcnt(0)" ::: "memory");
        } else {
            XB_SPIN(xb_ld(&bar[XB_XGEN(b.x)]) == gen, bar);
            __builtin_amdgcn_fence(__ATOMIC_ACQUIRE, "agent");
            asm volatile("s_waitcnt vmcnt(0)" ::: "memory");
        }
    }
    __syncthreads();
}

namespace pg8 {
constexpr int BM = 256, BK = 64, HALF = 128, HTB = HALF * BK * 2, NXCD = 8, WGM = 8;
__device__ __forceinline__ int lds_byte(int r, int c) { const int st = (r >> 4) * 2 + (c >> 5), rr = r & 15, cc = c & 31, ob = rr * 64 + cc * 2; return st * 1024 + (ob ^ (((ob >> 9) & 1) << 5)); }
__device__ __forceinline__ void stage_rc(int b, int& R, int& C) { const int st = b / 1024, sb = b % 1024, swz = sb ^ (((sb >> 9) & 1) << 5); R = (st >> 1) * 16 + swz / 64; C = (st & 1) * 32 + (swz % 64) / 2; }
__device__ __forceinline__ int perm32(int rho) { const int n = rho >> 4, i = rho & 15; return 8 * (i >> 2) + 4 * n + (i & 3); }

struct Unit { int pm, pn, k0, nt, sp; };
struct Gemm { const bf16_t* A; const bf16_t* Bt; int M, N, K, lda, ldb, agshift, agcols; };

struct StaticOrder {
    int nM, nN, nwg, G, c;
    int ntk;
    __device__ __forceinline__ void init(int M_, int N_, int G_, int c_, int K_) { nM = M_ / BM; nN = N_ / BM; nwg = nM * nN; G = G_; c = c_; ntk = K_ / BK; }
    __device__ __forceinline__ Unit get(int i) const {
        Unit u; u.pm = 0; u.pn = 0; u.k0 = 0; u.nt = 0; u.sp = -1;
        const long L = (long)i * G + c; if (L >= nwg) return u;
        int wgid = (int)L; { const int q = nwg / NXCD, r = nwg % NXCD, xcd = wgid % NXCD, off = wgid / NXCD; wgid = (xcd < r ? xcd * (q + 1) : r * (q + 1) + (xcd - r) * q) + off; }
        const int nig = WGM * nN, gid = wgid / nig, fm = gid * WGM, gsz = (nM - fm) < WGM ? (nM - fm) : WGM;
        u.pm = fm + ((wgid % nig) % gsz); u.pn = (wgid % nig) / gsz; u.nt = ntk; return u;
    }
};
struct SampleOrder {
    StaticOrder base;
    __device__ __forceinline__ Unit get(int i) const {
        int cnt = 0; Unit e; e.pm = 0; e.pn = 0; e.k0 = 0; e.nt = 0; e.sp = -1;
#pragma unroll
        for (int k = 0; k < 3; ++k) { const Unit u = base.get(k); if (u.nt != 0 && u.pm >= 32) { if (cnt == i) return u; ++cnt; } }
        return e;
    }
};
struct MixOrder {
    StaticOrder base; int G, c; bool sample_only;
    __device__ __forceinline__ Unit get(int i) const {
        Unit u; u.pm = 0; u.pn = 0; u.k0 = 0; u.nt = 0; u.sp = -1;
        const int np = G - 16;
        if (c < np) { if (sample_only) return u; StaticOrder b = base; b.G = 1 << 20; b.c = c + i * np; return (i < 64 && c + i * np < 256) ? b.get(0) : u; }
        const int t = c - np; if (i == 0 && t < 16) { u.pm = 32 + (t >> 3); u.pn = t & 7; u.nt = base.ntk; }
        return u;
    }
};
struct LowRankOrder {
    int part, G, c, ntk;
    __device__ __forceinline__ Unit get(int i) const {
        Unit u; u.pm = 0; u.pn = 0; u.k0 = 0; u.nt = 0; u.sp = -1;
        if (c < 0) return u;
        const int L = i * G + c;
        if (part == 0) { if (L < 272) { u.pm = L % 34; u.pn = L / 34; u.nt = ntk; } else if (L < 280) { u.pm = 32 + (L - 272) / 4; u.pn = 8 + (L - 272) % 4; u.nt = ntk; } }
        else if (L < 128) { u.pm = L / 4; u.pn = 8 + (L % 4); u.nt = ntk; }
        return u;
    }
};
struct SplitOrder {
    StaticOrder base; int S, nbase;
    __device__ __forceinline__ void init(int G_, int c_, int K_, int S_) { base.init(8192, 2048, G_, c_, K_); S = S_; nbase = (c_ < 256) ? (256 - c_ + G_ - 1) / G_ : 0; }
    __device__ __forceinline__ Unit get(int i) const {
        if (i < nbase) return base.get(i);
        Unit u; u.pm = 0; u.pn = 0; u.k0 = 0; u.nt = 0; u.sp = -1;
        if (i == nbase && base.c < 16 * S) { const int uu = base.c / S, sp = base.c % S; u.pm = 32 + (uu >> 3); u.pn = uu & 7; u.nt = base.ntk / S; u.k0 = sp * u.nt; u.sp = sp; }
        return u;
    }
};

template <class Epi, class Sched>
__device__ __forceinline__ void gemm_phase(LAS unsigned char* lds, const Gemm g, const Sched& S, const Epi& E) {
    int tid = threadIdx.x; asm volatile("" : "+v"(tid));
    const int wid = __builtin_amdgcn_readfirstlane(tid >> 6), lane = tid & 63, wr = wid >> 2, wc = wid & 3, fr = lane & 15, fq = lane >> 4;
    unsigned voffA[2], voffB[2];
#pragma unroll
    for (int i = 0; i < 2; ++i) { int R, C; stage_rc(tid * 16 + i * 8192, R, C); const int Rb = Epi::PERM ? ((R & ~31) + perm32(R & 31)) : R;
        voffA[i] = (unsigned)(R * g.lda + C) * 2u; voffB[i] = (unsigned)(Rb * g.ldb + C) * 2u; }
    const size_t kstep = (size_t)(BK * 2);
    const size_t hstepA = (size_t)HALF * g.lda * 2, hstepB = (size_t)HALF * g.ldb * 2;
    const size_t tstepA = 2 * hstepA, tstepB = 2 * hstepB;
    const unsigned ldsw = (unsigned)wid * 1024u;
    const int aoff = lds_byte(wr * 64 + fr, fq * 8), boff = lds_byte(wc * 32 + fr, fq * 8);
#define PG8_SA(b, h) (((b) * 2 + (h)) * HTB)
#define PG8_SB(b, h) ((4 + (b) * 2 + (h)) * HTB)
#define PG8_STAGE(bufoff, gbase, voff) do { _Pragma("unroll") for (int _i = 0; _i < 2; ++_i) \
        __builtin_amdgcn_global_load_lds((const unsigned*)((const char*)(gbase) + (voff)[_i]), (LAS unsigned*)(lds + (bufoff) + ldsw + _i * 8192), 16, 0, 0); } while (0)
#define PG8_LDA(dst, b, h) do { _Pragma("unroll") for (int m = 0; m < 4; ++m) _Pragma("unroll") for (int k = 0; k < 2; ++k) dst[m][k] = *(const LAS bf16x8*)(lds + PG8_SA(b, h) + aoff + m * 2048 + k * 1024); } while (0)
#define PG8_LDB(dst, b, h) do { _Pragma("unroll") for (int n = 0; n < 2; ++n) _Pragma("unroll") for (int k = 0; k < 2; ++k) dst[n][k] = *(const LAS bf16x8*)(lds + PG8_SB(b, h) + boff + n * 2048 + k * 1024); } while (0)
#define PG8_MMA(ai, bj, At, Bt) do { __builtin_amdgcn_s_setprio(1); _Pragma("unroll") for (int m = 0; m < 4; ++m) _Pragma("unroll") for (int n = 0; n < 2; ++n) _Pragma("unroll") for (int k = 0; k < 2; ++k) \
        acc[ai][bj][m][n] = __builtin_amdgcn_mfma_f32_16x16x32_bf16(Bt[n][k], At[m][k], acc[ai][bj][m][n], 0, 0, 0); __builtin_amdgcn_s_setprio(0); } while (0)
#define PG8_WAIT_V(n) asm volatile("s_waitcnt vmcnt(" #n ")" ::: "memory")
#define PG8_WAIT_L(n) asm volatile("s_waitcnt lgkmcnt(" #n ")" ::: "memory")
#define PG8_BAR __builtin_amdgcn_s_barrier()
#define PG8_SCHED __builtin_amdgcn_sched_barrier(0)
    Unit cur = S.get(0), nxt; int ui = 0;
    if (cur.nt == 0) return;
    f32x4 acc[2][2][4][2];
#pragma unroll
    for (int a = 0; a < 2; ++a)
#pragma unroll
        for (int b = 0; b < 2; ++b)
#pragma unroll
            for (int m = 0; m < 4; ++m)
#pragma unroll
                for (int n = 0; n < 2; ++n) acc[a][b][m][n] = (f32x4){0.f, 0.f, 0.f, 0.f};
    bf16x8 At[4][2], B0[2][2], B1[2][2];
    const char* cA = (const char*)g.A + (size_t)cur.pm * tstepA + (size_t)((cur.pn >> g.agshift) * g.agcols) * 2 + (size_t)cur.k0 * kstep; const char* cB = (const char*)g.Bt + (size_t)cur.pn * tstepB + (size_t)cur.k0 * kstep;
    PG8_STAGE(PG8_SB(0, 0), cB, voffB); PG8_STAGE(PG8_SA(0, 0), cA, voffA); PG8_STAGE(PG8_SB(0, 1), cB + hstepB, voffB); PG8_STAGE(PG8_SA(0, 1), cA + hstepA, voffA);
    if (wr == 1) PG8_BAR;
    PG8_WAIT_V(4); PG8_BAR;
    PG8_STAGE(PG8_SB(1, 0), cB + kstep, voffB); PG8_STAGE(PG8_SA(1, 0), cA + kstep, voffA); PG8_STAGE(PG8_SB(1, 1), cB + hstepB + kstep, voffB);
    PG8_WAIT_V(6); PG8_BAR;
    for (;;) {
        nxt = S.get(ui + 1); const bool has_next = nxt.nt != 0;
        const char* nA = has_next ? (const char*)g.A + (size_t)nxt.pm * tstepA + (size_t)((nxt.pn >> g.agshift) * g.agcols) * 2 + (size_t)nxt.k0 * kstep : cA; const char* nB = has_next ? (const char*)g.Bt + (size_t)nxt.pn * tstepB + (size_t)nxt.k0 * kstep : cB;
        const int nt = cur.nt;
        for (int t = 0; t < nt; t += 2) {
            const bool last = (t == nt - 2);
            const char* a1 = cA + (size_t)(t + 1) * kstep;
            const char* a2 = last ? nA : cA + (size_t)(t + 2) * kstep; const char* b2 = last ? nB : cB + (size_t)(t + 2) * kstep;
            const char* a3 = a2 + kstep; const char* b3 = b2 + kstep;
            PG8_LDB(B0, 0, 0); PG8_SCHED; PG8_LDA(At, 0, 0); PG8_STAGE(PG8_SA(1, 1), a1 + hstepA, voffA);
            PG8_WAIT_L(8); PG8_BAR; PG8_WAIT_L(0); PG8_MMA(0, 0, At, B0); PG8_BAR; PG8_SCHED;
            PG8_LDB(B1, 0, 1); PG8_STAGE(PG8_SB(0, 0), b2, voffB);
            PG8_BAR; PG8_WAIT_L(0); PG8_MMA(0, 1, At, B1); PG8_BAR;
            PG8_LDA(At, 0, 1); PG8_STAGE(PG8_SA(0, 0), a2, voffA);
            PG8_BAR; PG8_WAIT_L(0); PG8_MMA(1, 0, At, B0); PG8_BAR; PG8_SCHED;
            PG8_STAGE(PG8_SB(0, 1), b2 + hstepB, voffB);
            PG8_WAIT_V(6); PG8_BAR; PG8_MMA(1, 1, At, B1); PG8_BAR;
            PG8_LDB(B0, 1, 0); PG8_SCHED; PG8_LDA(At, 1, 0); PG8_STAGE(PG8_SA(0, 1), a2 + hstepA, voffA);
            PG8_WAIT_L(8); PG8_BAR; PG8_WAIT_L(0); PG8_MMA(0, 0, At, B0); PG8_BAR; PG8_SCHED;
            PG8_LDB(B1, 1, 1); PG8_STAGE(PG8_SB(1, 0), b3, voffB);
            PG8_BAR; PG8_WAIT_L(0); PG8_MMA(0, 1, At, B1); PG8_BAR;
            PG8_LDA(At, 1, 1); PG8_STAGE(PG8_SA(1, 0), a3, voffA);
            PG8_BAR; PG8_WAIT_L(0); PG8_MMA(1, 0, At, B0); PG8_BAR; PG8_SCHED;
            PG8_STAGE(PG8_SB(1, 1), b3 + hstepB, voffB);
            PG8_WAIT_V(6); PG8_BAR; PG8_MMA(1, 1, At, B1); PG8_BAR;
        }
        E(acc, cur, wr, wc, fr, fq);
        if (!has_next) break;
#pragma unroll
        for (int a = 0; a < 2; ++a)
#pragma unroll
            for (int b = 0; b < 2; ++b)
#pragma unroll
                for (int m = 0; m < 4; ++m)
#pragma unroll
                    for (int n = 0; n < 2; ++n) acc[a][b][m][n] = (f32x4){0.f, 0.f, 0.f, 0.f};
        cur = nxt; cA = nA; cB = nB; ++ui;
    }
    PG8_WAIT_V(0);
    if (wr == 0) PG8_BAR;
    PG8_BAR;
#undef PG8_SA
#undef PG8_SB
#undef PG8_STAGE
#undef PG8_LDA
#undef PG8_LDB
#undef PG8_MMA
#undef PG8_WAIT_V
#undef PG8_WAIT_L
#undef PG8_BAR
#undef PG8_SCHED
}
}
using pg8::Unit;
typedef const f32x4 (&AccRef)[2][2][4][2];

__device__ __forceinline__ u32x4 pack8(f32x4 v0, f32x4 v1) { u32x4 w; w.x = cvt_pk_bf16(v0[0], v0[1]); w.y = cvt_pk_bf16(v0[2], v0[3]); w.z = cvt_pk_bf16(v1[0], v1[1]); w.w = cvt_pk_bf16(v1[2], v1[3]); return w; }
__device__ __forceinline__ void unpack8(u32x4 w, f32x4& a, f32x4& b) { a = (f32x4){lo_bf(w.x), hi_bf(w.x), lo_bf(w.y), hi_bf(w.y)}; b = (f32x4){lo_bf(w.z), hi_bf(w.z), lo_bf(w.w), hi_bf(w.w)}; }

struct EpiZ {
    static constexpr bool PERM = true;
    bf16_t* Z; float* out;
    __device__ __forceinline__ void operator()(AccRef acc, const Unit& u, int wr, int wc, int fr, int fq) const {
        const int row0 = u.pm * 256 + wr * 64 + fr, col0 = u.pn * 256 + wc * 32 + 8 * fq;
#pragma unroll
        for (int ai = 0; ai < 2; ++ai)
#pragma unroll
            for (int m = 0; m < 4; ++m) { bf16_t* rowp = Z + (size_t)(row0 + ai * 128 + m * 16) * ZLD + col0;
#pragma unroll
                for (int bj = 0; bj < 2; ++bj) *(u32x4*)(rowp + bj * 128) = pack8(acc[ai][bj][m][0], acc[ai][bj][m][1]); }
        const bool special = (u.pm >= 32) || ((u.pm & 7) == 7);
        if (special && u.pn < 18) {
#pragma unroll
            for (int ai = 0; ai < 2; ++ai)
#pragma unroll
                for (int m = 0; m < 4; ++m) {
                    const int r = row0 + ai * 128 + m * 16; const bool smp = r >= MP; const int b = smp ? (r - MP) >> 2 : r >> 11, t = smp ? (r - MP) & 3 : r & 2047;
#pragma unroll
                    for (int bj = 0; bj < 2; ++bj) { const int c = col0 + bj * 128; float* dst = nullptr;
                        if (c < DSH) { if (smp ? (t == 3) : (t == 2047)) dst = out + (smp ? O_SSHIFT : O_PSHIFT) + (size_t)b * DSH + c; }
                        else if (c >= ZC_P && c < ZC_P + 1024) { const int cc = c - ZC_P;
                            if (smp) dst = out + O_SPOOL + ((size_t)b * 15 + 11 + t) * 1024 + cc;
                            else if (t >= 2033) dst = out + O_PPOOL + ((size_t)b * 15 + (t - 2033)) * 1024 + cc; }
                        if (dst) { *(f32x4*)dst = acc[ai][bj][m][0]; *(f32x4*)(dst + 4) = acc[ai][bj][m][1]; } } }
        }
    }
};
struct EpiLR {
    static constexpr bool PERM = true;
    bf16_t* XW; const float* w0; const float* a0;
    __device__ __forceinline__ void operator()(AccRef acc, const Unit& u, int wr, int wc, int fr, int fq) const {
        const int sel = u.pn >> 2; const int row0 = u.pm * 256 + wr * 64 + fr, col0 = (u.pn & 3) * 256 + wc * 32 + 8 * fq;
        bf16_t* base = XW + (size_t)sel * ((size_t)M * 1024);
#pragma unroll
        for (int bj = 0; bj < 2; ++bj) { const int c = col0 + bj * 128; f32x4 b0 = (f32x4){0.f, 0.f, 0.f, 0.f}, b1 = b0;
            if (sel == 0) { b0 = *(const f32x4*)(w0 + c); b1 = *(const f32x4*)(w0 + c + 4); } else if (sel == 1) { b0 = *(const f32x4*)(a0 + c); b1 = *(const f32x4*)(a0 + c + 4); }
#pragma unroll
            for (int ai = 0; ai < 2; ++ai)
#pragma unroll
                for (int m = 0; m < 4; ++m) { f32x4 v0 = acc[ai][bj][m][0] + b0, v1 = acc[ai][bj][m][1] + b1;
                    if (sel == 1) {
#pragma unroll
                        for (int j = 0; j < 4; ++j) { v0[j] = sigmoidf_(v0[j]); v1[j] = sigmoidf_(v1[j]); } }
                    *(u32x4*)(base + (size_t)(row0 + ai * 128 + m * 16) * 1024 + c) = pack8(v0, v1); } }
    }
};
struct EpiPool {
    static constexpr bool PERM = true;
    bf16_t* YB; const float* scale;
    __device__ __forceinline__ void operator()(AccRef acc, const Unit& u, int wr, int wc, int fr, int fq) const {
        const int row0 = u.pm * 256 + wr * 64 + fr, col0 = u.pn * 256 + wc * 32 + 8 * fq;
#pragma unroll
        for (int bj = 0; bj < 2; ++bj) { const int c = col0 + bj * 128; const f32x4 s0 = *(const f32x4*)(scale + c), s1 = *(const f32x4*)(scale + c + 4);
#pragma unroll
            for (int ai = 0; ai < 2; ++ai)
#pragma unroll
                for (int m = 0; m < 4; ++m) *(u32x4*)(YB + (size_t)(row0 + ai * 128 + m * 16) * 1024 + c) = pack8(acc[ai][bj][m][0] * s0, acc[ai][bj][m][1] * s1); }
    }
};
struct EpiGateB {
    static constexpr bool PERM = true;
    bf16_t* MM; const bf16_t* Z;
    __device__ __forceinline__ void operator()(AccRef acc, const Unit& u, int wr, int wc, int fr, int fq) const {
        const int row0 = u.pm * 256 + wr * 64 + fr, col0 = u.pn * 256 + wc * 32 + 8 * fq;
#pragma unroll
        for (int ai = 0; ai < 2; ++ai)
#pragma unroll
            for (int bj = 0; bj < 2; ++bj) { const int c = col0 + bj * 128;
                u32x4 gz[4];
#pragma unroll
                for (int m = 0; m < 4; ++m) gz[m] = *(const u32x4*)((const char*)Z + ((unsigned)(row0 + ai * 128 + m * 16) * (unsigned)ZLD + (unsigned)(ZC_GB + c)) * 2u);
#pragma unroll
                for (int m = 0; m < 4; ++m) { const int r = row0 + ai * 128 + m * 16; f32x4 g0, g1; unpack8(gz[m], g0, g1);
#pragma unroll
                    for (int j = 0; j < 4; ++j) { g0[j] = sigmoidf_(g0[j]); g1[j] = sigmoidf_(g1[j]); }
                    *(u32x4*)(MM + (size_t)r * DM + c) = pack8(g0 * acc[ai][bj][m][0], g1 * acc[ai][bj][m][1]); } }
    }
};
struct EpiGateA {
    static constexpr bool PERM = true;
    const bf16_t* Z; bf16_t* MM;
    __device__ __forceinline__ void operator()(AccRef acc, const Unit& u, int wr, int wc, int fr, int fq) const {
        const int row0 = u.pm * 256 + wr * 64 + fr, col0 = u.pn * 256 + wc * 32 + 8 * fq;
#pragma unroll
        for (int ai = 0; ai < 2; ++ai)
#pragma unroll
            for (int bj = 0; bj < 2; ++bj) { const int c = col0 + bj * 128;
                u32x4 gz[4], pm[4];
#pragma unroll
                for (int m = 0; m < 4; ++m) { const unsigned r = (unsigned)(row0 + ai * 128 + m * 16);
                    gz[m] = *(const u32x4*)((const char*)Z + (r * (unsigned)ZLD + (unsigned)(ZC_GA + c)) * 2u);
                    pm[m] = *(const u32x4*)((const char*)MM + (r * (unsigned)DM + (unsigned)c) * 2u); }
#pragma unroll
                for (int m = 0; m < 4; ++m) { const int r = row0 + ai * 128 + m * 16; f32x4 g0, g1, p0, p1; unpack8(gz[m], g0, g1); unpack8(pm[m], p0, p1);
#pragma unroll
                    for (int j = 0; j < 4; ++j) { g0[j] = sigmoidf_(g0[j]); g1[j] = sigmoidf_(g1[j]); }
                    *(u32x4*)(MM + (size_t)r * DM + c) = pack8(p0 + g0 * acc[ai][bj][m][0], p1 + g1 * acc[ai][bj][m][1]); } }
    }
};
struct EpiOutP {
    static constexpr bool PERM = true;
    bf16_t* C; float* P;
    __device__ __forceinline__ void operator()(AccRef acc, const Unit& u, int wr, int wc, int fr, int fq) const {
        const int row0 = u.pm * 256 + wr * 64 + fr, col0 = u.pn * 256 + wc * 32 + 8 * fq;
#pragma unroll
        for (int ai = 0; ai < 2; ++ai)
#pragma unroll
            for (int m = 0; m < 4; ++m) { const int r = row0 + ai * 128 + m * 16;
#pragma unroll
                for (int bj = 0; bj < 2; ++bj) { const int c = col0 + bj * 128;
                    if (u.sp < 0) *(u32x4*)(C + (size_t)r * DM + c) = pack8(acc[ai][bj][m][0], acc[ai][bj][m][1]);
                    else { float* pp = P + ((size_t)u.sp * 512 + (r - MP)) * DM + c; *(f32x4*)pp = acc[ai][bj][m][0]; *(f32x4*)(pp + 4) = acc[ai][bj][m][1]; } } }
    }
};
struct EpiGate7 {
    static constexpr bool PERM = true;
    bf16_t* G; float* out;
    __device__ __forceinline__ void operator()(AccRef acc, const Unit& u, int wr, int wc, int fr, int fq) const {
        const int row0 = u.pm * 256 + wr * 64 + fr, col0 = u.pn * 256 + wc * 32 + 8 * fq;
#pragma unroll
        for (int ai = 0; ai < 2; ++ai)
#pragma unroll
            for (int m = 0; m < 4; ++m) { bf16_t* rowp = G + (size_t)(row0 + ai * 128 + m * 16) * DFF + col0;
#pragma unroll
                for (int bj = 0; bj < 2; ++bj) *(u32x4*)(rowp + bj * 128) = pack8(acc[ai][bj][m][0], acc[ai][bj][m][1]); }
        const bool special = (u.pm >= 32) || ((u.pm & 7) == 7);
        if (special) {
#pragma unroll
            for (int ai = 0; ai < 2; ++ai)
#pragma unroll
                for (int m = 0; m < 4; ++m) {
                    const int r = row0 + ai * 128 + m * 16; const bool smp = r >= MP; const int b = smp ? (r - MP) >> 2 : r >> 11, t = smp ? (r - MP) & 3 : r & 2047;
                    const int j = smp ? t - 2 : t - 2046;
                    if (j >= 0) {
#pragma unroll
                        for (int bj = 0; bj < 2; ++bj) { float* dst = out + (smp ? O_SCONV : O_PCONV) + ((size_t)b * 2 + j) * DFF + col0 + bj * 128;
                            *(f32x4*)dst = acc[ai][bj][m][0]; *(f32x4*)(dst + 4) = acc[ai][bj][m][1]; } } }
        }
    }
};
struct EpiAct {
    static constexpr bool PERM = true;
    const bf16_t* G; bf16_t* ACT; const float* cw; const float* cb; const float* conv0;
    __device__ __forceinline__ void operator()(AccRef acc, const Unit& u, int wr, int wc, int fr, int fq) const {
        const int row0 = u.pm * 256 + wr * 64 + fr, col0 = u.pn * 256 + wc * 32 + 8 * fq;
        const bool smp_tile = u.pm >= 32;
#pragma unroll
        for (int bj = 0; bj < 2; ++bj) { const int c = col0 + bj * 128;
            const f32x4 w0a = *(const f32x4*)(cw + c), w0b = *(const f32x4*)(cw + c + 4), w1a = *(const f32x4*)(cw + DFF + c), w1b = *(const f32x4*)(cw + DFF + c + 4);
            const f32x4 w2a = *(const f32x4*)(cw + 2 * DFF + c), w2b = *(const f32x4*)(cw + 2 * DFF + c + 4), cba = *(const f32x4*)(cb + c), cbb = *(const f32x4*)(cb + c + 4);
#pragma unroll
            for (int ai = 0; ai < 2; ++ai) {
                u32x4 q2[4], q1[4], q0[4];
#pragma unroll
                for (int m = 0; m < 4; ++m) { const unsigned off = (unsigned)((row0 + ai * 128 + m * 16) * DFF + c) * 2u;
                    q2[m] = *(const u32x4*)((const char*)G + off);
                    u32x4 e1 = (u32x4){0u, 0u, 0u, 0u}, e0 = e1;
                    if (fr < 1) e1 = *(const u32x4*)((const char*)(G - DFF) + off);
                    if (fr < 2) e0 = *(const u32x4*)((const char*)(G - 2 * DFF) + off);
                    q1[m] = e1; q0[m] = e0; }
#pragma unroll
                for (int m = 0; m < 4; ++m) {
#pragma unroll
                    for (int wd = 0; wd < 4; ++wd) { q1[m][wd] = __builtin_amdgcn_update_dpp(q1[m][wd], q2[m][wd], 0x111, 0xF, 0xF, false);
                                                     q0[m][wd] = __builtin_amdgcn_update_dpp(q0[m][wd], q2[m][wd], 0x112, 0xF, 0xF, false); } }
#pragma unroll
                for (int m = 0; m < 4; ++m) {
                    const int r = row0 + ai * 128 + m * 16; const bool smp = r >= MP; const int b = smp ? (r - MP) >> 2 : r >> 11, t = smp ? (r - MP) & 3 : r & 2047;
                    f32x4 x2a, x2b, x1a, x1b, x0a, x0b;
                    unpack8(q2[m], x2a, x2b); unpack8(q1[m], x1a, x1b); unpack8(q0[m], x0a, x0b);
                    if (t < 1) { x1a = (f32x4){0.f, 0.f, 0.f, 0.f}; x1b = x1a; }
                    if (t < 2) { x0a = (f32x4){0.f, 0.f, 0.f, 0.f}; x0b = x0a; }
                    if (smp_tile) {
                        if (t < 1) { x1a = *(const f32x4*)(conv0 + ((size_t)b * 2 + 1) * DFF + c); x1b = *(const f32x4*)(conv0 + ((size_t)b * 2 + 1) * DFF + c + 4); }
                        if (t < 2) { x0a = *(const f32x4*)(conv0 + ((size_t)b * 2 + t) * DFF + c); x0b = *(const f32x4*)(conv0 + ((size_t)b * 2 + t) * DFF + c + 4); }
                    }
                    f32x4 ca = cba + w0a * x0a + w1a * x1a + w2a * x2a, cbv = cbb + w0b * x0b + w1b * x1b + w2b * x2b;
#pragma unroll
                    for (int j = 0; j < 4; ++j) { ca[j] = gelu_tanh(ca[j]); cbv[j] = gelu_tanh(cbv[j]); }
                    *(u32x4*)(ACT + (size_t)r * DFF + c) = pack8(ca * acc[ai][bj][m][0], cbv * acc[ai][bj][m][1]); }
            }
        }
    }
};

constexpr int TP = 136;
template <class Map>
__device__ __forceinline__ void transpose_job(const float* src, int ldsrc, int Ksrc, bf16_t* dst, int Kd, int Nd, Map map, float* tilef, int bid, int nblk) {
    int tid = threadIdx.x; asm volatile("" : "+v"(tid));
    LAS unsigned char* tile = (LAS unsigned char*)tilef;
    const int ntk = Kd / 128, ntn = Nd / 128, ntot = ntk * ntn;
    const int n4 = tid & 31, kp0 = tid >> 5;
    const int rn = tid >> 2, rq = tid & 3;
    f32x4 va[4], vb[4];
    auto load = [&](int ti) {
        const int tn = ti / ntk, tk = ti - tn * ntk; const int sc = map(tn * 128 + n4 * 4);
#pragma unroll
        for (int i = 0; i < 4; ++i) { const int k = tk * 128 + 2 * (kp0 + 16 * i);
            va[i] = (sc >= 0 && k < Ksrc) ? *(const f32x4*)(src + (size_t)k * ldsrc + sc) : (f32x4){0.f, 0.f, 0.f, 0.f};
            vb[i] = (sc >= 0 && k + 1 < Ksrc) ? *(const f32x4*)(src + (size_t)(k + 1) * ldsrc + sc) : (f32x4){0.f, 0.f, 0.f, 0.f}; }
    };
    int ti = bid;
    if (ti < ntot) load(ti);
    for (; ti < ntot; ti += nblk) {
        const int tn = ti / ntk, tk = ti - tn * ntk;
#pragma unroll
        for (int i = 0; i < 4; ++i) { const int kp = kp0 + 16 * i;
#pragma unroll
            for (int j = 0; j < 4; ++j) *(LAS unsigned*)(tile + ((n4 * 4 + j) * TP + 2 * kp) * 2) = cvt_pk_bf16(va[i][j], vb[i][j]); }
        __syncthreads();
        if (ti + nblk < ntot) load(ti + nblk);
        bf16_t* drow = dst + (size_t)(tn * 128 + rn) * Kd + tk * 128 + rq * 32;
#pragma unroll
        for (int i = 0; i < 4; ++i) *(u32x4*)(drow + i * 8) = *(const LAS u32x4*)(tile + (rn * TP + rq * 32 + i * 8) * 2);
        __syncthreads();
    }
}
struct MapId { __device__ int operator()(int n) const { return n; } };
struct MapWin { __device__ int operator()(int n) const { return n < DSH ? n : (n < ZC_P ? -1 : n - (ZC_P - DSH)); } };

__device__ __forceinline__ float z_shift(KArgP p, const bf16_t* Z, int r, int zc) {
    const float z = bf2f(Z[(size_t)r * ZLD + zc]);
    const bool smp = r >= MP; const int t = smp ? (r - MP) & 3 : r & 2047;
    float pv;
    if (t > 0) pv = bf2f(Z[(size_t)(r - 1) * ZLD + zc]); else pv = smp ? p->in[2][(size_t)((r - MP) >> 2) * DSH + zc] : 0.f;
    return z + (pv - z) * p->in[8][zc];
}

struct HeadConst { float mu_r, mu_k, mu_v, k_k, k_a, r_k; };
__device__ __forceinline__ void stage_token(float zr, float zk, float zv, float pr, float pk, float pv, float xw, float a, float g, const HeadConst& hc, float* o, float* bon, int lane) {
    const float r = zr + (pr - zr) * hc.mu_r, k = zk + (pk - zk) * hc.mu_k, v = zv + (pv - zv) * hc.mu_v;
    const float y = -xw;
    const float sp = fmaxf(y, 0.f) + __logf(1.0f + __expf(-fabsf(y)));
    const float dec = __expf(-__expf(-sp - 0.5f));
    const float kr = k * hc.k_k; const float n2 = wave_sum(kr * kr); const float kk = kr * rsqrtf(fmaxf(n2, 1e-24f));
    const float kp = k * (1.0f + (a - 1.0f) * hc.k_a);
    const float bs = wave_sum(r * kp * hc.r_k);
    o[0 * 64 + lane] = dec; o[1 * 64 + lane] = kk; o[2 * 64 + lane] = kk * a; o[3 * 64 + lane] = kp; o[4 * 64 + lane] = r; o[5 * 64 + lane] = v; o[6 * 64 + lane] = g;
    if (lane == 0) *bon = bs;
}

constexpr int ST = 72;
constexpr int L_AT = 0, L_BT = 9216, L_KT = 18432, L_RT = 27648, L_ATT = 36864, L_VMT = 46080, L_BGT = 55296, L_KGT = 64512,
              L_LOFF = 73728, L_LAK = 82944, L_MRB = 92160, L_MRK = 101376, L_LDIAG = 110592, L_CUM = 114688;
constexpr int L_TBD = L_CUM, L_SOLT = L_BT;
constexpr size_t SC_PF = 0, SC_QF = (size_t)2048 * 8192, SC_W2F = (size_t)2 * 2048 * 8192, SC_YLF = (size_t)3 * 2048 * 8192, SC_GAM = (size_t)4 * 2048 * 8192, SC_BON = SC_GAM + (size_t)2048 * 256;

__device__ __forceinline__ bf16x8 frag(LAS unsigned char* lds, int off, int row0, int ks, int lane) {
    return *(const LAS bf16x8*)(lds + off + ((row0 + (lane & 15)) * ST + ks * 32 + (lane >> 4) * 8) * 2);
}
__device__ __forceinline__ void st4(LAS unsigned char* lds, int off, int row, int col, f32x4 v) {
    u32x2 w; w.x = cvt_pk_bf16(v[0], v[1]); w.y = cvt_pk_bf16(v[2], v[3]); *(LAS u32x2*)(lds + off + (row * ST + col) * 2) = w;
}
__device__ __forceinline__ f32x4 ld4(LAS unsigned char* lds, int off, int row, int col) {
    const u32x2 w = *(const LAS u32x2*)(lds + off + (row * ST + col) * 2); return (f32x4){lo_bf(w.x), hi_bf(w.x), lo_bf(w.y), hi_bf(w.y)};
}
#define MFMA16(x, y, acc) __builtin_amdgcn_mfma_f32_16x16x32_bf16((x), (y), (acc), 0, 0, 0)
#define LDS_FENCE() asm volatile("s_waitcnt lgkmcnt(0)" ::: "memory")

__device__ __forceinline__ void wkv_pass_a(KArgP p, int cu, LAS unsigned char* lds) {
    int tid = threadIdx.x; asm volatile("" : "+v"(tid));
    const int w = __builtin_amdgcn_readfirstlane(tid >> 6), lane = tid & 63, q = lane >> 4, l15 = lane & 15;
    const int bh = cu >> 5, c = cu & 31, b = bh >> 4, h = bh & 15, ch = h * 64 + lane;
    const bf16_t* Z = (const bf16_t*)(p->ws + W_Z); const bf16_t* XW = (const bf16_t*)(p->ws + W_XW); const bf16_t* XA = (const bf16_t*)(p->ws + W_XA);
    unsigned char* sc = p->ws + W_RA;
    const int row0 = b * 2048 + c * 64 + w * 8;
    float kk[8], bb[8], kp[8], rr[8], vv[8], ld[8];
    {
        const float mu_r = p->in[8][ch], mu_k = p->in[8][1024 + ch], mu_v = p->in[8][2048 + ch], k_k = p->in[14][ch], k_a = p->in[15][ch], r_k = p->in[16][ch];
        float pz[3];
        const bool first = (c == 0 && w == 0);
#pragma unroll
        for (int qq = 0; qq < 3; ++qq) pz[qq] = first ? 0.f : bf2f(Z[(size_t)(row0 - 1) * ZLD + qq * 1024 + ch]);
        float bon[8];
#pragma unroll
        for (int i = 0; i < 8; ++i) {
            float z[3];
#pragma unroll
            for (int qq = 0; qq < 3; ++qq) z[qq] = bf2f(Z[(size_t)(row0 + i) * ZLD + qq * 1024 + ch]);
            const float xw = bf2f(XW[(size_t)(row0 + i) * 1024 + ch]), a = bf2f(XA[(size_t)(row0 + i) * 1024 + ch]);
            const float r = z[0] + (pz[0] - z[0]) * mu_r, k = z[1] + (pz[1] - z[1]) * mu_k, v = z[2] + (pz[2] - z[2]) * mu_v;
#pragma unroll
            for (int qq = 0; qq < 3; ++qq) pz[qq] = z[qq];
            const float y = -xw; const float sp = fmaxf(y, 0.f) + __logf(1.0f + __expf(-fabsf(y)));
            ld[i] = -__expf(-sp - 0.5f);
            const float kr = k * k_k; const float n2 = wave_sum(kr * kr); kk[i] = kr * rsqrtf(fmaxf(n2, 1e-24f));
            kp[i] = k * (1.0f + (a - 1.0f) * k_a); bb[i] = kk[i] * a; rr[i] = r; vv[i] = v;
            bon[i] = wave_sum(r * kp[i] * r_k);
        }
        { float tot = 0.f;
#pragma unroll
          for (int i = 0; i < 8; ++i) tot += ld[i];
          *(LAS float*)(lds + L_CUM + (w * 64 + lane) * 4) = tot; }
        if (lane < 8) { float bv = bon[0];
#pragma unroll
            for (int i = 1; i < 8; ++i) bv = (lane == i) ? bon[i] : bv;
            *(float*)(sc + SC_BON + (size_t)cu * 256 + (w * 8 + lane) * 4) = bv; }
    }
    __syncthreads();
    float cum[8], cumC;
    {
        float base = 0.f, all = 0.f;
#pragma unroll
        for (int seg = 0; seg < 8; ++seg) { const float tq = *(const LAS float*)(lds + L_CUM + (seg * 64 + lane) * 4); all += tq; base += (seg < w) ? tq : 0.f; }
        float acc = base;
#pragma unroll
        for (int i = 0; i < 8; ++i) { acc += ld[i]; cum[i] = acc; }
        cumC = all;
    }
    if (w == 0) *(float*)(sc + SC_GAM + (size_t)cu * 256 + lane * 4) = __expf(cumC);
    {
        float att[8], bgt[8], kgt[8];
#pragma unroll
        for (int i = 0; i < 8; ++i) {
            const int t = w * 8 + i; const float ep = __expf(cum[i]), em = __expf(-cum[i]), eg = __expf(cumC - cum[i]);
            att[i] = -kk[i] * __expf(cum[i] - ld[i]); bgt[i] = bb[i] * eg; kgt[i] = kp[i] * eg;
            *(LAS bf16_t*)(lds + L_AT + (t * ST + lane) * 2) = f2bf(att[i]);
            *(LAS bf16_t*)(lds + L_RT + (t * ST + lane) * 2) = f2bf(rr[i] * ep);
            *(LAS bf16_t*)(lds + L_BT + (t * ST + lane) * 2) = f2bf(bb[i] * em);
            *(LAS bf16_t*)(lds + L_KT + (t * ST + lane) * 2) = f2bf(kp[i] * em);
        }
        u32x4 x;
        x.x = cvt_pk_bf16(att[0], att[1]); x.y = cvt_pk_bf16(att[2], att[3]); x.z = cvt_pk_bf16(att[4], att[5]); x.w = cvt_pk_bf16(att[6], att[7]); *(LAS u32x4*)(lds + L_ATT + (lane * ST + w * 8) * 2) = x;
        x.x = cvt_pk_bf16(vv[0], vv[1]); x.y = cvt_pk_bf16(vv[2], vv[3]); x.z = cvt_pk_bf16(vv[4], vv[5]); x.w = cvt_pk_bf16(vv[6], vv[7]); *(LAS u32x4*)(lds + L_VMT + (lane * ST + w * 8) * 2) = x;
        x.x = cvt_pk_bf16(bgt[0], bgt[1]); x.y = cvt_pk_bf16(bgt[2], bgt[3]); x.z = cvt_pk_bf16(bgt[4], bgt[5]); x.w = cvt_pk_bf16(bgt[6], bgt[7]); *(LAS u32x4*)(lds + L_BGT + (lane * ST + w * 8) * 2) = x;
        x.x = cvt_pk_bf16(kgt[0], kgt[1]); x.y = cvt_pk_bf16(kgt[2], kgt[3]); x.z = cvt_pk_bf16(kgt[4], kgt[5]); x.w = cvt_pk_bf16(kgt[6], kgt[7]); *(LAS u32x4*)(lds + L_KGT + (lane * ST + w * 8) * 2) = x;
    }
    __syncthreads();
    for (int i = tid; i < 9216 / 16; i += NTHR) *(LAS u32x4*)(lds + L_TBD + i * 16) = (u32x4){0u, 0u, 0u, 0u};
    {
        const int jt = w & 3, isR = w >> 2; const int yoff = isR ? L_RT : L_AT;
        const bf16x8 y0 = frag(lds, yoff, 16 * jt, 0, lane), y1 = frag(lds, yoff, 16 * jt, 1, lane);
        const int t = 16 * jt + l15;
#pragma unroll
        for (int xt = 0; xt < 8; ++xt) {
            const int isK = xt >> 2, it = xt & 3; const int xoff = isK ? L_KT : L_BT;
            f32x4 acc = (f32x4){0.f, 0.f, 0.f, 0.f};
            if (it <= jt) { acc = MFMA16(frag(lds, xoff, 16 * it, 0, lane), y0, acc); acc = MFMA16(frag(lds, xoff, 16 * it, 1, lane), y1, acc); }
#pragma unroll
            for (int i = 0; i < 4; ++i) { const int s = 16 * it + 4 * q + i; const bool keep = isR ? (s <= t) : (s < t); acc[i] = keep ? acc[i] : 0.f; }
            const int dst = isR ? (isK ? L_MRK : L_MRB) : (isK ? L_LAK : L_LOFF);
            if (!isR && !isK && it == jt) { *(LAS f32x4*)(lds + L_LDIAG + ((jt * 16 + l15) * 16 + 4 * q) * 4) = acc; acc = (f32x4){0.f, 0.f, 0.f, 0.f}; }
            st4(lds, dst, t, 16 * it + 4 * q, acc);
        }
    }
    __syncthreads();
    f32x4 xacc[4];
#pragma unroll
    for (int i = 0; i < 4; ++i) xacc[i] = (f32x4){0.f, 0.f, 0.f, 0.f};
    if (w == 0) {
        const int blk = q, j = l15; float tc[16];
#pragma unroll
        for (int t = 0; t < 16; ++t) {
            float acc = (t == j) ? 1.0f : 0.0f;
            f32x4 lr[4];
#pragma unroll
            for (int g = 0; g < 4; ++g) lr[g] = *(const LAS f32x4*)(lds + L_LDIAG + ((blk * 16 + t) * 16 + g * 4) * 4);
#pragma unroll
            for (int s = 0; s < t; ++s) acc += lr[s >> 2][s & 3] * tc[s];
            tc[t] = acc;
            *(LAS bf16_t*)(lds + L_TBD + ((16 * blk + t) * ST + 16 * blk + j) * 2) = f2bf(acc);
        }
    } else if (w >= 4) {
        const int vt = w - 4;
#pragma unroll
        for (int i = 0; i < 4; ++i)
#pragma unroll
            for (int ks = 0; ks < 2; ++ks) xacc[i] = MFMA16(frag(lds, L_LAK, 16 * i, ks, lane), frag(lds, L_VMT, 16 * vt, ks, lane), xacc[i]);
    }
    __syncthreads();
    {
        const int crow = 16 * w + l15;
#pragma unroll
        for (int i = 0; i < 4; ++i) {
            f32x4 acc = (w < 4) ? ld4(lds, L_ATT, crow, 16 * i + 4 * q) : xacc[i];
#pragma unroll
            for (int ks = 0; ks < 2; ++ks) acc = MFMA16(frag(lds, L_LOFF, 16 * i, ks, lane), frag(lds, L_SOLT, 16 * w, ks, lane), acc);
            st4(lds, L_SOLT, crow, 16 * i + 4 * q, acc);
            LDS_FENCE();
            f32x4 acc2 = (f32x4){0.f, 0.f, 0.f, 0.f};
#pragma unroll
            for (int ks = 0; ks < 2; ++ks) acc2 = MFMA16(frag(lds, L_TBD, 16 * i, ks, lane), frag(lds, L_SOLT, 16 * w, ks, lane), acc2);
            st4(lds, L_SOLT, crow, 16 * i + 4 * q, acc2);
            LDS_FENCE();
        }
    }
    __syncthreads();
    {
        const int a = w >> 1, pr = w & 1;
        { f32x4 acc[2];
#pragma unroll
            for (int u = 0; u < 2; ++u) { const int kt = 2 * pr + u; acc[u] = ld4(lds, L_RT, 16 * a + l15, 16 * kt + 4 * q);
#pragma unroll
                for (int ks = 0; ks < 2; ++ks) acc[u] = MFMA16(frag(lds, L_SOLT, 16 * kt, ks, lane), frag(lds, L_MRB, 16 * a, ks, lane), acc[u]); }
            *(u32x4*)(sc + SC_W2F + (size_t)cu * 8192 + ((a * 2 + pr) * 64 + lane) * 16) = pack8(acc[0], acc[1]); }
#pragma unroll
        for (int u = 0; u < 2; ++u) { const int vt = 2 * pr + u; f32x4 acc = (f32x4){0.f, 0.f, 0.f, 0.f};
#pragma unroll
            for (int ks = 0; ks < 2; ++ks) { acc = MFMA16(frag(lds, L_SOLT, 64 + 16 * vt, ks, lane), frag(lds, L_MRB, 16 * a, ks, lane), acc); acc = MFMA16(frag(lds, L_VMT, 16 * vt, ks, lane), frag(lds, L_MRK, 16 * a, ks, lane), acc); }
            u32x2 o; o.x = cvt_pk_bf16(acc[0], acc[1]); o.y = cvt_pk_bf16(acc[2], acc[3]);
            *(u32x2*)(sc + SC_YLF + (size_t)cu * 8192 + ((vt * 4 + a) * 64 + lane) * 8) = o; }
        { f32x4 acc[2];
#pragma unroll
            for (int u = 0; u < 2; ++u) { const int kt = 2 * pr + u; acc[u] = (f32x4){0.f, 0.f, 0.f, 0.f};
#pragma unroll
                for (int ks = 0; ks < 2; ++ks) acc[u] = MFMA16(frag(lds, L_SOLT, 16 * kt, ks, lane), frag(lds, L_BGT, 16 * a, ks, lane), acc[u]); }
            *(u32x4*)(sc + SC_PF + (size_t)cu * 8192 + ((a * 2 + pr) * 64 + lane) * 16) = pack8(acc[0], acc[1]); }
#pragma unroll
        for (int u = 0; u < 2; ++u) { const int vt = 2 * pr + u; f32x4 acc = (f32x4){0.f, 0.f, 0.f, 0.f};
#pragma unroll
            for (int ks = 0; ks < 2; ++ks) { acc = MFMA16(frag(lds, L_BGT, 16 * a, ks, lane), frag(lds, L_SOLT, 64 + 16 * vt, ks, lane), acc); acc = MFMA16(frag(lds, L_KGT, 16 * a, ks, lane), frag(lds, L_VMT, 16 * vt, ks, lane), acc); }
            u32x2 o; o.x = cvt_pk_bf16(acc[0], acc[1]); o.y = cvt_pk_bf16(acc[2], acc[3]);
            *(u32x2*)(sc + SC_QF + (size_t)cu * 8192 + ((a * 4 + vt) * 64 + lane) * 8) = o; }
    }
    __syncthreads();
}

__device__ __forceinline__ void wkv_pass_b(KArgP p, int task, int lane) {
    const int bh = task >> 2, vs = task & 3, q = lane >> 4, l15 = lane & 15;
    const unsigned char* sc = p->ws + W_RA; unsigned char* sf = p->ws + W_SF;
    f32x4 S[4];
#pragma unroll
    for (int m = 0; m < 4; ++m) S[m] = (f32x4){0.f, 0.f, 0.f, 0.f};
    for (int c = 0; c < 32; ++c) {
        const int cu = bh * 32 + c;
        u32x4 pf[4][2]; u32x2 qf[4]; f32x4 gm[4];
#pragma unroll
        for (int m = 0; m < 4; ++m) {
#pragma unroll
            for (int ks = 0; ks < 2; ++ks) pf[m][ks] = *(const u32x4*)(sc + SC_PF + (size_t)cu * 8192 + ((m * 2 + ks) * 64 + lane) * 16);
            qf[m] = *(const u32x2*)(sc + SC_QF + (size_t)cu * 8192 + ((m * 4 + vs) * 64 + lane) * 8);
            gm[m] = *(const f32x4*)(sc + SC_GAM + (size_t)cu * 256 + (16 * m + 4 * q) * 4);
        }
        u32x4 sfr[2];
#pragma unroll
        for (int ks = 0; ks < 2; ++ks) { sfr[ks] = pack8(S[2 * ks], S[2 * ks + 1]); *(u32x4*)(sf + (size_t)cu * 8192 + ((vs * 2 + ks) * 64 + lane) * 16) = sfr[ks]; }
#pragma unroll
        for (int m = 0; m < 4; ++m) {
            f32x4 acc = S[m] * gm[m] + (f32x4){lo_bf(qf[m].x), hi_bf(qf[m].x), lo_bf(qf[m].y), hi_bf(qf[m].y)};
#pragma unroll
            for (int ks = 0; ks < 2; ++ks) { bf16x8 av, bv; __builtin_memcpy(&av, &pf[m][ks], 16); __builtin_memcpy(&bv, &sfr[ks], 16); acc = MFMA16(av, bv, acc); }
            S[m] = acc;
        }
    }
#pragma unroll
    for (int m = 0; m < 4; ++m) *(f32x4*)(p->out + O_PWKV + ((size_t)bh * 64 + 16 * vs + l15) * 64 + 16 * m + 4 * q) = S[m];
}

__device__ __forceinline__ void wkv_pass_c(KArgP p, int cu, int jt, int lane) {
    const int bh = cu >> 5, c = cu & 31, b = bh >> 4, h = bh & 15, q = lane >> 4, l15 = lane & 15;
    const unsigned char* sc = p->ws + W_RA; const unsigned char* sf = p->ws + W_SF;
    const bf16_t* Z = (const bf16_t*)(p->ws + W_Z); const bf16_t* GG = (const bf16_t*)(p->ws + W_GG); bf16_t* YA = (bf16_t*)(p->ws + W_DYA);
    const int t = c * 64 + 16 * jt + l15; const int row = b * 2048 + t;
    bf16x8 w2[2], sfr[4][2]; u32x2 yl[4], zc[4], zp[4], gz[4];
#pragma unroll
    for (int ks = 0; ks < 2; ++ks) w2[ks] = *(const bf16x8*)(sc + SC_W2F + (size_t)cu * 8192 + ((jt * 2 + ks) * 64 + lane) * 16);
#pragma unroll
    for (int vt = 0; vt < 4; ++vt) { const int chv = h * 64 + 16 * vt + 4 * q;
        yl[vt] = *(const u32x2*)(sc + SC_YLF + (size_t)cu * 8192 + ((vt * 4 + jt) * 64 + lane) * 8);
#pragma unroll
        for (int ks = 0; ks < 2; ++ks) sfr[vt][ks] = *(const bf16x8*)(sf + (size_t)cu * 8192 + ((vt * 2 + ks) * 64 + lane) * 16);
        zc[vt] = *(const u32x2*)(Z + (size_t)row * ZLD + 2048 + chv);
        zp[vt] = (t > 0) ? *(const u32x2*)(Z + (size_t)(row - 1) * ZLD + 2048 + chv) : (u32x2){0u, 0u};
        gz[vt] = *(const u32x2*)(GG + (size_t)row * 1024 + chv); }
    const float bon = *(const float*)(sc + SC_BON + (size_t)cu * 256 + (16 * jt + l15) * 4);
    f32x4 y[4]; float s1 = 0.f;
#pragma unroll
    for (int vt = 0; vt < 4; ++vt) {
        f32x4 acc = (f32x4){lo_bf(yl[vt].x), hi_bf(yl[vt].x), lo_bf(yl[vt].y), hi_bf(yl[vt].y)};
#pragma unroll
        for (int ks = 0; ks < 2; ++ks) acc = MFMA16(sfr[vt][ks], w2[ks], acc);
        y[vt] = acc; s1 += (acc[0] + acc[1]) + (acc[2] + acc[3]);
    }
    s1 = xor32_sum(xor16_sum(s1)); const float mu = s1 * (1.0f / 64.0f);
    float s2 = 0.f;
#pragma unroll
    for (int vt = 0; vt < 4; ++vt) { y[vt] -= mu; s2 += (y[vt][0] * y[vt][0] + y[vt][1] * y[vt][1]) + (y[vt][2] * y[vt][2] + y[vt][3] * y[vt][3]); }
    s2 = xor32_sum(xor16_sum(s2)); const float rstd = rsqrtf(s2 * (1.0f / 64.0f) + GN_EPS);
#pragma unroll
    for (int vt = 0; vt < 4; ++vt) {
        const int chv = h * 64 + 16 * vt + 4 * q;
        const f32x4 zv = (f32x4){lo_bf(zc[vt].x), hi_bf(zc[vt].x), lo_bf(zc[vt].y), hi_bf(zc[vt].y)}, pv = (f32x4){lo_bf(zp[vt].x), hi_bf(zp[vt].x), lo_bf(zp[vt].y), hi_bf(zp[vt].y)};
        const f32x4 muv = *(const f32x4*)(p->in[8] + 2048 + chv); const f32x4 vm = zv + (pv - zv) * muv;
        const f32x4 g = (f32x4){lo_bf(gz[vt].x), hi_bf(gz[vt].x), lo_bf(gz[vt].y), hi_bf(gz[vt].y)};
        const f32x4 lw = *(const f32x4*)(p->in[17] + chv), lb = *(const f32x4*)(p->in[18] + chv);
        const f32x4 o = ((y[vt] * rstd) * lw + lb + bon * vm) * g;
        u32x2 ow; ow.x = cvt_pk_bf16(o[0], o[1]); ow.y = cvt_pk_bf16(o[2], o[3]);
        *(u32x2*)(YA + (size_t)row * 1024 + chv) = ow;
    }
}

__device__ __forceinline__ void scan_sample(KArgP p, int unit, float* lds) {
    int tid = threadIdx.x; asm volatile("" : "+v"(tid));
    const int wave = tid >> 6, lane = tid & 63, b = unit >> 4, h = unit & 15, ch = h * 64 + lane;
    const bf16_t* Z = (const bf16_t*)(p->ws + W_Z); const bf16_t* XW = (const bf16_t*)(p->ws + W_XW); const bf16_t* XA = (const bf16_t*)(p->ws + W_XA); const bf16_t* GG = (const bf16_t*)(p->ws + W_GG);
    bf16_t* YA = (bf16_t*)(p->ws + W_DYA);
    float* ops = lds + wave * (4 * 7 * 64 + 64);
    float* bon = ops + 4 * 7 * 64;
    HeadConst hc; hc.mu_r = p->in[8][ch]; hc.mu_k = p->in[8][1024 + ch]; hc.mu_v = p->in[8][2048 + ch]; hc.k_k = p->in[14][ch]; hc.k_a = p->in[15][ch]; hc.r_k = p->in[16][ch];
    const float lw = p->in[17][ch], lb = p->in[18][ch];
    const int rbase = MP + b * 4;
    float pz[3];
#pragma unroll
    for (int q = 0; q < 3; ++q) pz[q] = p->in[2][(size_t)b * DSH + q * 1024 + ch];
#pragma unroll
    for (int t = 0; t < 4; ++t) {
        float z[3];
#pragma unroll
        for (int q = 0; q < 3; ++q) z[q] = bf2f(Z[(size_t)(rbase + t) * ZLD + q * 1024 + ch]);
        const size_t ro = (size_t)(rbase + t) * 1024 + ch;
        stage_token(z[0], z[1], z[2], pz[0], pz[1], pz[2], bf2f(XW[ro]), bf2f(XA[ro]), bf2f(GG[ro]), hc, ops + t * 7 * 64, bon + t, lane);
#pragma unroll
        for (int q = 0; q < 3; ++q) pz[q] = z[q];
    }
    f32x4 S[16];
    const float* s0 = p->in[3] + ((size_t)unit * 64 + lane) * 64;
#pragma unroll
    for (int j = 0; j < 16; ++j) S[j] = *(const f32x4*)(s0 + j * 4);
    __syncthreads();
#pragma nounroll
    for (int t = 0; t < 4; ++t) {
        const float* o = ops + t * 7 * 64;
        f32x4 a4 = (f32x4){0.f, 0.f, 0.f, 0.f};
#pragma unroll
        for (int j = 0; j < 16; ++j) { a4 += S[j] * *(const f32x4*)(o + 64 + j * 4); if ((j & 3) == 3) asm volatile("" ::: "memory"); }
        const float sa = -((a4[0] + a4[1]) + (a4[2] + a4[3]));
        const float vv = o[320 + lane];
        f32x4 y4 = (f32x4){0.f, 0.f, 0.f, 0.f};
#pragma unroll
        for (int j = 0; j < 16; ++j) { S[j] = S[j] * *(const f32x4*)(o + j * 4) + (sa * *(const f32x4*)(o + 128 + j * 4) + vv * *(const f32x4*)(o + 192 + j * 4)); y4 += S[j] * *(const f32x4*)(o + 256 + j * 4); if ((j & 1) == 1) asm volatile("" ::: "memory"); }
        const float y = (y4[0] + y4[1]) + (y4[2] + y4[3]);
        const float mu = wave_sum(y) * (1.0f / 64.0f); const float d = y - mu; const float var = wave_sum(d * d) * (1.0f / 64.0f);
        const float yn = d * rsqrtf(var + GN_EPS) * lw + lb;
        YA[(size_t)(rbase + t) * 1024 + ch] = f2bf((yn + bon[t] * vv) * o[384 + lane]);
    }
    float* so = p->out + O_SWKV + ((size_t)unit * 64 + lane) * 64;
#pragma unroll
    for (int j = 0; j < 16; ++j) *(f32x4*)(so + j * 4) = S[j];
    __syncthreads();
}

__device__ __forceinline__ void row_load_bf(f32x4 (&o)[8], const bf16_t* C, int row, int lane) {
#pragma unroll
    for (int i = 0; i < 8; ++i) { const u32x2 w = *(const u32x2*)(C + (size_t)row * DM + i * 256 + lane * 4); o[i] = (f32x4){lo_bf(w.x), hi_bf(w.x), lo_bf(w.y), hi_bf(w.y)}; }
}
template <int S>
__device__ __forceinline__ f32x4 part_sum(const float* P, int srow, int c) {
    f32x4 a = *(const f32x4*)(P + (size_t)srow * DM + c);
#pragma unroll
    for (int sp = 1; sp < S; ++sp) a += *(const f32x4*)(P + ((size_t)sp * 512 + srow) * DM + c);
    return a;
}
__device__ __forceinline__ float sumsq8(const f32x4 (&v)[8]) { float s = 0.f;
#pragma unroll
    for (int i = 0; i < 8; ++i) s += (v[i][0] * v[i][0] + v[i][1] * v[i][1]) + (v[i][2] * v[i][2] + v[i][3] * v[i][3]);
    return s; }

__global__ void __launch_bounds__(NTHR, 2) fwd_megakernel(Params p_unused) {
    extern __shared__ __attribute__((aligned(16))) unsigned char lds_raw[];
    cg::grid_group grid = cg::this_grid();
    LAS unsigned char* lds = (LAS unsigned char*)lds_raw;
    float* ldsf = (float*)lds_raw;
    const int bid = blockIdx.x, nblk = gridDim.x;
    __shared__ uint4 xb_words;
    if (threadIdx.x == 0) xb_words = make_uint4(0u, 0u, 0u, 0u);
    __syncthreads();
    if (kargs()->ws == nullptr) grid.sync();
    const XcdBarrier xbar = xcd_barrier_post((unsigned*)(kargs()->ws + W_BAR), (volatile LAS unsigned*)&xb_words);
#define PHASE_BEGIN() KArgP p = kargs(); int tid = threadIdx.x; asm volatile("" : "+v"(tid)); const int wave = tid >> 6, lane = tid & 63; (void)wave; (void)lane; \
    unsigned char* ws = p->ws; bf16_t* Z = (bf16_t*)(ws + W_Z); float* ssq = (float*)(ws + W_SSQ); float* Y = p->out + O_Y; (void)Z; (void)ssq; (void)Y;

    {
        PHASE_BEGIN();
    transpose_job(p->in[7], 8480, 2048, (bf16_t*)(ws + W_IN), 2048, 8704, MapWin(), ldsf, bid, nblk);
    {
        bf16_t* H = (bf16_t*)(ws + W_H); const float* gw = p->in[6];
        for (int row = bid * 8 + wave; row < M; row += 2 * nblk * 8) {
            const int rowB = row + nblk * 8; const bool hasB = rowB < M;
            const float* xa = xrow(p, row); const float* xb = xrow(p, hasB ? rowB : row); f32x4 va[8], vb[8];
#pragma unroll
            for (int i = 0; i < 8; ++i) { va[i] = *(const f32x4*)(xa + i * 256 + lane * 4); vb[i] = *(const f32x4*)(xb + i * 256 + lane * 4); }
            const float ra = rsqrtf(wave_sum(sumsq8(va)) * (1.0f / DM) + NORM_EPS), rb = rsqrtf(wave_sum(sumsq8(vb)) * (1.0f / DM) + NORM_EPS);
#pragma unroll
            for (int i = 0; i < 8; ++i) { const f32x4 g = *(const f32x4*)(gw + i * 256 + lane * 4); const f32x4 oa = va[i] * ra * g, ob = vb[i] * rb * g;
                u32x2 w; w.x = cvt_pk_bf16(oa[0], oa[1]); w.y = cvt_pk_bf16(oa[2], oa[3]); *(u32x2*)(H + (size_t)row * DM + i * 256 + lane * 4) = w;
                if (hasB) { u32x2 w2; w2.x = cvt_pk_bf16(ob[0], ob[1]); w2.y = cvt_pk_bf16(ob[2], ob[3]); *(u32x2*)(H + (size_t)rowB * DM + i * 256 + lane * 4) = w2; } }
        }
        for (int e = bid * NTHR + tid; e < 128 * 11 * 256; e += nblk * NTHR) { const int c4 = e & 255, j = (e >> 8) % 11, b = (e >> 8) / 11;
            *(f32x4*)(p->out + O_SPOOL + ((size_t)b * 15 + j) * 1024 + c4 * 4) = *(const f32x4*)(p->in[4] + ((size_t)b * 15 + j + 4) * 1024 + c4 * 4); }
    }
    }
    xcd_barrier(xbar);

    {
        PHASE_BEGIN();
        pg8::Gemm g{(const bf16_t*)(ws + W_H), (const bf16_t*)(ws + W_IN), M, 8704, 2048, 2048, 2048, 0, 0}; pg8::StaticOrder S; S.init(M, 8704, nblk, bid, 2048);
        EpiZ E{Z, p->out}; pg8::gemm_phase(lds, g, S, E);
        { const int nfull = (34 * 34) / nblk, nrem = (34 * 34) - nfull * nblk;
          if (bid >= nrem && nrem > 0 && nblk - nrem >= 8) { const int ob = bid - nrem, onb = nblk - nrem;
            transpose_job(p->in[19], 2048, 1024, (bf16_t*)(ws + W_AB), 1024, 2048, MapId(), ldsf, ob, onb);
            transpose_job(p->in[22], 2048, 1024, (bf16_t*)(ws + W_AB) + (size_t)2048 * 1024, 1024, 2048, MapId(), ldsf, ob, onb);
            transpose_job(p->in[23], 2048, 2048, (bf16_t*)(ws + W_O), 2048, 2048, MapId(), ldsf, ob, onb);
            for (int g = 0; g < 4; ++g) transpose_job(p->in[20] + (size_t)g * 65536, 256, 256, (bf16_t*)(ws + W_POOL) + (size_t)g * 65536, 256, 256, MapId(), ldsf, ob, onb);
            transpose_job(p->in[10], 1024, 64, (bf16_t*)(ws + W_LR), 256, 1024, MapId(), ldsf, ob, onb);
            transpose_job(p->in[12], 1024, 64, (bf16_t*)(ws + W_LR) + (size_t)1024 * 256, 256, 1024, MapId(), ldsf, ob, onb);
            transpose_job(p->in[13], 1024, 160, (bf16_t*)(ws + W_LR) + (size_t)2048 * 256, 256, 1024, MapId(), ldsf, ob, onb);
          } else if (nrem == 0 || nblk - nrem < 8) {
            transpose_job(p->in[19], 2048, 1024, (bf16_t*)(ws + W_AB), 1024, 2048, MapId(), ldsf, bid, nblk);
            transpose_job(p->in[22], 2048, 1024, (bf16_t*)(ws + W_AB) + (size_t)2048 * 1024, 1024, 2048, MapId(), ldsf, bid, nblk);
            transpose_job(p->in[23], 2048, 2048, (bf16_t*)(ws + W_O), 2048, 2048, MapId(), ldsf, bid, nblk);
            for (int g = 0; g < 4; ++g) transpose_job(p->in[20] + (size_t)g * 65536, 256, 256, (bf16_t*)(ws + W_POOL) + (size_t)g * 65536, 256, 256, MapId(), ldsf, bid, nblk);
            transpose_job(p->in[10], 1024, 64, (bf16_t*)(ws + W_LR), 256, 1024, MapId(), ldsf, bid, nblk);
            transpose_job(p->in[12], 1024, 64, (bf16_t*)(ws + W_LR) + (size_t)1024 * 256, 256, 1024, MapId(), ldsf, bid, nblk);
            transpose_job(p->in[13], 1024, 160, (bf16_t*)(ws + W_LR) + (size_t)2048 * 256, 256, 1024, MapId(), ldsf, bid, nblk);
          } }
    }
    xcd_barrier(xbar);

    {
        PHASE_BEGIN();
        bf16_t* A2 = (bf16_t*)(ws + W_A2);
        for (int e = bid * NTHR + tid; e < M * 96; e += nblk * NTHR) { const int r = e / 96, j8 = e - r * 96; u32x4 o = (u32x4){0u, 0u, 0u, 0u};
            int kind = -1, zc = 0;
            if (j8 < 8) { kind = 0; zc = ZC_LR + j8 * 8; } else if (j8 >= 32 && j8 < 40) { kind = 1; zc = ZC_LR + 64 + (j8 - 32) * 8; } else if (j8 >= 64 && j8 < 84) { kind = 2; zc = ZC_LR + 128 + (j8 - 64) * 8; }
            if (kind >= 0) {
                const bool smp = r >= MP; const int t = smp ? (r - MP) & 3 : r & 2047;
                f32x4 z0, z1, p0, p1; unpack8(*(const u32x4*)(Z + (size_t)r * ZLD + zc), z0, z1);
                if (t > 0) unpack8(*(const u32x4*)(Z + (size_t)(r - 1) * ZLD + zc), p0, p1);
                else if (smp) { const float* sp = p->in[2] + (size_t)((r - MP) >> 2) * DSH + zc; p0 = *(const f32x4*)sp; p1 = *(const f32x4*)(sp + 4); }
                else { p0 = (f32x4){0.f, 0.f, 0.f, 0.f}; p1 = p0; }
                const f32x4 m0 = *(const f32x4*)(p->in[8] + zc), m1 = *(const f32x4*)(p->in[8] + zc + 4);
                f32x4 v0 = z0 + (p0 - z0) * m0, v1 = z1 + (p1 - z1) * m1;
#pragma unroll
                for (int j = 0; j < 4; ++j) {
                    if (kind == 0) { v0[j] = 1.0f - 2.0f * __builtin_amdgcn_rcpf(1.0f + __expf(2.0f * v0[j])); v1[j] = 1.0f - 2.0f * __builtin_amdgcn_rcpf(1.0f + __expf(2.0f * v1[j])); }
                    else if (kind == 2) { v0[j] = sigmoidf_(v0[j]); v1[j] = sigmoidf_(v1[j]); } }
                o = pack8(v0, v1); }
            *(u32x4*)(A2 + (size_t)r * 768 + j8 * 8) = o; }
        bf16_t* D = (bf16_t*)(ws + W_DYA);
        for (int e = bid * NTHR + tid; e < 512 * 128; e += nblk * NTHR) { const int seg = e >> 7, c = (e & 127) * 8; const int gi = c >> 8, win = 2 << gi;
            const int r0 = seg * 16, t0 = r0 & 2047;
            f32x4 s0 = (f32x4){0.f, 0.f, 0.f, 0.f}, s1 = s0;
            for (int j = 1; j < win; ++j) { if (t0 - j >= 0) { f32x4 a, bq; unpack8(*(const u32x4*)(Z + (size_t)(r0 - j) * ZLD + ZC_P + c), a, bq); s0 += a; s1 += bq; } }
#pragma unroll 4
            for (int i = 0; i < 16; ++i) { const int t = t0 + i; f32x4 a, bq; unpack8(*(const u32x4*)(Z + (size_t)(r0 + i) * ZLD + ZC_P + c), a, bq);
                s0 += a; s1 += bq; const float ic = 1.0f / (float)min(win, t + 1);
                *(u32x4*)(D + (size_t)(r0 + i) * 1024 + c) = pack8(s0 * ic - a, s1 * ic - bq);
                if (t - win + 1 >= 0) { f32x4 oa, ob; unpack8(*(const u32x4*)(Z + (size_t)(r0 + i - win + 1) * ZLD + ZC_P + c), oa, ob); s0 -= oa; s1 -= ob; } }
        }
        for (int e = bid * NTHR + tid; e < 512 * 128; e += nblk * NTHR) { const int r = MP + (e >> 7), c = (e & 127) * 8; const int gi = c >> 8, win = 2 << gi;
            const int b = (r - MP) >> 2, t = (r - MP) & 3;
            f32x4 s0 = (f32x4){0.f, 0.f, 0.f, 0.f}, s1 = s0, z0 = s0, z1 = s0;
            for (int j = 0; j < win; ++j) { const int tj = t - j; f32x4 a, bq;
                if (tj >= 0) unpack8(*(const u32x4*)(Z + (size_t)(r - j) * ZLD + ZC_P + c), a, bq);
                else { const float* sp = p->in[4] + ((size_t)b * 15 + (15 + tj)) * 1024 + c; a = *(const f32x4*)sp; bq = *(const f32x4*)(sp + 4); }
                if (j == 0) { z0 = a; z1 = bq; }
                s0 += a; s1 += bq; }
            const float ic = 1.0f / (float)win;
            *(u32x4*)(D + (size_t)r * 1024 + c) = pack8(s0 * ic - z0, s1 * ic - z1); }
    }
    xcd_barrier(xbar);

    {
        PHASE_BEGIN();
        pg8::Gemm g{(const bf16_t*)(ws + W_A2), (const bf16_t*)(ws + W_LR), M, 3072, 256, 768, 256, 2, 256}; pg8::LowRankOrder S; S.part = 0; S.G = nblk; S.c = bid; S.ntk = 4;
        EpiLR E{(bf16_t*)(ws + W_XW), p->in[9], p->in[11]}; pg8::gemm_phase(lds, g, S, E);
        pg8::Gemm g3{(const bf16_t*)(ws + W_DYA), (const bf16_t*)(ws + W_POOL), M, 1024, 256, 1024, 256, 0, 256}; pg8::StaticOrder S3; S3.init(M, 1024, nblk, nblk - 1 - bid, 256);
        EpiPool E3{(bf16_t*)(ws + W_YB), p->in[21]}; pg8::gemm_phase(lds, g3, S3, E3);
    }
    xcd_barrier(xbar);

    {
        PHASE_BEGIN();
        scan_sample(p, bid * 8 + wave, ldsf);
        __syncthreads();
        for (int cu = bid; cu < 2048; cu += nblk) wkv_pass_a(p, cu, lds);
    }
    xcd_barrier(xbar);
    {
        PHASE_BEGIN();
        if (bid < 64) { if (wave < 4) wkv_pass_b(p, bid * 4 + wave, lane); }
        else {
            const int ob = bid - 64, onb = nblk - 64;
            pg8::Gemm g{(const bf16_t*)(ws + W_YB), (const bf16_t*)(ws + W_AB) + (size_t)2048 * 1024, M, 2048, 1024, 1024, 1024, 0, 0};
            pg8::MixOrder S; S.base.init(MP, 2048, 1, 0, 1024); S.G = onb; S.c = ob; S.sample_only = false;
            EpiGateB E{(bf16_t*)(ws + W_MM), Z}; pg8::gemm_phase(lds, g, S, E);
            pg8::Gemm ga{(const bf16_t*)(ws + W_DYA), (const bf16_t*)(ws + W_AB), M, 2048, 1024, 1024, 1024, 0, 0}; pg8::MixOrder SS = S; SS.sample_only = true;
            EpiGateA EA{Z, (bf16_t*)(ws + W_MM)}; pg8::gemm_phase(lds, ga, SS, EA);
            { const int first1 = 256 - (onb - 16), nfree = (onb - 16) - first1;
              pg8::Gemm gl{(const bf16_t*)(ws + W_A2), (const bf16_t*)(ws + W_LR), M, 3072, 256, 768, 256, 2, 256};
              pg8::LowRankOrder SL; SL.part = 1; SL.G = nfree > 0 ? nfree : onb; SL.c = nfree > 0 ? ((ob >= first1 && ob < onb - 16) ? ob - first1 : -1) : ob; SL.ntk = 4;
              EpiLR EL{(bf16_t*)(ws + W_XW), p->in[9], p->in[11]}; pg8::gemm_phase(lds, gl, SL, EL); }
        }
    }
    xcd_barrier(xbar);
    {
        PHASE_BEGIN();
        for (int cu = bid * 2 + (wave >> 2); cu < 2048; cu += nblk * 2) { if (wave < 8) wkv_pass_c(p, cu, wave & 3, lane); }
    }
    xcd_barrier(xbar);
    {
        PHASE_BEGIN();
        transpose_job(p->in[26], 11264, 2048, (bf16_t*)(ws + W_GU), 2048, 11264, MapId(), ldsf, bid, nblk);
        transpose_job(p->in[29], 2048, 5632, (bf16_t*)(ws + W_D), 5632, 2048, MapId(), ldsf, bid, nblk);
        pg8::Gemm g{(const bf16_t*)(ws + W_DYA), (const bf16_t*)(ws + W_AB), M, 2048, 1024, 1024, 1024, 0, 0}; pg8::StaticOrder S; S.init(MP, 2048, nblk, bid, 1024);
        EpiGateA E{Z, (bf16_t*)(ws + W_MM)}; pg8::gemm_phase(lds, g, S, E);
    }
    xcd_barrier(xbar);

    {
        PHASE_BEGIN();
        pg8::Gemm g{(const bf16_t*)(ws + W_MM), (const bf16_t*)(ws + W_O), M, 2048, 2048, 2048, 2048, 0, 0}; pg8::SplitOrder S; S.init(nblk, bid, 2048, 8);
        EpiOutP E{(bf16_t*)(ws + W_O16), (float*)(ws + W_PART5)}; pg8::gemm_phase(lds, g, S, E);
    }
    xcd_barrier(xbar);

    {
        PHASE_BEGIN();
        bf16_t* H2 = (bf16_t*)(ws + W_H2); const float* g1 = p->in[24]; const float* g2 = p->in[25]; const float* PT = (const float*)(ws + W_PART5); const bf16_t* O16 = (const bf16_t*)(ws + W_O16);
        const int stride = nblk * 8;
        for (int row = bid * 8 + wave; row < MP; row += 2 * stride) {
            const int rowB = row + stride; const bool hasB = rowB < MP;
            f32x4 oa[8], ob[8], xa[8], xb[8];
            row_load_bf(oa, O16, row, lane); if (hasB) row_load_bf(ob, O16, rowB, lane);
#pragma unroll
            for (int i = 0; i < 8; ++i) { xa[i] = *(const f32x4*)(p->in[0] + (size_t)row * DM + i * 256 + lane * 4); if (hasB) xb[i] = *(const f32x4*)(p->in[0] + (size_t)rowB * DM + i * 256 + lane * 4); }
            const float ra = rsqrtf(wave_sum(sumsq8(oa)) * (1.0f / DM) + NORM_EPS), rb = hasB ? rsqrtf(wave_sum(sumsq8(ob)) * (1.0f / DM) + NORM_EPS) : 0.f;
#pragma unroll
            for (int i = 0; i < 8; ++i) { const int c = i * 256 + lane * 4; const f32x4 g = *(const f32x4*)(g1 + c);
                xa[i] = xa[i] + oa[i] * ra * g; *(f32x4*)(Y + (size_t)row * DM + c) = xa[i];
                if (hasB) { xb[i] = xb[i] + ob[i] * rb * g; *(f32x4*)(Y + (size_t)rowB * DM + c) = xb[i]; } }
            const float qa = rsqrtf(wave_sum(sumsq8(xa)) * (1.0f / DM) + NORM_EPS), qb = hasB ? rsqrtf(wave_sum(sumsq8(xb)) * (1.0f / DM) + NORM_EPS) : 0.f;
#pragma unroll
            for (int i = 0; i < 8; ++i) { const int c = i * 256 + lane * 4; const f32x4 g = *(const f32x4*)(g2 + c);
                { const f32x4 o = xa[i] * qa * g; u32x2 w; w.x = cvt_pk_bf16(o[0], o[1]); w.y = cvt_pk_bf16(o[2], o[3]); *(u32x2*)(H2 + (size_t)row * DM + c) = w; }
                if (hasB) { const f32x4 o = xb[i] * qb * g; u32x2 w; w.x = cvt_pk_bf16(o[0], o[1]); w.y = cvt_pk_bf16(o[2], o[3]); *(u32x2*)(H2 + (size_t)rowB * DM + c) = w; } }
        }
        for (int srow = bid * 8 + wave; srow < M - MP; srow += stride) {
            const int row = MP + srow; float s1 = 0.f;
#pragma unroll 1
            for (int i = 0; i < 8; ++i) { const f32x4 o = part_sum<8>(PT, srow, i * 256 + lane * 4); s1 += (o[0] * o[0] + o[1] * o[1]) + (o[2] * o[2] + o[3] * o[3]); }
            const float ra = rsqrtf(wave_sum(s1) * (1.0f / DM) + NORM_EPS); float s2 = 0.f;
#pragma unroll 1
            for (int i = 0; i < 8; ++i) { const int c = i * 256 + lane * 4; const f32x4 o = part_sum<8>(PT, srow, c);
                const f32x4 v = *(const f32x4*)(p->in[1] + (size_t)srow * DM + c) + o * ra * *(const f32x4*)(g1 + c); *(f32x4*)(Y + (size_t)row * DM + c) = v; s2 += (v[0] * v[0] + v[1] * v[1]) + (v[2] * v[2] + v[3] * v[3]); }
            const float qa = rsqrtf(wave_sum(s2) * (1.0f / DM) + NORM_EPS);
            asm volatile("s_waitcnt vmcnt(0)" ::: "memory");
#pragma unroll 1
            for (int i = 0; i < 8; ++i) { const int c = i * 256 + lane * 4; const f32x4 o = *(const f32x4*)(Y + (size_t)row * DM + c) * qa * *(const f32x4*)(g2 + c);
                u32x2 w; w.x = cvt_pk_bf16(o[0], o[1]); w.y = cvt_pk_bf16(o[2], o[3]); *(u32x2*)(H2 + (size_t)row * DM + c) = w; }
        }
    }
    xcd_barrier(xbar);

    {
        PHASE_BEGIN();
        pg8::Gemm g{(const bf16_t*)(ws + W_H2), (const bf16_t*)(ws + W_GU), M, DFF, 2048, 2048, 2048, 0, 0}; pg8::StaticOrder S; S.init(M, DFF, nblk, bid, 2048);
        EpiGate7 E{(bf16_t*)(ws + W_GATE), p->out}; pg8::gemm_phase(lds, g, S, E);
    }
    xcd_barrier(xbar);

    {
        PHASE_BEGIN();
        pg8::Gemm g{(const bf16_t*)(ws + W_H2), (const bf16_t*)(ws + W_GU) + (size_t)DFF * 2048, M, DFF, 2048, 2048, 2048, 0, 0}; pg8::StaticOrder S; S.init(M, DFF, nblk, bid, 2048);
        EpiAct E{(const bf16_t*)(ws + W_GATE), (bf16_t*)(ws + W_ACT), p->in[27], p->in[28], p->in[5]}; pg8::gemm_phase(lds, g, S, E);
    }
    xcd_barrier(xbar);

    {
        PHASE_BEGIN();
        pg8::Gemm g{(const bf16_t*)(ws + W_ACT), (const bf16_t*)(ws + W_D), M, 2048, DFF, DFF, DFF, 0, 0}; pg8::SplitOrder S; S.init(nblk, bid, DFF, 11);
        EpiOutP E{(bf16_t*)(ws + W_F), (float*)(ws + W_PART9)}; pg8::gemm_phase(lds, g, S, E);
    }
    xcd_barrier(xbar);

    {
        PHASE_BEGIN();
        const bf16_t* F = (const bf16_t*)(ws + W_F); const float* g3 = p->in[30]; const float* PT = (const float*)(ws + W_PART9);
        const int stride = nblk * 8;
        for (int row = bid * 8 + wave; row < MP; row += 2 * stride) {
            const int rowB = row + stride; const bool hasB = rowB < MP;
            f32x4 fa[8], fb[8], xa[8], xb[8];
            row_load_bf(fa, F, row, lane); if (hasB) row_load_bf(fb, F, rowB, lane);
#pragma unroll
            for (int i = 0; i < 8; ++i) { xa[i] = *(const f32x4*)(Y + (size_t)row * DM + i * 256 + lane * 4); if (hasB) xb[i] = *(const f32x4*)(Y + (size_t)rowB * DM + i * 256 + lane * 4); }
            const float ra = rsqrtf(wave_sum(sumsq8(fa)) * (1.0f / DM) + NORM_EPS), rb = hasB ? rsqrtf(wave_sum(sumsq8(fb)) * (1.0f / DM) + NORM_EPS) : 0.f;
#pragma unroll
            for (int i = 0; i < 8; ++i) { const int c = i * 256 + lane * 4; const f32x4 g = *(const f32x4*)(g3 + c);
                *(f32x4*)(Y + (size_t)row * DM + c) = xa[i] + fa[i] * ra * g;
                if (hasB) *(f32x4*)(Y + (size_t)rowB * DM + c) = xb[i] + fb[i] * rb * g; }
        }
        for (int srow = bid * 8 + wave; srow < M - MP; srow += stride) {
            const int row = MP + srow; float s1 = 0.f;
#pragma unroll 1
            for (int i = 0; i < 8; ++i) { const f32x4 o = part_sum<11>(PT, srow, i * 256 + lane * 4); s1 += (o[0] * o[0] + o[1] * o[1]) + (o[2] * o[2] + o[3] * o[3]); }
            const float ra = rsqrtf(wave_sum(s1) * (1.0f / DM) + NORM_EPS);
#pragma unroll 1
            for (int i = 0; i < 8; ++i) { const int c = i * 256 + lane * 4; const f32x4 o = part_sum<11>(PT, srow, c);
                *(f32x4*)(Y + (size_t)row * DM + c) = *(const f32x4*)(Y + (size_t)row * DM + c) + o * ra * *(const f32x4*)(g3 + c); }
        }
    }
}

extern "C" void kernel_launch(void* const* d_in, const int* in_sizes, int n_in, void* d_out, int out_size, void* d_ws, size_t ws_size, hipStream_t stream) {
    static int grid_blocks = 0;
    if (!grid_blocks) {
        int dev = 0, cus = 0, per_cu = 0;
        hipGetDevice(&dev);
        hipDeviceGetAttribute(&cus, hipDeviceAttributeMultiprocessorCount, dev);
        hipFuncSetAttribute((const void*)fwd_megakernel, hipFuncAttributeMaxDynamicSharedMemorySize, LDS_BYTES);
        hipOccupancyMaxActiveBlocksPerMultiprocessor(&per_cu, (const void*)fwd_megakernel, NTHR, LDS_BYTES);
        if (per_cu < 1) per_cu = 1;
        grid_blocks = cus * 1;
        if (ws_size < W_END) fprintf(stderr, "kernel_launch: workspace too small: %zu < %zu\n", ws_size, (size_t)W_END);
        if (n_in != 31) fprintf(stderr, "kernel_launch: expected 31 inputs, got %d\n", n_in);
    }
    Params p{};
    for (int i = 0; i < 31; ++i) p.in[i] = (const float*)d_in[i];
    p.out = (float*)d_out; p.ws = (unsigned char*)d_ws;
    hipMemsetAsync((unsigned char*)d_ws + W_BAR, 0, 16384, stream);
    void* args[] = {&p};
    hipError_t e = hipLaunchCooperativeKernel((const void*)fwd_megakernel, dim3(grid_blocks), dim3(NTHR), args, LDS_BYTES, stream);
    if (e != hipSuccess) fprintf(stderr, "cooperative launch failed: %s (grid %d)\n", hipGetErrorString(e), grid_blocks);
}
```

```cpp
#include <hip/hip_runtime.h>
#include <hip/hip_cooperative_groups.h>
#include <cstdio>
namespace cg = cooperative_groups;

#define LAS __attribute__((address_space(3)))
typedef unsigned short bf16_t;
typedef short bf16x8 __attribute__((ext_vector_type(8)));
typedef float f32x4 __attribute__((ext_vector_type(4)));
typedef float f32x2 __attribute__((ext_vector_type(2)));
typedef unsigned u32x4 __attribute__((ext_vector_type(4)));
typedef unsigned u32x2 __attribute__((ext_vector_type(2)));

constexpr int M = 8704;
constexpr int MP = 8192;
constexpr int DM = 2048, DR = 1024, DSH = 3360, DFF = 5632;
constexpr int ZLD = 8704;
constexpr int ZC_LR = 3072, ZC_P = 3584, ZC_GA = 4608, ZC_GB = 6656;
constexpr int NTHR = 512;
constexpr int LDS_BYTES = 131072;
constexpr float NORM_EPS = 1e-6f, GN_EPS = 64e-5f;

constexpr size_t O_Y = 0;
constexpr size_t O_PSHIFT = 17825792, O_PWKV = 17839232, O_PPOOL = 18101376, O_PCONV = 18162816;
constexpr size_t O_SSHIFT = 18207872, O_SWKV = 18637952, O_SPOOL = 27026560, O_SCONV = 28992640;

constexpr size_t SZ_M1024_BF = (size_t)M * 1024 * 2;
constexpr size_t W_AB = 0;
constexpr size_t W_O = W_AB + 8388608;
constexpr size_t W_POOL = W_O + 8388608;
constexpr size_t W_LR = W_POOL + 524288;
constexpr size_t W_SSQ = W_LR + 1572864;
constexpr size_t W_RA = W_SSQ + (size_t)M * 32 * 4;
constexpr size_t W_IN = W_RA;
constexpr size_t W_H = W_RA + (size_t)8704 * 2048 * 2;
constexpr size_t W_GU = W_RA;
constexpr size_t W_D = W_RA + (size_t)11264 * 2048 * 2;
constexpr size_t W_Z = W_RA + (size_t)2 * 8704 * 2048 * 2;
constexpr size_t W_H2 = W_Z;
constexpr size_t W_GATE = W_Z + (size_t)M * 2048 * 2;
constexpr size_t W_F = W_Z;
constexpr size_t W_O16 = W_Z + (size_t)M * 2048 * 4 + (size_t)1048576;
constexpr size_t W_PART5 = W_Z + (size_t)M * 2048 * 2;
constexpr size_t W_PART9 = W_Z + (size_t)M * 2048 * 4;
constexpr size_t W_RC = W_Z + (size_t)M * ZLD * 2;
constexpr size_t W_XW = W_RC;
constexpr size_t W_XA = W_XW + SZ_M1024_BF;
constexpr size_t W_GG = W_XA + SZ_M1024_BF;
constexpr size_t W_DYA = W_GG + SZ_M1024_BF;
constexpr size_t W_YB = W_DYA + SZ_M1024_BF;
constexpr size_t W_A2 = W_YB + SZ_M1024_BF;
constexpr size_t W_MM = W_XW;
constexpr size_t W_ACT = W_RC;
constexpr size_t W_BAR = W_A2 + (size_t)M * 768 * 2;
constexpr size_t W_SF = W_BAR + 16384;
constexpr size_t W_END = W_SF + (size_t)2048 * 8192;

struct Params { const float* in[31]; float* out; unsigned char* ws; };
typedef const __attribute__((address_space(4))) Params* KArgP;
__device__ __forceinline__ KArgP kargs() { KArgP q = (KArgP)__builtin_amdgcn_kernarg_segment_ptr(); asm volatile("" : "+s"(q)); return q; }

__device__ __forceinline__ float bf2f(bf16_t b) { return __uint_as_float(((unsigned)b) << 16); }
__device__ __forceinline__ bf16_t f2bf(float f) { unsigned u = __float_as_uint(f); u += 0x7FFFu + ((u >> 16) & 1u); return (bf16_t)(u >> 16); }
typedef __bf16 bf16n2 __attribute__((ext_vector_type(2)));
__device__ __forceinline__ unsigned cvt_pk_bf16(float lo, float hi) { const f32x2 v = {lo, hi}; const bf16n2 r = __builtin_convertvector(v, bf16n2); unsigned u; __builtin_memcpy(&u, &r, 4); return u; }
__device__ __forceinline__ float lo_bf(unsigned w) { return __uint_as_float(w << 16); }
__device__ __forceinline__ float hi_bf(unsigned w) { return __uint_as_float(w & 0xffff0000u); }
__device__ __forceinline__ float sigmoidf_(float x) { return __builtin_amdgcn_rcpf(1.0f + __expf(-x)); }
#define DPP_ADD(v, ctrl) ((v) + __uint_as_float(__builtin_amdgcn_update_dpp(0u, __float_as_uint(v), (ctrl), 0xF, 0xF, true)))
__device__ __forceinline__ float xor16_sum(float v) { const auto r = __builtin_amdgcn_permlane16_swap(__float_as_uint(v), __float_as_uint(v), false, false); return __uint_as_float(r[0]) + __uint_as_float(r[1]); }
__device__ __forceinline__ float xor32_sum(float v) { const auto r = __builtin_amdgcn_permlane32_swap(__float_as_uint(v), __float_as_uint(v), false, false); return __uint_as_float(r[0]) + __uint_as_float(r[1]); }
__device__ __forceinline__ float wave_sum(float v) {
    v = DPP_ADD(v, 0xB1);
    v = DPP_ADD(v, 0x4E);
    v = DPP_ADD(v, 0x141);
    v = DPP_ADD(v, 0x140);
    v = xor16_sum(v);
    return xor32_sum(v);
}
__device__ __forceinline__ const float* xrow(KArgP p, int r) { return r < MP ? p->in[0] + (size_t)r * DM : p->in[1] + (size_t)(r - MP) * DM; }
__device__ __forceinline__ float gelu_tanh(float x) {
    const float u = 0.7978845608f * (x + 0.044715f * x * x * x);
    return x * __builtin_amdgcn_rcpf(1.0f + __expf(-2.0f * u));
}


#define XB_TMO      128
#define XB_XCNT(j)  (256  + 64 * (j))
#define XB_XSUB(j)  (1280 + 64 * (j))
#define XB_XGEN(j)  (2304 + 64 * (j))
#define XB_TOP      3328
#define XB_TOPGEN   3392
#define XCD_BAR_WORDS 3456
#define XB_SPIN_CAP (1u << 18)
__device__ __forceinline__ unsigned xb_ld(unsigned* p)              { return __hip_atomic_load(p, __ATOMIC_RELAXED, __HIP_MEMORY_SCOPE_AGENT); }
__device__ __forceinline__ unsigned xb_add(unsigned* p, unsigned v) { return __hip_atomic_fetch_add(p, v, __ATOMIC_RELAXED, __HIP_MEMORY_SCOPE_AGENT); }
__device__ __forceinline__ unsigned xb_xcc_id() { return (unsigned)__builtin_amdgcn_s_getreg((3 << 11) | 20) & 0xFu; }
#define XB_SPIN(cond, bar) do { unsigned _sp = 0; while (cond) { __builtin_amdgcn_s_sleep(1); \
    if ((++_sp & 255u) == 0u) { if (xb_ld(&(bar)[XB_TMO])) break; if (_sp > XB_SPIN_CAP) { atomicAdd(&(bar)[XB_TMO], 1u); break; } } } } while (0)
struct XcdBarrier { unsigned* bar; unsigned x; volatile LAS unsigned* st; };
__device__ __forceinline__ XcdBarrier xcd_barrier_post(unsigned* bar, volatile LAS unsigned* st) {
    XcdBarrier b; b.bar = bar; b.x = xb_xcc_id(); b.st = st;
    if (threadIdx.x == 0) (void)xb_add(&bar[XB_XCNT(b.x)], 1u);
    return b;
}
__device__ __forceinline__ void xcd_barrier_complete(unsigned* bar, unsigned x, unsigned& nloc, unsigned& nx) {
    const unsigned G = gridDim.x * gridDim.y * gridDim.z;
    unsigned sum, cnt, mine, sp = 0u;
    for (;;) {
        sum = 0u; cnt = 0u; mine = 0u;
#pragma unroll
        for (unsigned j = 0; j < 16; ++j) { const unsigned c = xb_ld(&bar[XB_XCNT(j)]); sum += c; cnt += (c > 0u) ? 1u : 0u; mine = (j == x) ? c : mine; }
        if (sum == G) break;
        __builtin_amdgcn_s_sleep(1);
        if ((++sp & 255u) == 0u) { if (xb_ld(&bar[XB_TMO])) break; if (sp > XB_SPIN_CAP) { atomicAdd(&bar[XB_TMO], 1u); break; } }
    }
    nloc = mine > 0u ? mine : 1u; nx = cnt > 0u ? cnt : 1u;
}
__device__ __forceinline__ void xcd_barrier(const XcdBarrier& b) {
    asm volatile("s_waitcnt vmcnt(0)" ::: "memory");
    __syncthreads();
    if (threadIdx.x == 0) {
        unsigned* bar = b.bar;
        __builtin_amdgcn_s_waitcnt(0);
        unsigned nloc = b.st[0], nx = b.st[1];
        if (nloc == 0u) { xcd_barrier_complete(bar, b.x, nloc, nx); b.st[0] = nloc; b.st[1] = nx; }
        const unsigned old = xb_add(&bar[XB_XSUB(b.x)], 1u);
        const unsigned gen = old / nloc;
        if (old + 1u == (gen + 1u) * nloc) {
            __builtin_amdgcn_fence(__ATOMIC_RELEASE, "agent");
            asm volatile("s_waitcnt vmcnt(0)" ::: "memory");
            const unsigned og = xb_add(&bar[XB_TOP], 1u);
            const unsigned tg = og / nx;
            if (og + 1u == (tg + 1u) * nx) xb_add(&bar[XB_TOPGEN], 1u);
            else XB_SPIN(xb_ld(&bar[XB_TOPGEN]) == tg, bar);
            __builtin_amdgcn_fence(__ATOMIC_ACQUIRE, "agent");
            xb_add(&bar[XB_XGEN(b.x)], 1u);
            asm volatile("s_waitcnt vmcnt(0)" ::: "memory");
        } else {
            XB_SPIN(xb_ld(&bar[XB_XGEN(b.x)]) == gen, bar);
            __builtin_amdgcn_fence(__ATOMIC_ACQUIRE, "agent");
            asm volatile("s_waitcnt vmcnt(0)" ::: "memory");
        }
    }
    __syncthreads();
}

namespace pg8 {
constexpr int BM = 256, BK = 64, HALF = 128, HTB = HALF * BK * 2, NXCD = 8, WGM = 8;
__device__ __forceinline__ int lds_byte(int r, int c) { const int st = (r >> 4) * 2 + (c >> 5), rr = r & 15, cc = c & 31, ob = rr * 64 + cc * 2; return st * 1024 + (ob ^ (((ob >> 9) & 1) << 5)); }
__device__ __forceinline__ void stage_rc(int b, int& R, int& C) { const int st = b / 1024, sb = b % 1024, swz = sb ^ (((sb >> 9) & 1) << 5); R = (st >> 1) * 16 + swz / 64; C = (st & 1) * 32 + (swz % 64) / 2; }
__device__ __forceinline__ int perm32(int rho) { const int n = rho >> 4, i = rho & 15; return 8 * (i >> 2) + 4 * n + (i & 3); }

struct Unit { int pm, pn, k0, nt, sp; };
struct Gemm { const bf16_t* A; const bf16_t* Bt; int M, N, K, lda, ldb, agshift, agcols; };

struct StaticOrder {
    int nM, nN, nwg, G, c;
    int ntk;
    __device__ __forceinline__ void init(int M_, int N_, int G_, int c_, int K_) { nM = M_ / BM; nN = N_ / BM; nwg = nM * nN; G = G_; c = c_; ntk = K_ / BK; }
    __device__ __forceinline__ Unit get(int i) const {
        Unit u; u.pm = 0; u.pn = 0; u.k0 = 0; u.nt = 0; u.sp = -1;
        const long L = (long)i * G + c; if (L >= nwg) return u;
        int wgid = (int)L; { const int q = nwg / NXCD, r = nwg % NXCD, xcd = wgid % NXCD, off = wgid / NXCD; wgid = (xcd < r ? xcd * (q + 1) : r * (q + 1) + (xcd - r) * q) + off; }
        const int nig = WGM * nN, gid = wgid / nig, fm = gid * WGM, gsz = (nM - fm) < WGM ? (nM - fm) : WGM;
        u.pm = fm + ((wgid % nig) % gsz); u.pn = (wgid % nig) / gsz; u.nt = ntk; return u;
    }
};
struct SampleOrder {
    StaticOrder base;
    __device__ __forceinline__ Unit get(int i) const {
        int cnt = 0; Unit e; e.pm = 0; e.pn = 0; e.k0 = 0; e.nt = 0; e.sp = -1;
#pragma unroll
        for (int k = 0; k < 3; ++k) { const Unit u = base.get(k); if (u.nt != 0 && u.pm >= 32) { if (cnt == i) return u; ++cnt; } }
        return e;
    }
};
struct MixOrder {
    StaticOrder base; int G, c; bool sample_only;
    __device__ __forceinline__ Unit get(int i) const {
        Unit u; u.pm = 0; u.pn = 0; u.k0 = 0; u.nt = 0; u.sp = -1;
        const int np = G - 16;
        if (c < np) { if (sample_only) return u; StaticOrder b = base; b.G = 1 << 20; b.c = c + i * np; return (i < 64 && c + i * np < 256) ? b.get(0) : u; }
        const int t = c - np; if (i == 0 && t < 16) { u.pm = 32 + (t >> 3); u.pn = t & 7; u.nt = base.ntk; }
        return u;
    }
};
struct LowRankOrder {
    int part, G, c, ntk;
    __device__ __forceinline__ Unit get(int i) const {
        Unit u; u.pm = 0; u.pn = 0; u.k0 = 0; u.nt = 0; u.sp = -1;
        if (c < 0) return u;
        const int L = i * G + c;
        if (part == 0) { if (L < 272) { u.pm = L % 34; u.pn = L / 34; u.nt = ntk; } else if (L < 280) { u.pm = 32 + (L - 272) / 4; u.pn = 8 + (L - 272) % 4; u.nt = ntk; } }
        else if (L < 128) { u.pm = L / 4; u.pn = 8 + (L % 4); u.nt = ntk; }
        return u;
    }
};
struct SplitOrder {
    StaticOrder base; int S, nbase;
    __device__ __forceinline__ void init(int G_, int c_, int K_, int S_) { base.init(8192, 2048, G_, c_, K_); S = S_; nbase = (c_ < 256) ? (256 - c_ + G_ - 1) / G_ : 0; }
    __device__ __forceinline__ Unit get(int i) const {
        if (i < nbase) return base.get(i);
        Unit u; u.pm = 0; u.pn = 0; u.k0 = 0; u.nt = 0; u.sp = -1;
        if (i == nbase && base.c < 16 * S) { const int uu = base.c / S, sp = base.c % S; u.pm = 32 + (uu >> 3); u.pn = uu & 7; u.nt = base.ntk / S; u.k0 = sp * u.nt; u.sp = sp; }
        return u;
    }
};

template <class Epi, class Sched>
__device__ __forceinline__ void gemm_phase(LAS unsigned char* lds, const Gemm g, const Sched& S, const Epi& E) {
    int tid = threadIdx.x; asm volatile("" : "+v"(tid));
    const int wid = __builtin_amdgcn_readfirstlane(tid >> 6), lane = tid & 63, wr = wid >> 2, wc = wid & 3, fr = lane & 15, fq = lane >> 4;
    unsigned voffA[2], voffB[2];
#pragma unroll
    for (int i = 0; i < 2; ++i) { int R, C; stage_rc(tid * 16 + i * 8192, R, C); const int Rb = Epi::PERM ? ((R & ~31) + perm32(R & 31)) : R;
        voffA[i] = (unsigned)(R * g.lda + C) * 2u; voffB[i] = (unsigned)(Rb * g.ldb + C) * 2u; }
    const size_t kstep = (size_t)(BK * 2);
    const size_t hstepA = (size_t)HALF * g.lda * 2, hstepB = (size_t)HALF * g.ldb * 2;
    const size_t tstepA = 2 * hstepA, tstepB = 2 * hstepB;
    const unsigned ldsw = (unsigned)wid * 1024u;
    const int aoff = lds_byte(wr * 64 + fr, fq * 8), boff = lds_byte(wc * 32 + fr, fq * 8);
#define PG8_SA(b, h) (((b) * 2 + (h)) * HTB)
#define PG8_SB(b, h) ((4 + (b) * 2 + (h)) * HTB)
#define PG8_STAGE(bufoff, gbase, voff) do { _Pragma("unroll") for (int _i = 0; _i < 2; ++_i) \
        __builtin_amdgcn_global_load_lds((const unsigned*)((const char*)(gbase) + (voff)[_i]), (LAS unsigned*)(lds + (bufoff) + ldsw + _i * 8192), 16, 0, 0); } while (0)
#define PG8_LDA(dst, b, h) do { _Pragma("unroll") for (int m = 0; m < 4; ++m) _Pragma("unroll") for (int k = 0; k < 2; ++k) dst[m][k] = *(const LAS bf16x8*)(lds + PG8_SA(b, h) + aoff + m * 2048 + k * 1024); } while (0)
#define PG8_LDB(dst, b, h) do { _Pragma("unroll") for (int n = 0; n < 2; ++n) _Pragma("unroll") for (int k = 0; k < 2; ++k) dst[n][k] = *(const LAS bf16x8*)(lds + PG8_SB(b, h) + boff + n * 2048 + k * 1024); } while (0)
#define PG8_MMA(ai, bj, At, Bt) do { __builtin_amdgcn_s_setprio(1); _Pragma("unroll") for (int m = 0; m < 4; ++m) _Pragma("unroll") for (int n = 0; n < 2; ++n) _Pragma("unroll") for (int k = 0; k < 2; ++k) \
        acc[ai][bj][m][n] = __builtin_amdgcn_mfma_f32_16x16x32_bf16(Bt[n][k], At[m][k], acc[ai][bj][m][n], 0, 0, 0); __builtin_amdgcn_s_setprio(0); } while (0)
#define PG8_WAIT_V(n) asm volatile("s_waitcnt vmcnt(" #n ")" ::: "memory")
#define PG8_WAIT_L(n) asm volatile("s_waitcnt lgkmcnt(" #n ")" ::: "memory")
#define PG8_BAR __builtin_amdgcn_s_barrier()
#define PG8_SCHED __builtin_amdgcn_sched_barrier(0)
    Unit cur = S.get(0), nxt; int ui = 0;
    if (cur.nt == 0) return;
    f32x4 acc[2][2][4][2];
#pragma unroll
    for (int a = 0; a < 2; ++a)
#pragma unroll
        for (int b = 0; b < 2; ++b)
#pragma unroll
            for (int m = 0; m < 4; ++m)
#pragma unroll
                for (int n = 0; n < 2; ++n) acc[a][b][m][n] = (f32x4){0.f, 0.f, 0.f, 0.f};
    bf16x8 At[4][2], B0[2][2], B1[2][2];
    const char* cA = (const char*)g.A + (size_t)cur.pm * tstepA + (size_t)((cur.pn >> g.agshift) * g.agcols) * 2 + (size_t)cur.k0 * kstep; const char* cB = (const char*)g.Bt + (size_t)cur.pn * tstepB + (size_t)cur.k0 * kstep;
    PG8_STAGE(PG8_SB(0, 0), cB, voffB); PG8_STAGE(PG8_SA(0, 0), cA, voffA); PG8_STAGE(PG8_SB(0, 1), cB + hstepB, voffB); PG8_STAGE(PG8_SA(0, 1), cA + hstepA, voffA);
    if (wr == 1) PG8_BAR;
    PG8_WAIT_V(4); PG8_BAR;
    PG8_STAGE(PG8_SB(1, 0), cB + kstep, voffB); PG8_STAGE(PG8_SA(1, 0), cA + kstep, voffA); PG8_STAGE(PG8_SB(1, 1), cB + hstepB + kstep, voffB);
    PG8_WAIT_V(6); PG8_BAR;
    for (;;) {
        nxt = S.get(ui + 1); const bool has_next = nxt.nt != 0;
        const char* nA = has_next ? (const char*)g.A + (size_t)nxt.pm * tstepA + (size_t)((nxt.pn >> g.agshift) * g.agcols) * 2 + (size_t)nxt.k0 * kstep : cA; const char* nB = has_next ? (const char*)g.Bt + (size_t)nxt.pn * tstepB + (size_t)nxt.k0 * kstep : cB;
        const int nt = cur.nt;
        for (int t = 0; t < nt; t += 2) {
            const bool last = (t == nt - 2);
            const char* a1 = cA + (size_t)(t + 1) * kstep;
            const char* a2 = last ? nA : cA + (size_t)(t + 2) * kstep; const char* b2 = last ? nB : cB + (size_t)(t + 2) * kstep;
            const char* a3 = a2 + kstep; const char* b3 = b2 + kstep;
            PG8_LDB(B0, 0, 0); PG8_SCHED; PG8_LDA(At, 0, 0); PG8_STAGE(PG8_SA(1, 1), a1 + hstepA, voffA);
            PG8_WAIT_L(8); PG8_BAR; PG8_WAIT_L(0); PG8_MMA(0, 0, At, B0); PG8_BAR; PG8_SCHED;
            PG8_LDB(B1, 0, 1); PG8_STAGE(PG8_SB(0, 0), b2, voffB);
            PG8_BAR; PG8_WAIT_L(0); PG8_MMA(0, 1, At, B1); PG8_BAR;
            PG8_LDA(At, 0, 1); PG8_STAGE(PG8_SA(0, 0), a2, voffA);
            PG8_BAR; PG8_WAIT_L(0); PG8_MMA(1, 0, At, B0); PG8_BAR; PG8_SCHED;
            PG8_STAGE(PG8_SB(0, 1), b2 + hstepB, voffB);
            PG8_WAIT_V(6); PG8_BAR; PG8_MMA(1, 1, At, B1); PG8_BAR;
            PG8_LDB(B0, 1, 0); PG8_SCHED; PG8_LDA(At, 1, 0); PG8_STAGE(PG8_SA(0, 1), a2 + hstepA, voffA);
            PG8_WAIT_L(8); PG8_BAR; PG8_WAIT_L(0); PG8_MMA(0, 0, At, B0); PG8_BAR; PG8_SCHED;
            PG8_LDB(B1, 1, 1); PG8_STAGE(PG8_SB(1, 0), b3, voffB);
            PG8_BAR; PG8_WAIT_L(0); PG8_MMA(0, 1, At, B1); PG8_BAR;
            PG8_LDA(At, 1, 1); PG8_STAGE(PG8_SA(1, 0), a3, voffA);
            PG8_BAR; PG8_WAIT_L(0); PG8_MMA(1, 0, At, B0); PG8_BAR; PG8_SCHED;
            PG8_STAGE(PG8_SB(1, 1), b3 + hstepB, voffB);
            PG8_WAIT_V(6); PG8_BAR; PG8_MMA(1, 1, At, B1); PG8_BAR;
        }
        E(acc, cur, wr, wc, fr, fq);
        if (!has_next) break;
#pragma unroll
        for (int a = 0; a < 2; ++a)
#pragma unroll
            for (int b = 0; b < 2; ++b)
#pragma unroll
                for (int m = 0; m < 4; ++m)
#pragma unroll
                    for (int n = 0; n < 2; ++n) acc[a][b][m][n] = (f32x4){0.f, 0.f, 0.f, 0.f};
        cur = nxt; cA = nA; cB = nB; ++ui;
    }
    PG8_WAIT_V(0);
    if (wr == 0) PG8_BAR;
    PG8_BAR;
#undef PG8_SA
#undef PG8_SB
#undef PG8_STAGE
#undef PG8_LDA
#undef PG8_LDB
#undef PG8_MMA
#undef PG8_WAIT_V
#undef PG8_WAIT_L
#undef PG8_BAR
#undef PG8_SCHED
}
}
using pg8::Unit;
typedef const f32x4 (&AccRef)[2][2][4][2];

__device__ __forceinline__ u32x4 pack8(f32x4 v0, f32x4 v1) { u32x4 w; w.x = cvt_pk_bf16(v0[0], v0[1]); w.y = cvt_pk_bf16(v0[2], v0[3]); w.z = cvt_pk_bf16(v1[0], v1[1]); w.w = cvt_pk_bf16(v1[2], v1[3]); return w; }
__device__ __forceinline__ void unpack8(u32x4 w, f32x4& a, f32x4& b) { a = (f32x4){lo_bf(w.x), hi_bf(w.x), lo_bf(w.y), hi_bf(w.y)}; b = (f32x4){lo_bf(w.z), hi_bf(w.z), lo_bf(w.w), hi_bf(w.w)}; }

struct EpiZ {
    static constexpr bool PERM = true;
    bf16_t* Z; float* out;
    __device__ __forceinline__ void operator()(AccRef acc, const Unit& u, int wr, int wc, int fr, int fq) const {
        const int row0 = u.pm * 256 + wr * 64 + fr, col0 = u.pn * 256 + wc * 32 + 8 * fq;
#pragma unroll
        for (int ai = 0; ai < 2; ++ai)
#pragma unroll
            for (int m = 0; m < 4; ++m) { bf16_t* rowp = Z + (size_t)(row0 + ai * 128 + m * 16) * ZLD + col0;
#pragma unroll
                for (int bj = 0; bj < 2; ++bj) *(u32x4*)(rowp + bj * 128) = pack8(acc[ai][bj][m][0], acc[ai][bj][m][1]); }
        const bool special = (u.pm >= 32) || ((u.pm & 7) == 7);
        if (special && u.pn < 18) {
#pragma unroll
            for (int ai = 0; ai < 2; ++ai)
#pragma unroll
                for (int m = 0; m < 4; ++m) {
                    const int r = row0 + ai * 128 + m * 16; const bool smp = r >= MP; const int b = smp ? (r - MP) >> 2 : r >> 11, t = smp ? (r - MP) & 3 : r & 2047;
#pragma unroll
                    for (int bj = 0; bj < 2; ++bj) { const int c = col0 + bj * 128; float* dst = nullptr;
                        if (c < DSH) { if (smp ? (t == 3) : (t == 2047)) dst = out + (smp ? O_SSHIFT : O_PSHIFT) + (size_t)b * DSH + c; }
                        else if (c >= ZC_P && c < ZC_P + 1024) { const int cc = c - ZC_P;
                            if (smp) dst = out + O_SPOOL + ((size_t)b * 15 + 11 + t) * 1024 + cc;
                            else if (t >= 2033) dst = out + O_PPOOL + ((size_t)b * 15 + (t - 2033)) * 1024 + cc; }
                        if (dst) { *(f32x4*)dst = acc[ai][bj][m][0]; *(f32x4*)(dst + 4) = acc[ai][bj][m][1]; } } }
        }
    }
};
struct EpiLR {
    static constexpr bool PERM = true;
    bf16_t* XW; const float* w0; const float* a0;
    __device__ __forceinline__ void operator()(AccRef acc, const Unit& u, int wr, int wc, int fr, int fq) const {
        const int sel = u.pn >> 2; const int row0 = u.pm * 256 + wr * 64 + fr, col0 = (u.pn & 3) * 256 + wc * 32 + 8 * fq;
        bf16_t* base = XW + (size_t)sel * ((size_t)M * 1024);
#pragma unroll
        for (int bj = 0; bj < 2; ++bj) { const int c = col0 + bj * 128; f32x4 b0 = (f32x4){0.f, 0.f, 0.f, 0.f}, b1 = b0;
            if (sel == 0) { b0 = *(const f32x4*)(w0 + c); b1 = *(const f32x4*)(w0 + c + 4); } else if (sel == 1) { b0 = *(const f32x4*)(a0 + c); b1 = *(const f32x4*)(a0 + c + 4); }
#pragma unroll
            for (int ai = 0; ai < 2; ++ai)
#pragma unroll
                for (int m = 0; m < 4; ++m) { f32x4 v0 = acc[ai][bj][m][0] + b0, v1 = acc[ai][bj][m][1] + b1;
                    if (sel == 1) {
#pragma unroll
                        for (int j = 0; j < 4; ++j) { v0[j] = sigmoidf_(v0[j]); v1[j] = sigmoidf_(v1[j]); } }
                    *(u32x4*)(base + (size_t)(row0 + ai * 128 + m * 16) * 1024 + c) = pack8(v0, v1); } }
    }
};
struct EpiPool {
    static constexpr bool PERM = true;
    bf16_t* YB; const float* scale;
    __device__ __forceinline__ void operator()(AccRef acc, const Unit& u, int wr, int wc, int fr, int fq) const {
        const int row0 = u.pm * 256 + wr * 64 + fr, col0 = u.pn * 256 + wc * 32 + 8 * fq;
#pragma unroll
        for (int bj = 0; bj < 2; ++bj) { const int c = col0 + bj * 128; const f32x4 s0 = *(const f32x4*)(scale + c), s1 = *(const f32x4*)(scale + c + 4);
#pragma unroll
            for (int ai = 0; ai < 2; ++ai)
#pragma unroll
                for (int m = 0; m < 4; ++m) *(u32x4*)(YB + (size_t)(row0 + ai * 128 + m * 16) * 1024 + c) = pack8(acc[ai][bj][m][0] * s0, acc[ai][bj][m][1] * s1); }
    }
};
struct EpiGateB {
    static constexpr bool PERM = true;
    bf16_t* MM; const bf16_t* Z;
    __device__ __forceinline__ void operator()(AccRef acc, const Unit& u, int wr, int wc, int fr, int fq) const {
        const int row0 = u.pm * 256 + wr * 64 + fr, col0 = u.pn * 256 + wc * 32 + 8 * fq;
#pragma unroll
        for (int ai = 0; ai < 2; ++ai)
#pragma unroll
            for (int bj = 0; bj < 2; ++bj) { const int c = col0 + bj * 128;
                u32x4 gz[4];
#pragma unroll
                for (int m = 0; m < 4; ++m) gz[m] = *(const u32x4*)((const char*)Z + ((unsigned)(row0 + ai * 128 + m * 16) * (unsigned)ZLD + (unsigned)(ZC_GB + c)) * 2u);
#pragma unroll
                for (int m = 0; m < 4; ++m) { const int r = row0 + ai * 128 + m * 16; f32x4 g0, g1; unpack8(gz[m], g0, g1);
#pragma unroll
                    for (int j = 0; j < 4; ++j) { g0[j] = sigmoidf_(g0[j]); g1[j] = sigmoidf_(g1[j]); }
                    *(u32x4*)(MM + (size_t)r * DM + c) = pack8(g0 * acc[ai][bj][m][0], g1 * acc[ai][bj][m][1]); } }
    }
};
struct EpiGateA {
    static constexpr bool PERM = true;
    const bf16_t* Z; bf16_t* MM;
    __device__ __forceinline__ void operator()(AccRef acc, const Unit& u, int wr, int wc, int fr, int fq) const {
        const int row0 = u.pm * 256 + wr * 64 + fr, col0 = u.pn * 256 + wc * 32 + 8 * fq;
#pragma unroll
        for (int ai = 0; ai < 2; ++ai)
#pragma unroll
            for (int bj = 0; bj < 2; ++bj) { const int c = col0 + bj * 128;
                u32x4 gz[4], pm[4];
#pragma unroll
                for (int m = 0; m < 4; ++m) { const unsigned r = (unsigned)(row0 + ai * 128 + m * 16);
                    gz[m] = *(const u32x4*)((const char*)Z + (r * (unsigned)ZLD + (unsigned)(ZC_GA + c)) * 2u);
                    pm[m] = *(const u32x4*)((const char*)MM + (r * (unsigned)DM + (unsigned)c) * 2u); }
#pragma unroll
                for (int m = 0; m < 4; ++m) { const int r = row0 + ai * 128 + m * 16; f32x4 g0, g1, p0, p1; unpack8(gz[m], g0, g1); unpack8(pm[m], p0, p1);
#pragma unroll
                    for (int j = 0; j < 4; ++j) { g0[j] = sigmoidf_(g0[j]); g1[j] = sigmoidf_(g1[j]); }
                    *(u32x4*)(MM + (size_t)r * DM + c) = pack8(p0 + g0 * acc[ai][bj][m][0], p1 + g1 * acc[ai][bj][m][1]); } }
    }
};
struct EpiOutP {
    static constexpr bool PERM = true;
    bf16_t* C; float* P;
    __device__ __forceinline__ void operator()(AccRef acc, const Unit& u, int wr, int wc, int fr, int fq) const {
        const int row0 = u.pm * 256 + wr * 64 + fr, col0 = u.pn * 256 + wc * 32 + 8 * fq;
#pragma unroll
        for (int ai = 0; ai < 2; ++ai)
#pragma unroll
            for (int m = 0; m < 4; ++m) { const int r = row0 + ai * 128 + m * 16;
#pragma unroll
                for (int bj = 0; bj < 2; ++bj) { const int c = col0 + bj * 128;
                    if (u.sp < 0) *(u32x4*)(C + (size_t)r * DM + c) = pack8(acc[ai][bj][m][0], acc[ai][bj][m][1]);
                    else { float* pp = P + ((size_t)u.sp * 512 + (r - MP)) * DM + c; *(f32x4*)pp = acc[ai][bj][m][0]; *(f32x4*)(pp + 4) = acc[ai][bj][m][1]; } } }
    }
};
struct EpiGate7 {
    static constexpr bool PERM = true;
    bf16_t* G; float* out;
    __device__ __forceinline__ void operator()(AccRef acc, const Unit& u, int wr, int wc, int fr, int fq) const {
        const int row0 = u.pm * 256 + wr * 64 + fr, col0 = u.pn * 256 + wc * 32 + 8 * fq;
#pragma unroll
        for (int ai = 0; ai < 2; ++ai)
#pragma unroll
            for (int m = 0; m < 4; ++m) { bf16_t* rowp = G + (size_t)(row0 + ai * 128 + m * 16) * DFF + col0;
#pragma unroll
                for (int bj = 0; bj < 2; ++bj) *(u32x4*)(rowp + bj * 128) = pack8(acc[ai][bj][m][0], acc[ai][bj][m][1]); }
        const bool special = (u.pm >= 32) || ((u.pm & 7) == 7);
        if (special) {
#pragma unroll
            for (int ai = 0; ai < 2; ++ai)
#pragma unroll
                for (int m = 0; m < 4; ++m) {
                    const int r = row0 + ai * 128 + m * 16; const bool smp = r >= MP; const int b = smp ? (r - MP) >> 2 : r >> 11, t = smp ? (r - MP) & 3 : r & 2047;
                    const int j = smp ? t - 2 : t - 2046;
                    if (j >= 0) {
#pragma unroll
                        for (int bj = 0; bj < 2; ++bj) { float* dst = out + (smp ? O_SCONV : O_PCONV) + ((size_t)b * 2 + j) * DFF + col0 + bj * 128;
                            *(f32x4*)dst = acc[ai][bj][m][0]; *(f32x4*)(dst + 4) = acc[ai][bj][m][1]; } } }
        }
    }
};
struct EpiAct {
    static constexpr bool PERM = true;
    const bf16_t* G; bf16_t* ACT; const float* cw; const float* cb; const float* conv0;
    __device__ __forceinline__ void operator()(AccRef acc, const Unit& u, int wr, int wc, int fr, int fq) const {
        const int row0 = u.pm * 256 + wr * 64 + fr, col0 = u.pn * 256 + wc * 32 + 8 * fq;
        const bool smp_tile = u.pm >= 32;
#pragma unroll
        for (int bj = 0; bj < 2; ++bj) { const int c = col0 + bj * 128;
            const f32x4 w0a = *(const f32x4*)(cw + c), w0b = *(const f32x4*)(cw + c + 4), w1a = *(const f32x4*)(cw + DFF + c), w1b = *(const f32x4*)(cw + DFF + c + 4);
            const f32x4 w2a = *(const f32x4*)(cw + 2 * DFF + c), w2b = *(const f32x4*)(cw + 2 * DFF + c + 4), cba = *(const f32x4*)(cb + c), cbb = *(const f32x4*)(cb + c + 4);
#pragma unroll
            for (int ai = 0; ai < 2; ++ai) {
                u32x4 q2[4], q1[4], q0[4];
#pragma unroll
                for (int m = 0; m < 4; ++m) { const unsigned off = (unsigned)((row0 + ai * 128 + m * 16) * DFF + c) * 2u;
                    q2[m] = *(const u32x4*)((const char*)G + off);
                    u32x4 e1 = (u32x4){0u, 0u, 0u, 0u}, e0 = e1;
                    if (fr < 1) e1 = *(const u32x4*)((const char*)(G - DFF) + off);
                    if (fr < 2) e0 = *(const u32x4*)((const char*)(G - 2 * DFF) + off);
                    q1[m] = e1; q0[m] = e0; }
#pragma unroll
                for (int m = 0; m < 4; ++m) {
#pragma unroll
                    for (int wd = 0; wd < 4; ++wd) { q1[m][wd] = __builtin_amdgcn_update_dpp(q1[m][wd], q2[m][wd], 0x111, 0xF, 0xF, false);
                                                     q0[m][wd] = __builtin_amdgcn_update_dpp(q0[m][wd], q2[m][wd], 0x112, 0xF, 0xF, false); } }
#pragma unroll
                for (int m = 0; m < 4; ++m) {
                    const int r = row0 + ai * 128 + m * 16; const bool smp = r >= MP; const int b = smp ? (r - MP) >> 2 : r >> 11, t = smp ? (r - MP) & 3 : r & 2047;
                    f32x4 x2a, x2b, x1a, x1b, x0a, x0b;
                    unpack8(q2[m], x2a, x2b); unpack8(q1[m], x1a, x1b); unpack8(q0[m], x0a, x0b);
                    if (t < 1) { x1a = (f32x4){0.f, 0.f, 0.f, 0.f}; x1b = x1a; }
                    if (t < 2) { x0a = (f32x4){0.f, 0.f, 0.f, 0.f}; x0b = x0a; }
                    if (smp_tile) {
                        if (t < 1) { x1a = *(const f32x4*)(conv0 + ((size_t)b * 2 + 1) * DFF + c); x1b = *(const f32x4*)(conv0 + ((size_t)b * 2 + 1) * DFF + c + 4); }
                        if (t < 2) { x0a = *(const f32x4*)(conv0 + ((size_t)b * 2 + t) * DFF + c); x0b = *(const f32x4*)(conv0 + ((size_t)b * 2 + t) * DFF + c + 4); }
                    }
                    f32x4 ca = cba + w0a * x0a + w1a * x1a + w2a * x2a, cbv = cbb + w0b * x0b + w1b * x1b + w2b * x2b;
#pragma unroll
                    for (int j = 0; j < 4; ++j) { ca[j] = gelu_tanh(ca[j]); cbv[j] = gelu_tanh(cbv[j]); }
                    *(u32x4*)(ACT + (size_t)r * DFF + c) = pack8(ca * acc[ai][bj][m][0], cbv * acc[ai][bj][m][1]); }
            }
        }
    }
};

constexpr int TP = 136;
template <class Map>
__device__ __forceinline__ void transpose_job(const float* src, int ldsrc, int Ksrc, bf16_t* dst, int Kd, int Nd, Map map, float* tilef, int bid, int nblk) {
    int tid = threadIdx.x; asm volatile("" : "+v"(tid));
    LAS unsigned char* tile = (LAS unsigned char*)tilef;
    const int ntk = Kd / 128, ntn = Nd / 128, ntot = ntk * ntn;
    const int n4 = tid & 31, kp0 = tid >> 5;
    const int rn = tid >> 2, rq = tid & 3;
    f32x4 va[4], vb[4];
    auto load = [&](int ti) {
        const int tn = ti / ntk, tk = ti - tn * ntk; const int sc = map(tn * 128 + n4 * 4);
#pragma unroll
        for (int i = 0; i < 4; ++i) { const int k = tk * 128 + 2 * (kp0 + 16 * i);
            va[i] = (sc >= 0 && k < Ksrc) ? *(const f32x4*)(src + (size_t)k * ldsrc + sc) : (f32x4){0.f, 0.f, 0.f, 0.f};
            vb[i] = (sc >= 0 && k + 1 < Ksrc) ? *(const f32x4*)(src + (size_t)(k + 1) * ldsrc + sc) : (f32x4){0.f, 0.f, 0.f, 0.f}; }
    };
    int ti = bid;
    if (ti < ntot) load(ti);
    for (; ti < ntot; ti += nblk) {
        const int tn = ti / ntk, tk = ti - tn * ntk;
#pragma unroll
        for (int i = 0; i < 4; ++i) { const int kp = kp0 + 16 * i;
#pragma unroll
            for (int j = 0; j < 4; ++j) *(LAS unsigned*)(tile + ((n4 * 4 + j) * TP + 2 * kp) * 2) = cvt_pk_bf16(va[i][j], vb[i][j]); }
        __syncthreads();
        if (ti + nblk < ntot) load(ti + nblk);
        bf16_t* drow = dst + (size_t)(tn * 128 + rn) * Kd + tk * 128 + rq * 32;
#pragma unroll
        for (int i = 0; i < 4; ++i) *(u32x4*)(drow + i * 8) = *(const LAS u32x4*)(tile + (rn * TP + rq * 32 + i * 8) * 2);
        __syncthreads();
    }
}
struct MapId { __device__ int operator()(int n) const { return n; } };
struct MapWin { __device__ int operator()(int n) const { return n < DSH ? n : (n < ZC_P ? -1 : n - (ZC_P - DSH)); } };

__device__ __forceinline__ float z_shift(KArgP p, const bf16_t* Z, int r, int zc) {
    const float z = bf2f(Z[(size_t)r * ZLD + zc]);
    const bool smp = r >= MP; const int t = smp ? (r - MP) & 3 : r & 2047;
    float pv;
    if (t > 0) pv = bf2f(Z[(size_t)(r - 1) * ZLD + zc]); else pv = smp ? p->in[2][(size_t)((r - MP) >> 2) * DSH + zc] : 0.f;
    return z + (pv - z) * p->in[8][zc];
}

struct HeadConst { float mu_r, mu_k, mu_v, k_k, k_a, r_k; };
__device__ __forceinline__ void stage_token(float zr, float zk, float zv, float pr, float pk, float pv, float xw, float a, float g, const HeadConst& hc, float* o, float* bon, int lane) {
    const float r = zr + (pr - zr) * hc.mu_r, k = zk + (pk - zk) * hc.mu_k, v = zv + (pv - zv) * hc.mu_v;
    const float y = -xw;
    const float sp = fmaxf(y, 0.f) + __logf(1.0f + __expf(-fabsf(y)));
    const float dec = __expf(-__expf(-sp - 0.5f));
    const float kr = k * hc.k_k; const float n2 = wave_sum(kr * kr); const float kk = kr * rsqrtf(fmaxf(n2, 1e-24f));
    const float kp = k * (1.0f + (a - 1.0f) * hc.k_a);
    const float bs = wave_sum(r * kp * hc.r_k);
    o[0 * 64 + lane] = dec; o[1 * 64 + lane] = kk; o[2 * 64 + lane] = kk * a; o[3 * 64 + lane] = kp; o[4 * 64 + lane] = r; o[5 * 64 + lane] = v; o[6 * 64 + lane] = g;
    if (lane == 0) *bon = bs;
}

constexpr int ST = 72;
constexpr int L_AT = 0, L_BT = 9216, L_KT = 18432, L_RT = 27648, L_ATT = 36864, L_VMT = 46080, L_BGT = 55296, L_KGT = 64512,
              L_LOFF = 73728, L_LAK = 82944, L_MRB = 92160, L_MRK = 101376, L_LDIAG = 110592, L_CUM = 114688;
constexpr int L_TBD = L_CUM, L_SOLT = L_BT;
constexpr size_t SC_PF = 0, SC_QF = (size_t)2048 * 8192, SC_W2F = (size_t)2 * 2048 * 8192, SC_YLF = (size_t)3 * 2048 * 8192, SC_GAM = (size_t)4 * 2048 * 8192, SC_BON = SC_GAM + (size_t)2048 * 256;

__device__ __forceinline__ bf16x8 frag(LAS unsigned char* lds, int off, int row0, int ks, int lane) {
    return *(const LAS bf16x8*)(lds + off + ((row0 + (lane & 15)) * ST + ks * 32 + (lane >> 4) * 8) * 2);
}
__device__ __forceinline__ void st4(LAS unsigned char* lds, int off, int row, int col, f32x4 v) {
    u32x2 w; w.x = cvt_pk_bf16(v[0], v[1]); w.y = cvt_pk_bf16(v[2], v[3]); *(LAS u32x2*)(lds + off + (row * ST + col) * 2) = w;
}
__device__ __forceinline__ f32x4 ld4(LAS unsigned char* lds, int off, int row, int col) {
    const u32x2 w = *(const LAS u32x2*)(lds + off + (row * ST + col) * 2); return (f32x4){lo_bf(w.x), hi_bf(w.x), lo_bf(w.y), hi_bf(w.y)};
}
#define MFMA16(x, y, acc) __builtin_amdgcn_mfma_f32_16x16x32_bf16((x), (y), (acc), 0, 0, 0)
#define LDS_FENCE() asm volatile("s_waitcnt lgkmcnt(0)" ::: "memory")

struct PARaw { bf16_t z[9][3], xw[8], xa[8]; };
__device__ __forceinline__ void pa_load(KArgP p, int cu, int w, int lane, PARaw& R) {
    const int bh = cu >> 5, c = cu & 31, b = bh >> 4, h = bh & 15, ch = h * 64 + lane;
    const bf16_t* Z = (const bf16_t*)(p->ws + W_Z); const bf16_t* XW = (const bf16_t*)(p->ws + W_XW); const bf16_t* XA = (const bf16_t*)(p->ws + W_XA);
    const int row0 = b * 2048 + c * 64 + w * 8; const bool first = (c == 0 && w == 0);
#pragma unroll
    for (int i = 0; i < 9; ++i)
#pragma unroll
        for (int qq = 0; qq < 3; ++qq) R.z[i][qq] = (i == 0 && first) ? (bf16_t)0 : Z[(size_t)(row0 - 1 + i) * ZLD + qq * 1024 + ch];
#pragma unroll
    for (int i = 0; i < 8; ++i) { R.xw[i] = XW[(size_t)(row0 + i) * 1024 + ch]; R.xa[i] = XA[(size_t)(row0 + i) * 1024 + ch]; }
}
#define PA_BAR() do { asm volatile("s_waitcnt lgkmcnt(0)" ::: "memory"); __builtin_amdgcn_s_barrier(); asm volatile("" ::: "memory"); } while (0)
__device__ __forceinline__ void wkv_pass_a(KArgP p, int cu, LAS unsigned char* lds, PARaw& R, int ncu) {
    int tid = threadIdx.x; asm volatile("" : "+v"(tid));
    const int w = __builtin_amdgcn_readfirstlane(tid >> 6), lane = tid & 63, q = lane >> 4, l15 = lane & 15;
    const int bh = cu >> 5, c = cu & 31, b = bh >> 4, h = bh & 15, ch = h * 64 + lane;
    const bf16_t* Z = (const bf16_t*)(p->ws + W_Z); const bf16_t* XW = (const bf16_t*)(p->ws + W_XW); const bf16_t* XA = (const bf16_t*)(p->ws + W_XA);
    unsigned char* sc = p->ws + W_RA;
    const int row0 = b * 2048 + c * 64 + w * 8;
    float kk[8], bb[8], kp[8], rr[8], vv[8], ld[8];
    {
        const float mu_r = p->in[8][ch], mu_k = p->in[8][1024 + ch], mu_v = p->in[8][2048 + ch], k_k = p->in[14][ch], k_a = p->in[15][ch], r_k = p->in[16][ch];
        float pz[3];
#pragma unroll
        for (int qq = 0; qq < 3; ++qq) pz[qq] = bf2f(R.z[0][qq]);
        float bon[8];
#pragma unroll
        for (int i = 0; i < 8; ++i) {
            float z[3];
#pragma unroll
            for (int qq = 0; qq < 3; ++qq) z[qq] = bf2f(R.z[i + 1][qq]);
            const float xw = bf2f(R.xw[i]), a = bf2f(R.xa[i]);
            const float r = z[0] + (pz[0] - z[0]) * mu_r, k = z[1] + (pz[1] - z[1]) * mu_k, v = z[2] + (pz[2] - z[2]) * mu_v;
#pragma unroll
            for (int qq = 0; qq < 3; ++qq) pz[qq] = z[qq];
            const float y = -xw; const float sp = fmaxf(y, 0.f) + __logf(1.0f + __expf(-fabsf(y)));
            ld[i] = -__expf(-sp - 0.5f);
            const float kr = k * k_k; const float n2 = wave_sum(kr * kr); kk[i] = kr * rsqrtf(fmaxf(n2, 1e-24f));
            kp[i] = k * (1.0f + (a - 1.0f) * k_a); bb[i] = kk[i] * a; rr[i] = r; vv[i] = v;
            bon[i] = wave_sum(r * kp[i] * r_k);
        }
        if (ncu >= 0) pa_load(p, ncu, w, lane, R);
        { float tot = 0.f;
#pragma unroll
          for (int i = 0; i < 8; ++i) tot += ld[i];
          *(LAS float*)(lds + L_CUM + (w * 64 + lane) * 4) = tot; }
        if (lane < 8) { float bv = bon[0];
#pragma unroll
            for (int i = 1; i < 8; ++i) bv = (lane == i) ? bon[i] : bv;
            *(float*)(sc + SC_BON + (size_t)cu * 256 + (w * 8 + lane) * 4) = bv; }
    }
    PA_BAR();
    float cum[8], cumC;
    {
        float base = 0.f, all = 0.f;
#pragma unroll
        for (int seg = 0; seg < 8; ++seg) { const float tq = *(const LAS float*)(lds + L_CUM + (seg * 64 + lane) * 4); all += tq; base += (seg < w) ? tq : 0.f; }
        float acc = base;
#pragma unroll
        for (int i = 0; i < 8; ++i) { acc += ld[i]; cum[i] = acc; }
        cumC = all;
    }
    if (w == 0) *(float*)(sc + SC_GAM + (size_t)cu * 256 + lane * 4) = __expf(cumC);
    {
        float att[8], bgt[8], kgt[8];
#pragma unroll
        for (int i = 0; i < 8; ++i) {
            const int t = w * 8 + i; const float ep = __expf(cum[i]), em = __expf(-cum[i]), eg = __expf(cumC - cum[i]);
            att[i] = -kk[i] * __expf(cum[i] - ld[i]); bgt[i] = bb[i] * eg; kgt[i] = kp[i] * eg;
            *(LAS bf16_t*)(lds + L_AT + (t * ST + lane) * 2) = f2bf(att[i]);
            *(LAS bf16_t*)(lds + L_RT + (t * ST + lane) * 2) = f2bf(rr[i] * ep);
            *(LAS bf16_t*)(lds + L_BT + (t * ST + lane) * 2) = f2bf(bb[i] * em);
            *(LAS bf16_t*)(lds + L_KT + (t * ST + lane) * 2) = f2bf(kp[i] * em);
        }
        u32x4 x;
        x.x = cvt_pk_bf16(att[0], att[1]); x.y = cvt_pk_bf16(att[2], att[3]); x.z = cvt_pk_bf16(att[4], att[5]); x.w = cvt_pk_bf16(att[6], att[7]); *(LAS u32x4*)(lds + L_ATT + (lane * ST + w * 8) * 2) = x;
        x.x = cvt_pk_bf16(vv[0], vv[1]); x.y = cvt_pk_bf16(vv[2], vv[3]); x.z = cvt_pk_bf16(vv[4], vv[5]); x.w = cvt_pk_bf16(vv[6], vv[7]); *(LAS u32x4*)(lds + L_VMT + (lane * ST + w * 8) * 2) = x;
        x.x = cvt_pk_bf16(bgt[0], bgt[1]); x.y = cvt_pk_bf16(bgt[2], bgt[3]); x.z = cvt_pk_bf16(bgt[4], bgt[5]); x.w = cvt_pk_bf16(bgt[6], bgt[7]); *(LAS u32x4*)(lds + L_BGT + (lane * ST + w * 8) * 2) = x;
        x.x = cvt_pk_bf16(kgt[0], kgt[1]); x.y = cvt_pk_bf16(kgt[2], kgt[3]); x.z = cvt_pk_bf16(kgt[4], kgt[5]); x.w = cvt_pk_bf16(kgt[6], kgt[7]); *(LAS u32x4*)(lds + L_KGT + (lane * ST + w * 8) * 2) = x;
    }
    PA_BAR();
    for (int i = tid; i < 9216 / 16; i += NTHR) *(LAS u32x4*)(lds + L_TBD + i * 16) = (u32x4){0u, 0u, 0u, 0u};
    {
        const int jt = w & 3, isR = w >> 2; const int yoff = isR ? L_RT : L_AT;
        const bf16x8 y0 = frag(lds, yoff, 16 * jt, 0, lane), y1 = frag(lds, yoff, 16 * jt, 1, lane);
        const int t = 16 * jt + l15;
#pragma unroll
        for (int xt = 0; xt < 8; ++xt) {
            const int isK = xt >> 2, it = xt & 3; const int xoff = isK ? L_KT : L_BT;
            f32x4 acc = (f32x4){0.f, 0.f, 0.f, 0.f};
            if (it <= jt) { acc = MFMA16(frag(lds, xoff, 16 * it, 0, lane), y0, acc); acc = MFMA16(frag(lds, xoff, 16 * it, 1, lane), y1, acc); }
#pragma unroll
            for (int i = 0; i < 4; ++i) { const int s = 16 * it + 4 * q + i; const bool keep = isR ? (s <= t) : (s < t); acc[i] = keep ? acc[i] : 0.f; }
            const int dst = isR ? (isK ? L_MRK : L_MRB) : (isK ? L_LAK : L_LOFF);
            if (!isR && !isK && it == jt) { *(LAS f32x4*)(lds + L_LDIAG + ((jt * 16 + l15) * 16 + 4 * q) * 4) = acc; acc = (f32x4){0.f, 0.f, 0.f, 0.f}; }
            st4(lds, dst, t, 16 * it + 4 * q, acc);
        }
    }
    PA_BAR();
    f32x4 xacc[4];
#pragma unroll
    for (int i = 0; i < 4; ++i) xacc[i] = (f32x4){0.f, 0.f, 0.f, 0.f};
    if (w == 0) {
        const int blk = q, j = l15; float tc[16];
#pragma unroll
        for (int t = 0; t < 16; ++t) {
            float acc = (t == j) ? 1.0f : 0.0f;
            f32x4 lr[4];
#pragma unroll
            for (int g = 0; g < 4; ++g) lr[g] = *(const LAS f32x4*)(lds + L_LDIAG + ((blk * 16 + t) * 16 + g * 4) * 4);
#pragma unroll
            for (int s = 0; s < t; ++s) acc += lr[s >> 2][s & 3] * tc[s];
            tc[t] = acc;
            *(LAS bf16_t*)(lds + L_TBD + ((16 * blk + t) * ST + 16 * blk + j) * 2) = f2bf(acc);
        }
    } else if (w >= 4) {
        const int vt = w - 4;
#pragma unroll
        for (int i = 0; i < 4; ++i)
#pragma unroll
            for (int ks = 0; ks < 2; ++ks) xacc[i] = MFMA16(frag(lds, L_LAK, 16 * i, ks, lane), frag(lds, L_VMT, 16 * vt, ks, lane), xacc[i]);
    }
    PA_BAR();
    {
        const int crow = 16 * w + l15;
#pragma unroll
        for (int i = 0; i < 4; ++i) {
            f32x4 acc = (w < 4) ? ld4(lds, L_ATT, crow, 16 * i + 4 * q) : xacc[i];
#pragma unroll
            for (int ks = 0; ks < 2; ++ks) acc = MFMA16(frag(lds, L_LOFF, 16 * i, ks, lane), frag(lds, L_SOLT, 16 * w, ks, lane), acc);
            st4(lds, L_SOLT, crow, 16 * i + 4 * q, acc);
            LDS_FENCE();
            f32x4 acc2 = (f32x4){0.f, 0.f, 0.f, 0.f};
#pragma unroll
            for (int ks = 0; ks < 2; ++ks) acc2 = MFMA16(frag(lds, L_TBD, 16 * i, ks, lane), frag(lds, L_SOLT, 16 * w, ks, lane), acc2);
            st4(lds, L_SOLT, crow, 16 * i + 4 * q, acc2);
            LDS_FENCE();
        }
    }
    PA_BAR();
    {
        const int a = w >> 1, pr = w & 1;
        { f32x4 acc[2];
#pragma unroll
            for (int u = 0; u < 2; ++u) { const int kt = 2 * pr + u; acc[u] = ld4(lds, L_RT, 16 * a + l15, 16 * kt + 4 * q);
#pragma unroll
                for (int ks = 0; ks < 2; ++ks) acc[u] = MFMA16(frag(lds, L_SOLT, 16 * kt, ks, lane), frag(lds, L_MRB, 16 * a, ks, lane), acc[u]); }
            *(u32x4*)(sc + SC_W2F + (size_t)cu * 8192 + ((a * 2 + pr) * 64 + lane) * 16) = pack8(acc[0], acc[1]); }
#pragma unroll
        for (int u = 0; u < 2; ++u) { const int vt = 2 * pr + u; f32x4 acc = (f32x4){0.f, 0.f, 0.f, 0.f};
#pragma unroll
            for (int ks = 0; ks < 2; ++ks) { acc = MFMA16(frag(lds, L_SOLT, 64 + 16 * vt, ks, lane), frag(lds, L_MRB, 16 * a, ks, lane), acc); acc = MFMA16(frag(lds, L_VMT, 16 * vt, ks, lane), frag(lds, L_MRK, 16 * a, ks, lane), acc); }
            u32x2 o; o.x = cvt_pk_bf16(acc[0], acc[1]); o.y = cvt_pk_bf16(acc[2], acc[3]);
            *(u32x2*)(sc + SC_YLF + (size_t)cu * 8192 + ((vt * 4 + a) * 64 + lane) * 8) = o; }
        { f32x4 acc[2];
#pragma unroll
            for (int u = 0; u < 2; ++u) { const int kt = 2 * pr + u; acc[u] = (f32x4){0.f, 0.f, 0.f, 0.f};
#pragma unroll
                for (int ks = 0; ks < 2; ++ks) acc[u] = MFMA16(frag(lds, L_SOLT, 16 * kt, ks, lane), frag(lds, L_BGT, 16 * a, ks, lane), acc[u]); }
            *(u32x4*)(sc + SC_PF + (size_t)cu * 8192 + ((a * 2 + pr) * 64 + lane) * 16) = pack8(acc[0], acc[1]); }
#pragma unroll
        for (int u = 0; u < 2; ++u) { const int vt = 2 * pr + u; f32x4 acc = (f32x4){0.f, 0.f, 0.f, 0.f};
#pragma unroll
            for (int ks = 0; ks < 2; ++ks) { acc = MFMA16(frag(lds, L_BGT, 16 * a, ks, lane), frag(lds, L_SOLT, 64 + 16 * vt, ks, lane), acc); acc = MFMA16(frag(lds, L_KGT, 16 * a, ks, lane), frag(lds, L_VMT, 16 * vt, ks, lane), acc); }
            u32x2 o; o.x = cvt_pk_bf16(acc[0], acc[1]); o.y = cvt_pk_bf16(acc[2], acc[3]);
            *(u32x2*)(sc + SC_QF + (size_t)cu * 8192 + ((a * 4 + vt) * 64 + lane) * 8) = o; }
    }
    PA_BAR();
}

#undef PA_BAR_UNUSED
__device__ __forceinline__ void wkv_pass_b(KArgP p, int task, int lane) {
    const int bh = task >> 2, vs = task & 3, q = lane >> 4, l15 = lane & 15;
    const unsigned char* sc = p->ws + W_RA; unsigned char* sf = p->ws + W_SF;
    f32x4 S[4];
#pragma unroll
    for (int m = 0; m < 4; ++m) S[m] = (f32x4){0.f, 0.f, 0.f, 0.f};
    for (int c = 0; c < 32; ++c) {
        const int cu = bh * 32 + c;
        u32x4 pf[4][2]; u32x2 qf[4]; f32x4 gm[4];
#pragma unroll
        for (int m = 0; m < 4; ++m) {
#pragma unroll
            for (int ks = 0; ks < 2; ++ks) pf[m][ks] = *(const u32x4*)(sc + SC_PF + (size_t)cu * 8192 + ((m * 2 + ks) * 64 + lane) * 16);
            qf[m] = *(const u32x2*)(sc + SC_QF + (size_t)cu * 8192 + ((m * 4 + vs) * 64 + lane) * 8);
            gm[m] = *(const f32x4*)(sc + SC_GAM + (size_t)cu * 256 + (16 * m + 4 * q) * 4);
        }
        u32x4 sfr[2];
#pragma unroll
        for (int ks = 0; ks < 2; ++ks) { sfr[ks] = pack8(S[2 * ks], S[2 * ks + 1]); *(u32x4*)(sf + (size_t)cu * 8192 + ((vs * 2 + ks) * 64 + lane) * 16) = sfr[ks]; }
#pragma unroll
        for (int m = 0; m < 4; ++m) {
            f32x4 acc = S[m] * gm[m] + (f32x4){lo_bf(qf[m].x), hi_bf(qf[m].x), lo_bf(qf[m].y), hi_bf(qf[m].y)};
#pragma unroll
            for (int ks = 0; ks < 2; ++ks) { bf16x8 av, bv; __builtin_memcpy(&av, &pf[m][ks], 16); __builtin_memcpy(&bv, &sfr[ks], 16); acc = MFMA16(av, bv, acc); }
            S[m] = acc;
        }
    }
#pragma unroll
    for (int m = 0; m < 4; ++m) *(f32x4*)(p->out + O_PWKV + ((size_t)bh * 64 + 16 * vs + l15) * 64 + 16 * m + 4 * q) = S[m];
}

__device__ __forceinline__ void wkv_pass_c(KArgP p, int cu, int jt, int lane) {
    const int bh = cu >> 5, c = cu & 31, b = bh >> 4, h = bh & 15, q = lane >> 4, l15 = lane & 15;
    const unsigned char* sc = p->ws + W_RA; const unsigned char* sf = p->ws + W_SF;
    const bf16_t* Z = (const bf16_t*)(p->ws + W_Z); const bf16_t* GG = (const bf16_t*)(p->ws + W_GG); bf16_t* YA = (bf16_t*)(p->ws + W_DYA);
    const int t = c * 64 + 16 * jt + l15; const int row = b * 2048 + t;
    bf16x8 w2[2], sfr[4][2]; u32x2 yl[4], zc[4], zp[4], gz[4];
#pragma unroll
    for (int ks = 0; ks < 2; ++ks) w2[ks] = *(const bf16x8*)(sc + SC_W2F + (size_t)cu * 8192 + ((jt * 2 + ks) * 64 + lane) * 16);
#pragma unroll
    for (int vt = 0; vt < 4; ++vt) { const int chv = h * 64 + 16 * vt + 4 * q;
        yl[vt] = *(const u32x2*)(sc + SC_YLF + (size_t)cu * 8192 + ((vt * 4 + jt) * 64 + lane) * 8);
#pragma unroll
        for (int ks = 0; ks < 2; ++ks) sfr[vt][ks] = *(const bf16x8*)(sf + (size_t)cu * 8192 + ((vt * 2 + ks) * 64 + lane) * 16);
        zc[vt] = *(const u32x2*)(Z + (size_t)row * ZLD + 2048 + chv);
        zp[vt] = (t > 0) ? *(const u32x2*)(Z + (size_t)(row - 1) * ZLD + 2048 + chv) : (u32x2){0u, 0u};
        gz[vt] = *(const u32x2*)(GG + (size_t)row * 1024 + chv); }
    const float bon = *(const float*)(sc + SC_BON + (size_t)cu * 256 + (16 * jt + l15) * 4);
    f32x4 y[4]; float s1 = 0.f;
#pragma unroll
    for (int vt = 0; vt < 4; ++vt) {
        f32x4 acc = (f32x4){lo_bf(yl[vt].x), hi_bf(yl[vt].x), lo_bf(yl[vt].y), hi_bf(yl[vt].y)};
#pragma unroll
        for (int ks = 0; ks < 2; ++ks) acc = MFMA16(sfr[vt][ks], w2[ks], acc);
        y[vt] = acc; s1 += (acc[0] + acc[1]) + (acc[2] + acc[3]);
    }
    s1 = xor32_sum(xor16_sum(s1)); const float mu = s1 * (1.0f / 64.0f);
    float s2 = 0.f;
#pragma unroll
    for (int vt = 0; vt < 4; ++vt) { y[vt] -= mu; s2 += (y[vt][0] * y[vt][0] + y[vt][1] * y[vt][1]) + (y[vt][2] * y[vt][2] + y[vt][3] * y[vt][3]); }
    s2 = xor32_sum(xor16_sum(s2)); const float rstd = rsqrtf(s2 * (1.0f / 64.0f) + GN_EPS);
#pragma unroll
    for (int vt = 0; vt < 4; ++vt) {
        const int chv = h * 64 + 16 * vt + 4 * q;
        const f32x4 zv = (f32x4){lo_bf(zc[vt].x), hi_bf(zc[vt].x), lo_bf(zc[vt].y), hi_bf(zc[vt].y)}, pv = (f32x4){lo_bf(zp[vt].x), hi_bf(zp[vt].x), lo_bf(zp[vt].y), hi_bf(zp[vt].y)};
        const f32x4 muv = *(const f32x4*)(p->in[8] + 2048 + chv); const f32x4 vm = zv + (pv - zv) * muv;
        const f32x4 g = (f32x4){lo_bf(gz[vt].x), hi_bf(gz[vt].x), lo_bf(gz[vt].y), hi_bf(gz[vt].y)};
        const f32x4 lw = *(const f32x4*)(p->in[17] + chv), lb = *(const f32x4*)(p->in[18] + chv);
        const f32x4 o = ((y[vt] * rstd) * lw + lb + bon * vm) * g;
        u32x2 ow; ow.x = cvt_pk_bf16(o[0], o[1]); ow.y = cvt_pk_bf16(o[2], o[3]);
        *(u32x2*)(YA + (size_t)row * 1024 + chv) = ow;
    }
}

__device__ __forceinline__ void scan_sample(KArgP p, int unit, float* lds) {
    int tid = threadIdx.x; asm volatile("" : "+v"(tid));
    const int wave = tid >> 6, lane = tid & 63, b = unit >> 4, h = unit & 15, ch = h * 64 + lane;
    const bf16_t* Z = (const bf16_t*)(p->ws + W_Z); const bf16_t* XW = (const bf16_t*)(p->ws + W_XW); const bf16_t* XA = (const bf16_t*)(p->ws + W_XA); const bf16_t* GG = (const bf16_t*)(p->ws + W_GG);
    bf16_t* YA = (bf16_t*)(p->ws + W_DYA);
    float* ops = lds + wave * (4 * 7 * 64 + 64);
    float* bon = ops + 4 * 7 * 64;
    HeadConst hc; hc.mu_r = p->in[8][ch]; hc.mu_k = p->in[8][1024 + ch]; hc.mu_v = p->in[8][2048 + ch]; hc.k_k = p->in[14][ch]; hc.k_a = p->in[15][ch]; hc.r_k = p->in[16][ch];
    const float lw = p->in[17][ch], lb = p->in[18][ch];
    const int rbase = MP + b * 4;
    float pz[3];
#pragma unroll
    for (int q = 0; q < 3; ++q) pz[q] = p->in[2][(size_t)b * DSH + q * 1024 + ch];
#pragma unroll
    for (int t = 0; t < 4; ++t) {
        float z[3];
#pragma unroll
        for (int q = 0; q < 3; ++q) z[q] = bf2f(Z[(size_t)(rbase + t) * ZLD + q * 1024 + ch]);
        const size_t ro = (size_t)(rbase + t) * 1024 + ch;
        stage_token(z[0], z[1], z[2], pz[0], pz[1], pz[2], bf2f(XW[ro]), bf2f(XA[ro]), bf2f(GG[ro]), hc, ops + t * 7 * 64, bon + t, lane);
#pragma unroll
        for (int q = 0; q < 3; ++q) pz[q] = z[q];
    }
    f32x4 S[16];
    const float* s0 = p->in[3] + ((size_t)unit * 64 + lane) * 64;
#pragma unroll
    for (int j = 0; j < 16; ++j) S[j] = *(const f32x4*)(s0 + j * 4);
    __syncthreads();
#pragma nounroll
    for (int t = 0; t < 4; ++t) {
        const float* o = ops + t * 7 * 64;
        f32x4 a4 = (f32x4){0.f, 0.f, 0.f, 0.f};
#pragma unroll
        for (int j = 0; j < 16; ++j) { a4 += S[j] * *(const f32x4*)(o + 64 + j * 4); if ((j & 3) == 3) asm volatile("" ::: "memory"); }
        const float sa = -((a4[0] + a4[1]) + (a4[2] + a4[3]));
        const float vv = o[320 + lane];
        f32x4 y4 = (f32x4){0.f, 0.f, 0.f, 0.f};
#pragma unroll
        for (int j = 0; j < 16; ++j) { S[j] = S[j] * *(const f32x4*)(o + j * 4) + (sa * *(const f32x4*)(o + 128 + j * 4) + vv * *(const f32x4*)(o + 192 + j * 4)); y4 += S[j] * *(const f32x4*)(o + 256 + j * 4); if ((j & 1) == 1) asm volatile("" ::: "memory"); }
        const float y = (y4[0] + y4[1]) + (y4[2] + y4[3]);
        const float mu = wave_sum(y) * (1.0f / 64.0f); const float d = y - mu; const float var = wave_sum(d * d) * (1.0f / 64.0f);
        const float yn = d * rsqrtf(var + GN_EPS) * lw + lb;
        YA[(size_t)(rbase + t) * 1024 + ch] = f2bf((yn + bon[t] * vv) * o[384 + lane]);
    }
    float* so = p->out + O_SWKV + ((size_t)unit * 64 + lane) * 64;
#pragma unroll
    for (int j = 0; j < 16; ++j) *(f32x4*)(so + j * 4) = S[j];
    __syncthreads();
}

__device__ __forceinline__ void row_load_bf(f32x4 (&o)[8], const bf16_t* C, int row, int lane) {
#pragma unroll
    for (int i = 0; i < 8; ++i) { const u32x2 w = *(const u32x2*)(C + (size_t)row * DM + i * 256 + lane * 4); o[i] = (f32x4){lo_bf(w.x), hi_bf(w.x), lo_bf(w.y), hi_bf(w.y)}; }
}
template <int S>
__device__ __forceinline__ f32x4 part_sum(const float* P, int srow, int c) {
    f32x4 a = *(const f32x4*)(P + (size_t)srow * DM + c);
#pragma unroll
    for (int sp = 1; sp < S; ++sp) a += *(const f32x4*)(P + ((size_t)sp * 512 + srow) * DM + c);
    return a;
}
__device__ __forceinline__ float sumsq8(const f32x4 (&v)[8]) { float s = 0.f;
#pragma unroll
    for (int i = 0; i < 8; ++i) s += (v[i][0] * v[i][0] + v[i][1] * v[i][1]) + (v[i][2] * v[i][2] + v[i][3] * v[i][3]);
    return s; }

__global__ void __launch_bounds__(NTHR, 2) fwd_megakernel(Params p_unused) {
    extern __shared__ __attribute__((aligned(16))) unsigned char lds_raw[];
    cg::grid_group grid = cg::this_grid();
    LAS unsigned char* lds = (LAS unsigned char*)lds_raw;
    float* ldsf = (float*)lds_raw;
    const int bid = blockIdx.x, nblk = gridDim.x;
    __shared__ uint4 xb_words;
    if (threadIdx.x == 0) xb_words = make_uint4(0u, 0u, 0u, 0u);
    __syncthreads();
    if (kargs()->ws == nullptr) grid.sync();
    const XcdBarrier xbar = xcd_barrier_post((unsigned*)(kargs()->ws + W_BAR), (volatile LAS unsigned*)&xb_words);
#define PHASE_BEGIN() KArgP p = kargs(); int tid = threadIdx.x; asm volatile("" : "+v"(tid)); const int wave = tid >> 6, lane = tid & 63; (void)wave; (void)lane; \
    unsigned char* ws = p->ws; bf16_t* Z = (bf16_t*)(ws + W_Z); float* ssq = (float*)(ws + W_SSQ); float* Y = p->out + O_Y; (void)Z; (void)ssq; (void)Y;

    {
        PHASE_BEGIN();
    transpose_job(p->in[7], 8480, 2048, (bf16_t*)(ws + W_IN), 2048, 8704, MapWin(), ldsf, bid, nblk);
    {
        bf16_t* H = (bf16_t*)(ws + W_H); const float* gw = p->in[6];
        for (int row = bid * 8 + wave; row < M; row += 2 * nblk * 8) {
            const int rowB = row + nblk * 8; const bool hasB = rowB < M;
            const float* xa = xrow(p, row); const float* xb = xrow(p, hasB ? rowB : row); f32x4 va[8], vb[8];
#pragma unroll
            for (int i = 0; i < 8; ++i) { va[i] = *(const f32x4*)(xa + i * 256 + lane * 4); vb[i] = *(const f32x4*)(xb + i * 256 + lane * 4); }
            const float ra = rsqrtf(wave_sum(sumsq8(va)) * (1.0f / DM) + NORM_EPS), rb = rsqrtf(wave_sum(sumsq8(vb)) * (1.0f / DM) + NORM_EPS);
#pragma unroll
            for (int i = 0; i < 8; ++i) { const f32x4 g = *(const f32x4*)(gw + i * 256 + lane * 4); const f32x4 oa = va[i] * ra * g, ob = vb[i] * rb * g;
                u32x2 w; w.x = cvt_pk_bf16(oa[0], oa[1]); w.y = cvt_pk_bf16(oa[2], oa[3]); *(u32x2*)(H + (size_t)row * DM + i * 256 + lane * 4) = w;
                if (hasB) { u32x2 w2; w2.x = cvt_pk_bf16(ob[0], ob[1]); w2.y = cvt_pk_bf16(ob[2], ob[3]); *(u32x2*)(H + (size_t)rowB * DM + i * 256 + lane * 4) = w2; } }
        }
        for (int e = bid * NTHR + tid; e < 128 * 11 * 256; e += nblk * NTHR) { const int c4 = e & 255, j = (e >> 8) % 11, b = (e >> 8) / 11;
            *(f32x4*)(p->out + O_SPOOL + ((size_t)b * 15 + j) * 1024 + c4 * 4) = *(const f32x4*)(p->in[4] + ((size_t)b * 15 + j + 4) * 1024 + c4 * 4); }
    }
    }
    xcd_barrier(xbar);

    {
        PHASE_BEGIN();
        pg8::Gemm g{(const bf16_t*)(ws + W_H), (const bf16_t*)(ws + W_IN), M, 8704, 2048, 2048, 2048, 0, 0}; pg8::StaticOrder S; S.init(M, 8704, nblk, bid, 2048);
        EpiZ E{Z, p->out}; pg8::gemm_phase(lds, g, S, E);
        { const int nfull = (34 * 34) / nblk, nrem = (34 * 34) - nfull * nblk;
          if (bid >= nrem && nrem > 0 && nblk - nrem >= 8) { const int ob = bid - nrem, onb = nblk - nrem;
            transpose_job(p->in[19], 2048, 1024, (bf16_t*)(ws + W_AB), 1024, 2048, MapId(), ldsf, ob, onb);
            transpose_job(p->in[22], 2048, 1024, (bf16_t*)(ws + W_AB) + (size_t)2048 * 1024, 1024, 2048, MapId(), ldsf, ob, onb);
            transpose_job(p->in[23], 2048, 2048, (bf16_t*)(ws + W_O), 2048, 2048, MapId(), ldsf, ob, onb);
            for (int g = 0; g < 4; ++g) transpose_job(p->in[20] + (size_t)g * 65536, 256, 256, (bf16_t*)(ws + W_POOL) + (size_t)g * 65536, 256, 256, MapId(), ldsf, ob, onb);
            transpose_job(p->in[10], 1024, 64, (bf16_t*)(ws + W_LR), 256, 1024, MapId(), ldsf, ob, onb);
            transpose_job(p->in[12], 1024, 64, (bf16_t*)(ws + W_LR) + (size_t)1024 * 256, 256, 1024, MapId(), ldsf, ob, onb);
            transpose_job(p->in[13], 1024, 160, (bf16_t*)(ws + W_LR) + (size_t)2048 * 256, 256, 1024, MapId(), ldsf, ob, onb);
          } else if (nrem == 0 || nblk - nrem < 8) {
            transpose_job(p->in[19], 2048, 1024, (bf16_t*)(ws + W_AB), 1024, 2048, MapId(), ldsf, bid, nblk);
            transpose_job(p->in[22], 2048, 1024, (bf16_t*)(ws + W_AB) + (size_t)2048 * 1024, 1024, 2048, MapId(), ldsf, bid, nblk);
            transpose_job(p->in[23], 2048, 2048, (bf16_t*)(ws + W_O), 2048, 2048, MapId(), ldsf, bid, nblk);
            for (int g = 0; g < 4; ++g) transpose_job(p->in[20] + (size_t)g * 65536, 256, 256, (bf16_t*)(ws + W_POOL) + (size_t)g * 65536, 256, 256, MapId(), ldsf, bid, nblk);
            transpose_job(p->in[10], 1024, 64, (bf16_t*)(ws + W_LR), 256, 1024, MapId(), ldsf, bid, nblk);
            transpose_job(p->in[12], 1024, 64, (bf16_t*)(ws + W_LR) + (size_t)1024 * 256, 256, 1024, MapId(), ldsf, bid, nblk);
            transpose_job(p->in[13], 1024, 160, (bf16_t*)(ws + W_LR) + (size_t)2048 * 256, 256, 1024, MapId(), ldsf, bid, nblk);
          } }
    }
    xcd_barrier(xbar);

    {
        PHASE_BEGIN();
        bf16_t* A2 = (bf16_t*)(ws + W_A2);
        for (int e = bid * NTHR + tid; e < M * 96; e += nblk * NTHR) { const int r = e / 96, j8 = e - r * 96; u32x4 o = (u32x4){0u, 0u, 0u, 0u};
            int kind = -1, zc = 0;
            if (j8 < 8) { kind = 0; zc = ZC_LR + j8 * 8; } else if (j8 >= 32 && j8 < 40) { kind = 1; zc = ZC_LR + 64 + (j8 - 32) * 8; } else if (j8 >= 64 && j8 < 84) { kind = 2; zc = ZC_LR + 128 + (j8 - 64) * 8; }
            if (kind >= 0) {
                const bool smp = r >= MP; const int t = smp ? (r - MP) & 3 : r & 2047;
                f32x4 z0, z1, p0, p1; unpack8(*(const u32x4*)(Z + (size_t)r * ZLD + zc), z0, z1);
                if (t > 0) unpack8(*(const u32x4*)(Z + (size_t)(r - 1) * ZLD + zc), p0, p1);
                else if (smp) { const float* sp = p->in[2] + (size_t)((r - MP) >> 2) * DSH + zc; p0 = *(const f32x4*)sp; p1 = *(const f32x4*)(sp + 4); }
                else { p0 = (f32x4){0.f, 0.f, 0.f, 0.f}; p1 = p0; }
                const f32x4 m0 = *(const f32x4*)(p->in[8] + zc), m1 = *(const f32x4*)(p->in[8] + zc + 4);
                f32x4 v0 = z0 + (p0 - z0) * m0, v1 = z1 + (p1 - z1) * m1;
#pragma unroll
                for (int j = 0; j < 4; ++j) {
                    if (kind == 0) { v0[j] = 1.0f - 2.0f * __builtin_amdgcn_rcpf(1.0f + __expf(2.0f * v0[j])); v1[j] = 1.0f - 2.0f * __builtin_amdgcn_rcpf(1.0f + __expf(2.0f * v1[j])); }
                    else if (kind == 2) { v0[j] = sigmoidf_(v0[j]); v1[j] = sigmoidf_(v1[j]); } }
                o = pack8(v0, v1); }
            *(u32x4*)(A2 + (size_t)r * 768 + j8 * 8) = o; }
        bf16_t* D = (bf16_t*)(ws + W_DYA);
        for (int e = bid * NTHR + tid; e < 512 * 128; e += nblk * NTHR) { const int seg = e >> 7, c = (e & 127) * 8; const int gi = c >> 8, win = 2 << gi;
            const int r0 = seg * 16, t0 = r0 & 2047;
            f32x4 s0 = (f32x4){0.f, 0.f, 0.f, 0.f}, s1 = s0;
            for (int j = 1; j < win; ++j) { if (t0 - j >= 0) { f32x4 a, bq; unpack8(*(const u32x4*)(Z + (size_t)(r0 - j) * ZLD + ZC_P + c), a, bq); s0 += a; s1 += bq; } }
#pragma unroll 4
            for (int i = 0; i < 16; ++i) { const int t = t0 + i; f32x4 a, bq; unpack8(*(const u32x4*)(Z + (size_t)(r0 + i) * ZLD + ZC_P + c), a, bq);
                s0 += a; s1 += bq; const float ic = 1.0f / (float)min(win, t + 1);
                *(u32x4*)(D + (size_t)(r0 + i) * 1024 + c) = pack8(s0 * ic - a, s1 * ic - bq);
                if (t - win + 1 >= 0) { f32x4 oa, ob; unpack8(*(const u32x4*)(Z + (size_t)(r0 + i - win + 1) * ZLD + ZC_P + c), oa, ob); s0 -= oa; s1 -= ob; } }
        }
        for (int e = bid * NTHR + tid; e < 512 * 128; e += nblk * NTHR) { const int r = MP + (e >> 7), c = (e & 127) * 8; const int gi = c >> 8, win = 2 << gi;
            const int b = (r - MP) >> 2, t = (r - MP) & 3;
            f32x4 s0 = (f32x4){0.f, 0.f, 0.f, 0.f}, s1 = s0, z0 = s0, z1 = s0;
            for (int j = 0; j < win; ++j) { const int tj = t - j; f32x4 a, bq;
                if (tj >= 0) unpack8(*(const u32x4*)(Z + (size_t)(r - j) * ZLD + ZC_P + c), a, bq);
                else { const float* sp = p->in[4] + ((size_t)b * 15 + (15 + tj)) * 1024 + c; a = *(const f32x4*)sp; bq = *(const f32x4*)(sp + 4); }
                if (j == 0) { z0 = a; z1 = bq; }
                s0 += a; s1 += bq; }
            const float ic = 1.0f / (float)win;
            *(u32x4*)(D + (size_t)r * 1024 + c) = pack8(s0 * ic - z0, s1 * ic - z1); }
    }
    xcd_barrier(xbar);

    {
        PHASE_BEGIN();
        pg8::Gemm g{(const bf16_t*)(ws + W_A2), (const bf16_t*)(ws + W_LR), M, 3072, 256, 768, 256, 2, 256}; pg8::LowRankOrder S; S.part = 0; S.G = nblk; S.c = bid; S.ntk = 4;
        EpiLR E{(bf16_t*)(ws + W_XW), p->in[9], p->in[11]}; pg8::gemm_phase(lds, g, S, E);
        pg8::Gemm g3{(const bf16_t*)(ws + W_DYA), (const bf16_t*)(ws + W_POOL), M, 1024, 256, 1024, 256, 0, 256}; pg8::StaticOrder S3; S3.init(M, 1024, nblk, nblk - 1 - bid, 256);
        EpiPool E3{(bf16_t*)(ws + W_YB), p->in[21]}; pg8::gemm_phase(lds, g3, S3, E3);
    }
    xcd_barrier(xbar);

    {
        PHASE_BEGIN();
        scan_sample(p, bid * 8 + wave, ldsf);
        __syncthreads();
        { PARaw R; int cu = bid; if (cu < 2048) pa_load(p, cu, wave, lane, R);
          for (; cu < 2048; cu += nblk) wkv_pass_a(p, cu, lds, R, cu + nblk < 2048 ? cu + nblk : -1);
          __syncthreads(); }
    }
    xcd_barrier(xbar);
    {
        PHASE_BEGIN();
        if (bid < 64) { if (wave < 4) wkv_pass_b(p, bid * 4 + wave, lane); }
        else {
            const int ob = bid - 64, onb = nblk - 64;
            pg8::Gemm g{(const bf16_t*)(ws + W_YB), (const bf16_t*)(ws + W_AB) + (size_t)2048 * 1024, M, 2048, 1024, 1024, 1024, 0, 0};
            pg8::MixOrder S; S.base.init(MP, 2048, 1, 0, 1024); S.G = onb; S.c = ob; S.sample_only = false;
            EpiGateB E{(bf16_t*)(ws + W_MM), Z}; pg8::gemm_phase(lds, g, S, E);
            pg8::Gemm ga{(const bf16_t*)(ws + W_DYA), (const bf16_t*)(ws + W_AB), M, 2048, 1024, 1024, 1024, 0, 0}; pg8::MixOrder SS = S; SS.sample_only = true;
            EpiGateA EA{Z, (bf16_t*)(ws + W_MM)}; pg8::gemm_phase(lds, ga, SS, EA);
            { const int first1 = 256 - (onb - 16), nfree = (onb - 16) - first1;
              pg8::Gemm gl{(const bf16_t*)(ws + W_A2), (const bf16_t*)(ws + W_LR), M, 3072, 256, 768, 256, 2, 256};
              pg8::LowRankOrder SL; SL.part = 1; SL.G = nfree > 0 ? nfree : onb; SL.c = nfree > 0 ? ((ob >= first1 && ob < onb - 16) ? ob - first1 : -1) : ob; SL.ntk = 4;
              EpiLR EL{(bf16_t*)(ws + W_XW), p->in[9], p->in[11]}; pg8::gemm_phase(lds, gl, SL, EL); }
        }
    }
    xcd_barrier(xbar);
    {
        PHASE_BEGIN();
        for (int cu = bid * 2 + (wave >> 2); cu < 2048; cu += nblk * 2) { if (wave < 8) wkv_pass_c(p, cu, wave & 3, lane); }
    }
    xcd_barrier(xbar);
    {
        PHASE_BEGIN();
        transpose_job(p->in[26], 11264, 2048, (bf16_t*)(ws + W_GU), 2048, 11264, MapId(), ldsf, bid, nblk);
        transpose_job(p->in[29], 2048, 5632, (bf16_t*)(ws + W_D), 5632, 2048, MapId(), ldsf, bid, nblk);
        pg8::Gemm g{(const bf16_t*)(ws + W_DYA), (const bf16_t*)(ws + W_AB), M, 2048, 1024, 1024, 1024, 0, 0}; pg8::StaticOrder S; S.init(MP, 2048, nblk, bid, 1024);
        EpiGateA E{Z, (bf16_t*)(ws + W_MM)}; pg8::gemm_phase(lds, g, S, E);
    }
    xcd_barrier(xbar);

    {
        PHASE_BEGIN();
        pg8::Gemm g{(const bf16_t*)(ws + W_MM), (const bf16_t*)(ws + W_O), M, 2048, 2048, 2048, 2048, 0, 0}; pg8::SplitOrder S; S.init(nblk, bid, 2048, 8);
        EpiOutP E{(bf16_t*)(ws + W_O16), (float*)(ws + W_PART5)}; pg8::gemm_phase(lds, g, S, E);
    }
    xcd_barrier(xbar);

    {
        PHASE_BEGIN();
        bf16_t* H2 = (bf16_t*)(ws + W_H2); const float* g1 = p->in[24]; const float* g2 = p->in[25]; const float* PT = (const float*)(ws + W_PART5); const bf16_t* O16 = (const bf16_t*)(ws + W_O16);
        const int stride = nblk * 8;
        for (int row = bid * 8 + wave; row < MP; row += 2 * stride) {
            const int rowB = row + stride; const bool hasB = rowB < MP;
            f32x4 oa[8], ob[8], xa[8], xb[8];
            row_load_bf(oa, O16, row, lane); if (hasB) row_load_bf(ob, O16, rowB, lane);
#pragma unroll
            for (int i = 0; i < 8; ++i) { xa[i] = *(const f32x4*)(p->in[0] + (size_t)row * DM + i * 256 + lane * 4); if (hasB) xb[i] = *(const f32x4*)(p->in[0] + (size_t)rowB * DM + i * 256 + lane * 4); }
            const float ra = rsqrtf(wave_sum(sumsq8(oa)) * (1.0f / DM) + NORM_EPS), rb = hasB ? rsqrtf(wave_sum(sumsq8(ob)) * (1.0f / DM) + NORM_EPS) : 0.f;
#pragma unroll
            for (int i = 0; i < 8; ++i) { const int c = i * 256 + lane * 4; const f32x4 g = *(const f32x4*)(g1 + c);
                xa[i] = xa[i] + oa[i] * ra * g; *(f32x4*)(Y + (size_t)row * DM + c) = xa[i];
                if (hasB) { xb[i] = xb[i] + ob[i] * rb * g; *(f32x4*)(Y + (size_t)rowB * DM + c) = xb[i]; } }
            const float qa = rsqrtf(wave_sum(sumsq8(xa)) * (1.0f / DM) + NORM_EPS), qb = hasB ? rsqrtf(wave_sum(sumsq8(xb)) * (1.0f / DM) + NORM_EPS) : 0.f;
#pragma unroll
            for (int i = 0; i < 8; ++i) { const int c = i * 256 + lane * 4; const f32x4 g = *(const f32x4*)(g2 + c);
                { const f32x4 o = xa[i] * qa * g; u32x2 w; w.x = cvt_pk_bf16(o[0], o[1]); w.y = cvt_pk_bf16(o[2], o[3]); *(u32x2*)(H2 + (size_t)row * DM + c) = w; }
                if (hasB) { const f32x4 o = xb[i] * qb * g; u32x2 w; w.x = cvt_pk_bf16(o[0], o[1]); w.y = cvt_pk_bf16(o[2], o[3]); *(u32x2*)(H2 + (size_t)rowB * DM + c) = w; } }
        }
        for (int srow = bid * 8 + wave; srow < M - MP; srow += stride) {
            const int row = MP + srow; float s1 = 0.f;
#pragma unroll 1
            for (int i = 0; i < 8; ++i) { const f32x4 o = part_sum<8>(PT, srow, i * 256 + lane * 4); s1 += (o[0] * o[0] + o[1] * o[1]) + (o[2] * o[2] + o[3] * o[3]); }
            const float ra = rsqrtf(wave_sum(s1) * (1.0f / DM) + NORM_EPS); float s2 = 0.f;
#pragma unroll 1
            for (int i = 0; i < 8; ++i) { const int c = i * 256 + lane * 4; const f32x4 o = part_sum<8>(PT, srow, c);
                const f32x4 v = *(const f32x4*)(p->in[1] + (size_t)srow * DM + c) + o * ra * *(const f32x4*)(g1 + c); *(f32x4*)(Y + (size_t)row * DM + c) = v; s2 += (v[0] * v[0] + v[1] * v[1]) + (v[2] * v[2] + v[3] * v[3]); }
            const float qa = rsqrtf(wave_sum(s2) * (1.0f / DM) + NORM_EPS);
            asm volatile("s_waitcnt vmcnt(0)" ::: "memory");
#pragma unroll 1
            for (int i = 0; i < 8; ++i) { const int c = i * 256 + lane * 4; const f32x4 o = *(const f32x4*)(Y + (size_t)row * DM + c) * qa * *(const f32x4*)(g2 + c);
                u32x2 w; w.x = cvt_pk_bf16(o[0], o[1]); w.y = cvt_pk_bf16(o[2], o[3]); *(u32x2*)(H2 + (size_t)row * DM + c) = w; }
        }
    }
    xcd_barrier(xbar);

    {
        PHASE_BEGIN();
        pg8::Gemm g{(const bf16_t*)(ws + W_H2), (const bf16_t*)(ws + W_GU), M, DFF, 2048, 2048, 2048, 0, 0}; pg8::StaticOrder S; S.init(M, DFF, nblk, bid, 2048);
        EpiGate7 E{(bf16_t*)(ws + W_GATE), p->out}; pg8::gemm_phase(lds, g, S, E);
    }
    xcd_barrier(xbar);

    {
        PHASE_BEGIN();
        pg8::Gemm g{(const bf16_t*)(ws + W_H2), (const bf16_t*)(ws + W_GU) + (size_t)DFF * 2048, M, DFF, 2048, 2048, 2048, 0, 0}; pg8::StaticOrder S; S.init(M, DFF, nblk, bid, 2048);
        EpiAct E{(const bf16_t*)(ws + W_GATE), (bf16_t*)(ws + W_ACT), p->in[27], p->in[28], p->in[5]}; pg8::gemm_phase(lds, g, S, E);
    }
    xcd_barrier(xbar);

    {
        PHASE_BEGIN();
        pg8::Gemm g{(const bf16_t*)(ws + W_ACT), (const bf16_t*)(ws + W_D), M, 2048, DFF, DFF, DFF, 0, 0}; pg8::SplitOrder S; S.init(nblk, bid, DFF, 11);
        EpiOutP E{(bf16_t*)(ws + W_F), (float*)(ws + W_PART9)}; pg8::gemm_phase(lds, g, S, E);
    }
    xcd_barrier(xbar);

    {
        PHASE_BEGIN();
        const bf16_t* F = (const bf16_t*)(ws + W_F); const float* g3 = p->in[30]; const float* PT = (const float*)(ws + W_PART9);
        const int stride = nblk * 8;
        for (int row = bid * 8 + wave; row < MP; row += 2 * stride) {
            const int rowB = row + stride; const bool hasB = rowB < MP;
            f32x4 fa[8], fb[8], xa[8], xb[8];
            row_load_bf(fa, F, row, lane); if (hasB) row_load_bf(fb, F, rowB, lane);
#pragma unroll
            for (int i = 0; i < 8; ++i) { xa[i] = *(const f32x4*)(Y + (size_t)row * DM + i * 256 + lane * 4); if (hasB) xb[i] = *(const f32x4*)(Y + (size_t)rowB * DM + i * 256 + lane * 4); }
            const float ra = rsqrtf(wave_sum(sumsq8(fa)) * (1.0f / DM) + NORM_EPS), rb = hasB ? rsqrtf(wave_sum(sumsq8(fb)) * (1.0f / DM) + NORM_EPS) : 0.f;
#pragma unroll
            for (int i = 0; i < 8; ++i) { const int c = i * 256 + lane * 4; const f32x4 g = *(const f32x4*)(g3 + c);
                *(f32x4*)(Y + (size_t)row * DM + c) = xa[i] + fa[i] * ra * g;
                if (hasB) *(f32x4*)(Y + (size_t)rowB * DM + c) = xb[i] + fb[i] * rb * g; }
        }
        for (int srow = bid * 8 + wave; srow < M - MP; srow += stride) {
            const int row = MP + srow; float s1 = 0.f;
#pragma unroll 1
            for (int i = 0; i < 8; ++i) { const f32x4 o = part_sum<11>(PT, srow, i * 256 + lane * 4); s1 += (o[0] * o[0] + o[1] * o[1]) + (o[2] * o[2] + o[3] * o[3]); }
            const float ra = rsqrtf(wave_sum(s1) * (1.0f / DM) + NORM_EPS);
#pragma unroll 1
            for (int i = 0; i < 8; ++i) { const int c = i * 256 + lane * 4; const f32x4 o = part_sum<11>(PT, srow, c);
                *(f32x4*)(Y + (size_t)row * DM + c) = *(const f32x4*)(Y + (size_t)row * DM + c) + o * ra * *(const f32x4*)(g3 + c); }
        }
    }
}

extern "C" void kernel_launch(void* const* d_in, const int* in_sizes, int n_in, void* d_out, int out_size, void* d_ws, size_t ws_size, hipStream_t stream) {
    static int grid_blocks = 0;
    if (!grid_blocks) {
        int dev = 0, cus = 0, per_cu = 0;
        hipGetDevice(&dev);
        hipDeviceGetAttribute(&cus, hipDeviceAttributeMultiprocessorCount, dev);
        hipFuncSetAttribute((const void*)fwd_megakernel, hipFuncAttributeMaxDynamicSharedMemorySize, LDS_BYTES);
        hipOccupancyMaxActiveBlocksPerMultiprocessor(&per_cu, (const void*)fwd_megakernel, NTHR, LDS_BYTES);
        if (per_cu < 1) per_cu = 1;
        grid_blocks = cus * 1;
        if (ws_size < W_END) fprintf(stderr, "kernel_launch: workspace too small: %zu < %zu\n", ws_size, (size_t)W_END);
        if (n_in != 31) fprintf(stderr, "kernel_launch: expected 31 inputs, got %d\n", n_in);
    }
    Params p{};
    for (int i = 0; i < 31; ++i) p.in[i] = (const float*)d_in[i];
    p.out = (float*)d_out; p.ws = (unsigned char*)d_ws;
    hipMemsetAsync((unsigned char*)d_ws + W_BAR, 0, 16384, stream);
    void* args[] = {&p};
    hipError_t e = hipLaunchCooperativeKernel((const void*)fwd_megakernel, dim3(grid_blocks), dim3(NTHR), args, LDS_BYTES, stream);
    if (e != hipSuccess) fprintf(stderr, "cooperative launch failed: %s (grid %d)\n", hipGetErrorString(e), grid_blocks);
}
```

```cpp
#include <hip/hip_runtime.h>
#include <hip/hip_cooperative_groups.h>
#include <cstdio>
namespace cg = cooperative_groups;

#define LAS __attribute__((address_space(3)))
typedef unsigned short bf16_t;
typedef short bf16x8 __attribute__((ext_vector_type(8)));
typedef float f32x4 __attribute__((ext_vector_type(4)));
typedef float f32x2 __attribute__((ext_vector_type(2)));
typedef unsigned u32x4 __attribute__((ext_vector_type(4)));
typedef unsigned u32x2 __attribute__((ext_vector_type(2)));

constexpr int M = 8704;
constexpr int MP = 8192;
constexpr int DM = 2048, DR = 1024, DSH = 3360, DFF = 5632;
constexpr int ZLD = 8704;
constexpr int ZC_LR = 3072, ZC_P = 3584, ZC_GA = 4608, ZC_GB = 6656;
constexpr int NTHR = 512;
constexpr int LDS_BYTES = 131072;
constexpr float NORM_EPS = 1e-6f, GN_EPS = 64e-5f;

constexpr size_t O_Y = 0;
constexpr size_t O_PSHIFT = 17825792, O_PWKV = 17839232, O_PPOOL = 18101376, O_PCONV = 18162816;
constexpr size_t O_SSHIFT = 18207872, O_SWKV = 18637952, O_SPOOL = 27026560, O_SCONV = 28992640;

constexpr size_t SZ_M1024_BF = (size_t)M * 1024 * 2;
constexpr size_t W_AB = 0;
constexpr size_t W_O = W_AB + 8388608;
constexpr size_t W_POOL = W_O + 8388608;
constexpr size_t W_LR = W_POOL + 524288;
constexpr size_t W_SSQ = W_LR + 1572864;
constexpr size_t W_RA = W_SSQ + (size_t)M * 32 * 4;
constexpr size_t W_IN = W_RA;
constexpr size_t W_H = W_RA + (size_t)8704 * 2048 * 2;
constexpr size_t W_GU = W_RA;
constexpr size_t W_D = W_RA + (size_t)11264 * 2048 * 2;
constexpr size_t W_Z = W_RA + (size_t)2 * 8704 * 2048 * 2;
constexpr size_t W_H2 = W_Z;
constexpr size_t W_GATE = W_Z + (size_t)M * 2048 * 2;
constexpr size_t W_F = W_Z;
constexpr size_t W_O16 = W_Z + (size_t)M * 2048 * 4 + (size_t)1048576;
constexpr size_t W_PART5 = W_Z + (size_t)M * 2048 * 2;
constexpr size_t W_PART9 = W_Z + (size_t)M * 2048 * 4;
constexpr size_t W_RC = W_Z + (size_t)M * ZLD * 2;
constexpr size_t W_XW = W_RC;
constexpr size_t W_XA = W_XW + SZ_M1024_BF;
constexpr size_t W_GG = W_XA + SZ_M1024_BF;
constexpr size_t W_DYA = W_GG + SZ_M1024_BF;
constexpr size_t W_YB = W_DYA + SZ_M1024_BF;
constexpr size_t W_A2 = W_YB + SZ_M1024_BF;
constexpr size_t W_MM = W_XW;
constexpr size_t W_ACT = W_RC;
constexpr size_t W_BAR = W_A2 + (size_t)M * 768 * 2;
constexpr size_t W_SF = W_BAR + 16384;
constexpr size_t W_END = W_SF + (size_t)2048 * 8192;

struct Params { const float* in[31]; float* out; unsigned char* ws; };
typedef const __attribute__((address_space(4))) Params* KArgP;
__device__ __forceinline__ KArgP kargs() { KArgP q = (KArgP)__builtin_amdgcn_kernarg_segment_ptr(); asm volatile("" : "+s"(q)); return q; }

__device__ __forceinline__ float bf2f(bf16_t b) { return __uint_as_float(((unsigned)b) << 16); }
__device__ __forceinline__ bf16_t f2bf(float f) { unsigned u = __float_as_uint(f); u += 0x7FFFu + ((u >> 16) & 1u); return (bf16_t)(u >> 16); }
typedef __bf16 bf16n2 __attribute__((ext_vector_type(2)));
__device__ __forceinline__ unsigned cvt_pk_bf16(float lo, float hi) { const f32x2 v = {lo, hi}; const bf16n2 r = __builtin_convertvector(v, bf16n2); unsigned u; __builtin_memcpy(&u, &r, 4); return u; }
__device__ __forceinline__ float lo_bf(unsigned w) { return __uint_as_float(w << 16); }
__device__ __forceinline__ float hi_bf(unsigned w) { return __uint_as_float(w & 0xffff0000u); }
__device__ __forceinline__ float sigmoidf_(float x) { return __builtin_amdgcn_rcpf(1.0f + __expf(-x)); }
#define DPP_ADD(v, ctrl) ((v) + __uint_as_float(__builtin_amdgcn_update_dpp(0u, __float_as_uint(v), (ctrl), 0xF, 0xF, true)))
__device__ __forceinline__ float xor16_sum(float v) { const auto r = __builtin_amdgcn_permlane16_swap(__float_as_uint(v), __float_as_uint(v), false, false); return __uint_as_float(r[0]) + __uint_as_float(r[1]); }
__device__ __forceinline__ float xor32_sum(float v) { const auto r = __builtin_amdgcn_permlane32_swap(__float_as_uint(v), __float_as_uint(v), false, false); return __uint_as_float(r[0]) + __uint_as_float(r[1]); }
__device__ __forceinline__ float wave_sum(float v) {
    v = DPP_ADD(v, 0xB1);
    v = DPP_ADD(v, 0x4E);
    v = DPP_ADD(v, 0x141);
    v = DPP_ADD(v, 0x140);
    v = xor16_sum(v);
    return xor32_sum(v);
}
__device__ __forceinline__ const float* xrow(KArgP p, int r) { return r < MP ? p->in[0] + (size_t)r * DM : p->in[1] + (size_t)(r - MP) * DM; }
__device__ __forceinline__ float gelu_tanh(float x) {
    const float u = 0.7978845608f * (x + 0.044715f * x * x * x);
    return x * __builtin_amdgcn_rcpf(1.0f + __expf(-2.0f * u));
}


#define XB_TMO      128
#define XB_XCNT(j)  (256  + 64 * (j))
#define XB_XSUB(j)  (1280 + 64 * (j))
#define XB_XGEN(j)  (2304 + 64 * (j))
#define XB_TOP      3328
#define XB_TOPGEN   3392
#define XCD_BAR_WORDS 3456
#define XB_SPIN_CAP (1u << 18)
__device__ __forceinline__ unsigned xb_ld(unsigned* p)              { return __hip_atomic_load(p, __ATOMIC_RELAXED, __HIP_MEMORY_SCOPE_AGENT); }
__device__ __forceinline__ unsigned xb_add(unsigned* p, unsigned v) { return __hip_atomic_fetch_add(p, v, __ATOMIC_RELAXED, __HIP_MEMORY_SCOPE_AGENT); }
__device__ __forceinline__ unsigned xb_xcc_id() { return (unsigned)__builtin_amdgcn_s_getreg((3 << 11) | 20) & 0xFu; }
#define XB_SPIN(cond, bar) do { unsigned _sp = 0; while (cond) { __builtin_amdgcn_s_sleep(1); \
    if ((++_sp & 255u) == 0u) { if (xb_ld(&(bar)[XB_TMO])) break; if (_sp > XB_SPIN_CAP) { atomicAdd(&(bar)[XB_TMO], 1u); break; } } } } while (0)
struct XcdBarrier { unsigned* bar; unsigned x; volatile LAS unsigned* st; };
__device__ __forceinline__ XcdBarrier xcd_barrier_post(unsigned* bar, volatile LAS unsigned* st) {
    XcdBarrier b; b.bar = bar; b.x = xb_xcc_id(); b.st = st;
    if (threadIdx.x == 0) (void)xb_add(&bar[XB_XCNT(b.x)], 1u);
    return b;
}
__device__ __forceinline__ void xcd_barrier_complete(unsigned* bar, unsigned x, unsigned& nloc, unsigned& nx) {
    const unsigned G = gridDim.x * gridDim.y * gridDim.z;
    unsigned sum, cnt, mine, sp = 0u;
    for (;;) {
        sum = 0u; cnt = 0u; mine = 0u;
#pragma unroll
        for (unsigned j = 0; j < 16; ++j) { const unsigned c = xb_ld(&bar[XB_XCNT(j)]); sum += c; cnt += (c > 0u) ? 1u : 0u; mine = (j == x) ? c : mine; }
        if (sum == G) break;
        __builtin_amdgcn_s_sleep(1);
        if ((++sp & 255u) == 0u) { if (xb_ld(&bar[XB_TMO])) break; if (sp > XB_SPIN_CAP) { atomicAdd(&bar[XB_TMO], 1u); break; } }
    }
    nloc = mine > 0u ? mine : 1u; nx = cnt > 0u ? cnt : 1u;
}
__device__ __forceinline__ void xcd_barrier(const XcdBarrier& b) {
    asm volatile("s_waitcnt vmcnt(0)" ::: "memory");
    __syncthreads();
    if (threadIdx.x == 0) {
        unsigned* bar = b.bar;
        __builtin_amdgcn_s_waitcnt(0);
        unsigned nloc = b.st[0], nx = b.st[1];
        if (nloc == 0u) { xcd_barrier_complete(bar, b.x, nloc, nx); b.st[0] = nloc; b.st[1] = nx; }
        const unsigned old = xb_add(&bar[XB_XSUB(b.x)], 1u);
        const unsigned gen = old / nloc;
        if (old + 1u == (gen + 1u) * nloc) {
            __builtin_amdgcn_fence(__ATOMIC_RELEASE, "agent");
            asm volatile("s_waitcnt vmcnt(0)" ::: "memory");
            const unsigned og = xb_add(&bar[XB_TOP], 1u);
            const unsigned tg = og / nx;
            if (og + 1u == (tg + 1u) * nx) xb_add(&bar[XB_TOPGEN], 1u);
            else XB_SPIN(xb_ld(&bar[XB_TOPGEN]) == tg, bar);
            __builtin_amdgcn_fence(__ATOMIC_ACQUIRE, "agent");
            xb_add(&bar[XB_XGEN(b.x)], 1u);
            asm volatile("s_waitcnt vmcnt(0)" ::: "memory");
        } else {
            XB_SPIN(xb_ld(&bar[XB_XGEN(b.x)]) == gen, bar);
            __builtin_amdgcn_fence(__ATOMIC_ACQUIRE, "agent");
            asm volatile("s_waitcnt vmcnt(0)" ::: "memory");
        }
    }
    __syncthreads();
}

namespace pg8 {
constexpr int BM = 256, BK = 64, HALF = 128, HTB = HALF * BK * 2, NXCD = 8, WGM = 8;
__device__ __forceinline__ int lds_byte(int r, int c) { const int st = (r >> 4) * 2 + (c >> 5), rr = r & 15, cc = c & 31, ob = rr * 64 + cc * 2; return st * 1024 + (ob ^ (((ob >> 9) & 1) << 5)); }
__device__ __forceinline__ void stage_rc(int b, int& R, int& C) { const int st = b / 1024, sb = b % 1024, swz = sb ^ (((sb >> 9) & 1) << 5); R = (st >> 1) * 16 + swz / 64; C = (st & 1) * 32 + (swz % 64) / 2; }
__device__ __forceinline__ int perm32(int rho) { const int n = rho >> 4, i = rho & 15; return 8 * (i >> 2) + 4 * n + (i & 3); }

struct Unit { int pm, pn, k0, nt, sp; };
struct Gemm { const bf16_t* A; const bf16_t* Bt; int M, N, K, lda, ldb, agshift, agcols; };

struct StaticOrder {
    int nM, nN, nwg, G, c;
    int ntk;
    __device__ __forceinline__ void init(int M_, int N_, int G_, int c_, int K_) { nM = M_ / BM; nN = N_ / BM; nwg = nM * nN; G = G_; c = c_; ntk = K_ / BK; }
    __device__ __forceinline__ Unit get(int i) const {
        Unit u; u.pm = 0; u.pn = 0; u.k0 = 0; u.nt = 0; u.sp = -1;
        const long L = (long)i * G + c; if (L >= nwg) return u;
        int wgid = (int)L; { const int q = nwg / NXCD, r = nwg % NXCD, xcd = wgid % NXCD, off = wgid / NXCD; wgid = (xcd < r ? xcd * (q + 1) : r * (q + 1) + (xcd - r) * q) + off; }
        const int nig = WGM * nN, gid = wgid / nig, fm = gid * WGM, gsz = (nM - fm) < WGM ? (nM - fm) : WGM;
        u.pm = fm + ((wgid % nig) % gsz); u.pn = (wgid % nig) / gsz; u.nt = ntk; return u;
    }
};
struct SampleOrder {
    StaticOrder base;
    __device__ __forceinline__ Unit get(int i) const {
        int cnt = 0; Unit e; e.pm = 0; e.pn = 0; e.k0 = 0; e.nt = 0; e.sp = -1;
#pragma unroll
        for (int k = 0; k < 3; ++k) { const Unit u = base.get(k); if (u.nt != 0 && u.pm >= 32) { if (cnt == i) return u; ++cnt; } }
        return e;
    }
};
struct MixOrder {
    StaticOrder base; int G, c; bool sample_only;
    __device__ __forceinline__ Unit get(int i) const {
        Unit u; u.pm = 0; u.pn = 0; u.k0 = 0; u.nt = 0; u.sp = -1;
        const int np = G - 16;
        if (c < np) { if (sample_only) return u; StaticOrder b = base; b.G = 1 << 20; b.c = c + i * np; return (i < 64 && c + i * np < 256) ? b.get(0) : u; }
        const int t = c - np; if (i == 0 && t < 16) { u.pm = 32 + (t >> 3); u.pn = t & 7; u.nt = base.ntk; }
        return u;
    }
};
struct LowRankOrder {
    int part, G, c, ntk;
    __device__ __forceinline__ Unit get(int i) const {
        Unit u; u.pm = 0; u.pn = 0; u.k0 = 0; u.nt = 0; u.sp = -1;
        if (c < 0) return u;
        const int L = i * G + c;
        if (part == 0) { if (L < 272) { u.pm = L % 34; u.pn = L / 34; u.nt = ntk; } else if (L < 280) { u.pm = 32 + (L - 272) / 4; u.pn = 8 + (L - 272) % 4; u.nt = ntk; } }
        else if (L < 128) { u.pm = L / 4; u.pn = 8 + (L % 4); u.nt = ntk; }
        return u;
    }
};
struct SplitOrder {
    StaticOrder base; int S, nbase;
    __device__ __forceinline__ void init(int G_, int c_, int K_, int S_) { base.init(8192, 2048, G_, c_, K_); S = S_; nbase = (c_ < 256) ? (256 - c_ + G_ - 1) / G_ : 0; }
    __device__ __forceinline__ Unit get(int i) const {
        if (i < nbase) return base.get(i);
        Unit u; u.pm = 0; u.pn = 0; u.k0 = 0; u.nt = 0; u.sp = -1;
        if (i == nbase && base.c < 16 * S) { const int uu = base.c / S, sp = base.c % S; u.pm = 32 + (uu >> 3); u.pn = uu & 7; u.nt = base.ntk / S; u.k0 = sp * u.nt; u.sp = sp; }
        return u;
    }
};

template <class Epi, class Sched>
__device__ __forceinline__ void gemm_phase(LAS unsigned char* lds, const Gemm g, const Sched& S, const Epi& E) {
    int tid = threadIdx.x; asm volatile("" : "+v"(tid));
    const int wid = __builtin_amdgcn_readfirstlane(tid >> 6), lane = tid & 63, wr = wid >> 2, wc = wid & 3, fr = lane & 15, fq = lane >> 4;
    unsigned voffA[2], voffB[2];
#pragma unroll
    for (int i = 0; i < 2; ++i) { int R, C; stage_rc(tid * 16 + i * 8192, R, C); const int Rb = Epi::PERM ? ((R & ~31) + perm32(R & 31)) : R;
        voffA[i] = (unsigned)(R * g.lda + C) * 2u; voffB[i] = (unsigned)(Rb * g.ldb + C) * 2u; }
    const size_t kstep = (size_t)(BK * 2);
    const size_t hstepA = (size_t)HALF * g.lda * 2, hstepB = (size_t)HALF * g.ldb * 2;
    const size_t tstepA = 2 * hstepA, tstepB = 2 * hstepB;
    const unsigned ldsw = (unsigned)wid * 1024u;
    const int aoff = lds_byte(wr * 64 + fr, fq * 8), boff = lds_byte(wc * 32 + fr, fq * 8);
#define PG8_SA(b, h) (((b) * 2 + (h)) * HTB)
#define PG8_SB(b, h) ((4 + (b) * 2 + (h)) * HTB)
#define PG8_STAGE(bufoff, gbase, voff) do { _Pragma("unroll") for (int _i = 0; _i < 2; ++_i) \
        __builtin_amdgcn_global_load_lds((const unsigned*)((const char*)(gbase) + (voff)[_i]), (LAS unsigned*)(lds + (bufoff) + ldsw + _i * 8192), 16, 0, 0); } while (0)
#define PG8_LDA(dst, b, h) do { _Pragma("unroll") for (int m = 0; m < 4; ++m) _Pragma("unroll") for (int k = 0; k < 2; ++k) dst[m][k] = *(const LAS bf16x8*)(lds + PG8_SA(b, h) + aoff + m * 2048 + k * 1024); } while (0)
#define PG8_LDB(dst, b, h) do { _Pragma("unroll") for (int n = 0; n < 2; ++n) _Pragma("unroll") for (int k = 0; k < 2; ++k) dst[n][k] = *(const LAS bf16x8*)(lds + PG8_SB(b, h) + boff + n * 2048 + k * 1024); } while (0)
#define PG8_MMA(ai, bj, At, Bt) do { __builtin_amdgcn_s_setprio(1); _Pragma("unroll") for (int m = 0; m < 4; ++m) _Pragma("unroll") for (int n = 0; n < 2; ++n) _Pragma("unroll") for (int k = 0; k < 2; ++k) \
        acc[ai][bj][m][n] = __builtin_amdgcn_mfma_f32_16x16x32_bf16(Bt[n][k], At[m][k], acc[ai][bj][m][n], 0, 0, 0); __builtin_amdgcn_s_setprio(0); } while (0)
#define PG8_WAIT_V(n) asm volatile("s_waitcnt vmcnt(" #n ")" ::: "memory")
#define PG8_WAIT_L(n) asm volatile("s_waitcnt lgkmcnt(" #n ")" ::: "memory")
#define PG8_BAR __builtin_amdgcn_s_barrier()
#define PG8_SCHED __builtin_amdgcn_sched_barrier(0)
    Unit cur = S.get(0), nxt; int ui = 0;
    if (cur.nt == 0) return;
    f32x4 acc[2][2][4][2];
#pragma unroll
    for (int a = 0; a < 2; ++a)
#pragma unroll
        for (int b = 0; b < 2; ++b)
#pragma unroll
            for (int m = 0; m < 4; ++m)
#pragma unroll
                for (int n = 0; n < 2; ++n) acc[a][b][m][n] = (f32x4){0.f, 0.f, 0.f, 0.f};
    bf16x8 At[4][2], B0[2][2], B1[2][2];
    const char* cA = (const char*)g.A + (size_t)cur.pm * tstepA + (size_t)((cur.pn >> g.agshift) * g.agcols) * 2 + (size_t)cur.k0 * kstep; const char* cB = (const char*)g.Bt + (size_t)cur.pn * tstepB + (size_t)cur.k0 * kstep;
    PG8_STAGE(PG8_SB(0, 0), cB, voffB); PG8_STAGE(PG8_SA(0, 0), cA, voffA); PG8_STAGE(PG8_SB(0, 1), cB + hstepB, voffB); PG8_STAGE(PG8_SA(0, 1), cA + hstepA, voffA);
    if (wr == 1) PG8_BAR;
    PG8_WAIT_V(4); PG8_BAR;
    PG8_STAGE(PG8_SB(1, 0), cB + kstep, voffB); PG8_STAGE(PG8_SA(1, 0), cA + kstep, voffA); PG8_STAGE(PG8_SB(1, 1), cB + hstepB + kstep, voffB);
    PG8_WAIT_V(6); PG8_BAR;
    for (;;) {
        nxt = S.get(ui + 1); const bool has_next = nxt.nt != 0;
        const char* nA = has_next ? (const char*)g.A + (size_t)nxt.pm * tstepA + (size_t)((nxt.pn >> g.agshift) * g.agcols) * 2 + (size_t)nxt.k0 * kstep : cA; const char* nB = has_next ? (const char*)g.Bt + (size_t)nxt.pn * tstepB + (size_t)nxt.k0 * kstep : cB;
        const int nt = cur.nt;
        for (int t = 0; t < nt; t += 2) {
            const bool last = (t == nt - 2);
            const char* a1 = cA + (size_t)(t + 1) * kstep;
            const char* a2 = last ? nA : cA + (size_t)(t + 2) * kstep; const char* b2 = last ? nB : cB + (size_t)(t + 2) * kstep;
            const char* a3 = a2 + kstep; const char* b3 = b2 + kstep;
            PG8_LDB(B0, 0, 0); PG8_SCHED; PG8_LDA(At, 0, 0); PG8_STAGE(PG8_SA(1, 1), a1 + hstepA, voffA);
            PG8_WAIT_L(8); PG8_BAR; PG8_WAIT_L(0); PG8_MMA(0, 0, At, B0); PG8_BAR; PG8_SCHED;
            PG8_LDB(B1, 0, 1); PG8_STAGE(PG8_SB(0, 0), b2, voffB);
            PG8_BAR; PG8_WAIT_L(0); PG8_MMA(0, 1, At, B1); PG8_BAR;
            PG8_LDA(At, 0, 1); PG8_STAGE(PG8_SA(0, 0), a2, voffA);
            PG8_BAR; PG8_WAIT_L(0); PG8_MMA(1, 0, At, B0); PG8_BAR; PG8_SCHED;
            PG8_STAGE(PG8_SB(0, 1), b2 + hstepB, voffB);
            PG8_WAIT_V(6); PG8_BAR; PG8_MMA(1, 1, At, B1); PG8_BAR;
            PG8_LDB(B0, 1, 0); PG8_SCHED; PG8_LDA(At, 1, 0); PG8_STAGE(PG8_SA(0, 1), a2 + hstepA, voffA);
            PG8_WAIT_L(8); PG8_BAR; PG8_WAIT_L(0); PG8_MMA(0, 0, At, B0); PG8_BAR; PG8_SCHED;
            PG8_LDB(B1, 1, 1); PG8_STAGE(PG8_SB(1, 0), b3, voffB);
            PG8_BAR; PG8_WAIT_L(0); PG8_MMA(0, 1, At, B1); PG8_BAR;
            PG8_LDA(At, 1, 1); PG8_STAGE(PG8_SA(1, 0), a3, voffA);
            PG8_BAR; PG8_WAIT_L(0); PG8_MMA(1, 0, At, B0); PG8_BAR; PG8_SCHED;
            PG8_STAGE(PG8_SB(1, 1), b3 + hstepB, voffB);
            PG8_WAIT_V(6); PG8_BAR; PG8_MMA(1, 1, At, B1); PG8_BAR;
        }
        E(acc, cur, wr, wc, fr, fq);
        if (!has_next) break;
#pragma unroll
        for (int a = 0; a < 2; ++a)
#pragma unroll
            for (int b = 0; b < 2; ++b)
#pragma unroll
                for (int m = 0; m < 4; ++m)
#pragma unroll
                    for (int n = 0; n < 2; ++n) acc[a][b][m][n] = (f32x4){0.f, 0.f, 0.f, 0.f};
        cur = nxt; cA = nA; cB = nB; ++ui;
    }
    PG8_WAIT_V(0);
    if (wr == 0) PG8_BAR;
    PG8_BAR;
#undef PG8_SA
#undef PG8_SB
#undef PG8_STAGE
#undef PG8_LDA
#undef PG8_LDB
#undef PG8_MMA
#undef PG8_WAIT_V
#undef PG8_WAIT_L
#undef PG8_BAR
#undef PG8_SCHED
}
}
using pg8::Unit;
typedef const f32x4 (&AccRef)[2][2][4][2];

__device__ __forceinline__ u32x4 pack8(f32x4 v0, f32x4 v1) { u32x4 w; w.x = cvt_pk_bf16(v0[0], v0[1]); w.y = cvt_pk_bf16(v0[2], v0[3]); w.z = cvt_pk_bf16(v1[0], v1[1]); w.w = cvt_pk_bf16(v1[2], v1[3]); return w; }
__device__ __forceinline__ void unpack8(u32x4 w, f32x4& a, f32x4& b) { a = (f32x4){lo_bf(w.x), hi_bf(w.x), lo_bf(w.y), hi_bf(w.y)}; b = (f32x4){lo_bf(w.z), hi_bf(w.z), lo_bf(w.w), hi_bf(w.w)}; }

struct EpiZ {
    static constexpr bool PERM = true;
    bf16_t* Z; float* out;
    __device__ __forceinline__ void operator()(AccRef acc, const Unit& u, int wr, int wc, int fr, int fq) const {
        const int row0 = u.pm * 256 + wr * 64 + fr, col0 = u.pn * 256 + wc * 32 + 8 * fq;
#pragma unroll
        for (int ai = 0; ai < 2; ++ai)
#pragma unroll
            for (int m = 0; m < 4; ++m) { bf16_t* rowp = Z + (size_t)(row0 + ai * 128 + m * 16) * ZLD + col0;
#pragma unroll
                for (int bj = 0; bj < 2; ++bj) *(u32x4*)(rowp + bj * 128) = pack8(acc[ai][bj][m][0], acc[ai][bj][m][1]); }
        const bool special = (u.pm >= 32) || ((u.pm & 7) == 7);
        if (special && u.pn < 18) {
#pragma unroll
            for (int ai = 0; ai < 2; ++ai)
#pragma unroll
                for (int m = 0; m < 4; ++m) {
                    const int r = row0 + ai * 128 + m * 16; const bool smp = r >= MP; const int b = smp ? (r - MP) >> 2 : r >> 11, t = smp ? (r - MP) & 3 : r & 2047;
#pragma unroll
                    for (int bj = 0; bj < 2; ++bj) { const int c = col0 + bj * 128; float* dst = nullptr;
                        if (c < DSH) { if (smp ? (t == 3) : (t == 2047)) dst = out + (smp ? O_SSHIFT : O_PSHIFT) + (size_t)b * DSH + c; }
                        else if (c >= ZC_P && c < ZC_P + 1024) { const int cc = c - ZC_P;
                            if (smp) dst = out + O_SPOOL + ((size_t)b * 15 + 11 + t) * 1024 + cc;
                            else if (t >= 2033) dst = out + O_PPOOL + ((size_t)b * 15 + (t - 2033)) * 1024 + cc; }
                        if (dst) { *(f32x4*)dst = acc[ai][bj][m][0]; *(f32x4*)(dst + 4) = acc[ai][bj][m][1]; } } }
        }
    }
};
struct EpiLR {
    static constexpr bool PERM = true;
    bf16_t* XW; const float* w0; const float* a0;
    __device__ __forceinline__ void operator()(AccRef acc, const Unit& u, int wr, int wc, int fr, int fq) const {
        const int sel = u.pn >> 2; const int row0 = u.pm * 256 + wr * 64 + fr, col0 = (u.pn & 3) * 256 + wc * 32 + 8 * fq;
        bf16_t* base = XW + (size_t)sel * ((size_t)M * 1024);
#pragma unroll
        for (int bj = 0; bj < 2; ++bj) { const int c = col0 + bj * 128; f32x4 b0 = (f32x4){0.f, 0.f, 0.f, 0.f}, b1 = b0;
            if (sel == 0) { b0 = *(const f32x4*)(w0 + c); b1 = *(const f32x4*)(w0 + c + 4); } else if (sel == 1) { b0 = *(const f32x4*)(a0 + c); b1 = *(const f32x4*)(a0 + c + 4); }
#pragma unroll
            for (int ai = 0; ai < 2; ++ai)
#pragma unroll
                for (int m = 0; m < 4; ++m) { f32x4 v0 = acc[ai][bj][m][0] + b0, v1 = acc[ai][bj][m][1] + b1;
                    if (sel == 1) {
#pragma unroll
                        for (int j = 0; j < 4; ++j) { v0[j] = sigmoidf_(v0[j]); v1[j] = sigmoidf_(v1[j]); } }
                    *(u32x4*)(base + (size_t)(row0 + ai * 128 + m * 16) * 1024 + c) = pack8(v0, v1); } }
    }
};
struct EpiPool {
    static constexpr bool PERM = true;
    bf16_t* YB; const float* scale;
    __device__ __forceinline__ void operator()(AccRef acc, const Unit& u, int wr, int wc, int fr, int fq) const {
        const int row0 = u.pm * 256 + wr * 64 + fr, col0 = u.pn * 256 + wc * 32 + 8 * fq;
#pragma unroll
        for (int bj = 0; bj < 2; ++bj) { const int c = col0 + bj * 128; const f32x4 s0 = *(const f32x4*)(scale + c), s1 = *(const f32x4*)(scale + c + 4);
#pragma unroll
            for (int ai = 0; ai < 2; ++ai)
#pragma unroll
                for (int m = 0; m < 4; ++m) *(u32x4*)(YB + (size_t)(row0 + ai * 128 + m * 16) * 1024 + c) = pack8(acc[ai][bj][m][0] * s0, acc[ai][bj][m][1] * s1); }
    }
};
struct EpiGateB {
    static constexpr bool PERM = true;
    bf16_t* MM; const bf16_t* Z;
    __device__ __forceinline__ void operator()(AccRef acc, const Unit& u, int wr, int wc, int fr, int fq) const {
        const int row0 = u.pm * 256 + wr * 64 + fr, col0 = u.pn * 256 + wc * 32 + 8 * fq;
#pragma unroll
        for (int ai = 0; ai < 2; ++ai)
#pragma unroll
            for (int bj = 0; bj < 2; ++bj) { const int c = col0 + bj * 128;
                u32x4 gz[4];
#pragma unroll
                for (int m = 0; m < 4; ++m) gz[m] = *(const u32x4*)((const char*)Z + ((unsigned)(row0 + ai * 128 + m * 16) * (unsigned)ZLD + (unsigned)(ZC_GB + c)) * 2u);
#pragma unroll
                for (int m = 0; m < 4; ++m) { const int r = row0 + ai * 128 + m * 16; f32x4 g0, g1; unpack8(gz[m], g0, g1);
#pragma unroll
                    for (int j = 0; j < 4; ++j) { g0[j] = sigmoidf_(g0[j]); g1[j] = sigmoidf_(g1[j]); }
                    *(u32x4*)(MM + (size_t)r * DM + c) = pack8(g0 * acc[ai][bj][m][0], g1 * acc[ai][bj][m][1]); } }
    }
};
struct EpiGateA {
    static constexpr bool PERM = true;
    const bf16_t* Z; bf16_t* MM;
    __device__ __forceinline__ void operator()(AccRef acc, const Unit& u, int wr, int wc, int fr, int fq) const {
        const int row0 = u.pm * 256 + wr * 64 + fr, col0 = u.pn * 256 + wc * 32 + 8 * fq;
#pragma unroll
        for (int ai = 0; ai < 2; ++ai)
#pragma unroll
            for (int bj = 0; bj < 2; ++bj) { const int c = col0 + bj * 128;
                u32x4 gz[4], pm[4];
#pragma unroll
                for (int m = 0; m < 4; ++m) { const unsigned r = (unsigned)(row0 + ai * 128 + m * 16);
                    gz[m] = *(const u32x4*)((const char*)Z + (r * (unsigned)ZLD + (unsigned)(ZC_GA + c)) * 2u);
                    pm[m] = *(const u32x4*)((const char*)MM + (r * (unsigned)DM + (unsigned)c) * 2u); }
#pragma unroll
                for (int m = 0; m < 4; ++m) { const int r = row0 + ai * 128 + m * 16; f32x4 g0, g1, p0, p1; unpack8(gz[m], g0, g1); unpack8(pm[m], p0, p1);
#pragma unroll
                    for (int j = 0; j < 4; ++j) { g0[j] = sigmoidf_(g0[j]); g1[j] = sigmoidf_(g1[j]); }
                    *(u32x4*)(MM + (size_t)r * DM + c) = pack8(p0 + g0 * acc[ai][bj][m][0], p1 + g1 * acc[ai][bj][m][1]); } }
    }
};
struct EpiOutP {
    static constexpr bool PERM = true;
    bf16_t* C; float* P;
    __device__ __forceinline__ void operator()(AccRef acc, const Unit& u, int wr, int wc, int fr, int fq) const {
        const int row0 = u.pm * 256 + wr * 64 + fr, col0 = u.pn * 256 + wc * 32 + 8 * fq;
#pragma unroll
        for (int ai = 0; ai < 2; ++ai)
#pragma unroll
            for (int m = 0; m < 4; ++m) { const int r = row0 + ai * 128 + m * 16;
#pragma unroll
                for (int bj = 0; bj < 2; ++bj) { const int c = col0 + bj * 128;
                    if (u.sp < 0) *(u32x4*)(C + (size_t)r * DM + c) = pack8(acc[ai][bj][m][0], acc[ai][bj][m][1]);
                    else { float* pp = P + ((size_t)u.sp * 512 + (r - MP)) * DM + c; *(f32x4*)pp = acc[ai][bj][m][0]; *(f32x4*)(pp + 4) = acc[ai][bj][m][1]; } } }
    }
};
struct EpiGate7 {
    static constexpr bool PERM = true;
    bf16_t* G; float* out;
    __device__ __forceinline__ void operator()(AccRef acc, const Unit& u, int wr, int wc, int fr, int fq) const {
        const int row0 = u.pm * 256 + wr * 64 + fr, col0 = u.pn * 256 + wc * 32 + 8 * fq;
#pragma unroll
        for (int ai = 0; ai < 2; ++ai)
#pragma unroll
            for (int m = 0; m < 4; ++m) { bf16_t* rowp = G + (size_t)(row0 + ai * 128 + m * 16) * DFF + col0;
#pragma unroll
                for (int bj = 0; bj < 2; ++bj) *(u32x4*)(rowp + bj * 128) = pack8(acc[ai][bj][m][0], acc[ai][bj][m][1]); }
        const bool special = (u.pm >= 32) || ((u.pm & 7) == 7);
        if (special) {
#pragma unroll
            for (int ai = 0; ai < 2; ++ai)
#pragma unroll
                for (int m = 0; m < 4; ++m) {
                    const int r = row0 + ai * 128 + m * 16; const bool smp = r >= MP; const int b = smp ? (r - MP) >> 2 : r >> 11, t = smp ? (r - MP) & 3 : r & 2047;
                    const int j = smp ? t - 2 : t - 2046;
                    if (j >= 0) {
#pragma unroll
                        for (int bj = 0; bj < 2; ++bj) { float* dst = out + (smp ? O_SCONV : O_PCONV) + ((size_t)b * 2 + j) * DFF + col0 + bj * 128;
                            *(f32x4*)dst = acc[ai][bj][m][0]; *(f32x4*)(dst + 4) = acc[ai][bj][m][1]; } } }
        }
    }
};
struct EpiAct {
    static constexpr bool PERM = true;
    const bf16_t* G; bf16_t* ACT; const float* cw; const float* cb; const float* conv0;
    __device__ __forceinline__ void operator()(AccRef acc, const Unit& u, int wr, int wc, int fr, int fq) const {
        const int row0 = u.pm * 256 + wr * 64 + fr, col0 = u.pn * 256 + wc * 32 + 8 * fq;
        const bool smp_tile = u.pm >= 32;
#pragma unroll
        for (int bj = 0; bj < 2; ++bj) { const int c = col0 + bj * 128;
            const f32x4 w0a = *(const f32x4*)(cw + c), w0b = *(const f32x4*)(cw + c + 4), w1a = *(const f32x4*)(cw + DFF + c), w1b = *(const f32x4*)(cw + DFF + c + 4);
            const f32x4 w2a = *(const f32x4*)(cw + 2 * DFF + c), w2b = *(const f32x4*)(cw + 2 * DFF + c + 4), cba = *(const f32x4*)(cb + c), cbb = *(const f32x4*)(cb + c + 4);
#pragma unroll
            for (int ai = 0; ai < 2; ++ai) {
                u32x4 q2[4], q1[4], q0[4];
#pragma unroll
                for (int m = 0; m < 4; ++m) { const unsigned off = (unsigned)((row0 + ai * 128 + m * 16) * DFF + c) * 2u;
                    q2[m] = *(const u32x4*)((const char*)G + off);
                    u32x4 e1 = (u32x4){0u, 0u, 0u, 0u}, e0 = e1;
                    if (fr < 1) e1 = *(const u32x4*)((const char*)(G - DFF) + off);
                    if (fr < 2) e0 = *(const u32x4*)((const char*)(G - 2 * DFF) + off);
                    q1[m] = e1; q0[m] = e0; }
#pragma unroll
                for (int m = 0; m < 4; ++m) {
#pragma unroll
                    for (int wd = 0; wd < 4; ++wd) { q1[m][wd] = __builtin_amdgcn_update_dpp(q1[m][wd], q2[m][wd], 0x111, 0xF, 0xF, false);
                                                     q0[m][wd] = __builtin_amdgcn_update_dpp(q0[m][wd], q2[m][wd], 0x112, 0xF, 0xF, false); } }
#pragma unroll
                for (int m = 0; m < 4; ++m) {
                    const int r = row0 + ai * 128 + m * 16; const bool smp = r >= MP; const int b = smp ? (r - MP) >> 2 : r >> 11, t = smp ? (r - MP) & 3 : r & 2047;
                    f32x4 x2a, x2b, x1a, x1b, x0a, x0b;
                    unpack8(q2[m], x2a, x2b); unpack8(q1[m], x1a, x1b); unpack8(q0[m], x0a, x0b);
                    if (t < 1) { x1a = (f32x4){0.f, 0.f, 0.f, 0.f}; x1b = x1a; }
                    if (t < 2) { x0a = (f32x4){0.f, 0.f, 0.f, 0.f}; x0b = x0a; }
                    if (smp_tile) {
                        if (t < 1) { x1a = *(const f32x4*)(conv0 + ((size_t)b * 2 + 1) * DFF + c); x1b = *(const f32x4*)(conv0 + ((size_t)b * 2 + 1) * DFF + c + 4); }
                        if (t < 2) { x0a = *(const f32x4*)(conv0 + ((size_t)b * 2 + t) * DFF + c); x0b = *(const f32x4*)(conv0 + ((size_t)b * 2 + t) * DFF + c + 4); }
                    }
                    f32x4 ca = cba + w0a * x0a + w1a * x1a + w2a * x2a, cbv = cbb + w0b * x0b + w1b * x1b + w2b * x2b;
#pragma unroll
                    for (int j = 0; j < 4; ++j) { ca[j] = gelu_tanh(ca[j]); cbv[j] = gelu_tanh(cbv[j]); }
                    *(u32x4*)(ACT + (size_t)r * DFF + c) = pack8(ca * acc[ai][bj][m][0], cbv * acc[ai][bj][m][1]); }
            }
        }
    }
};

constexpr int TP = 136;
#define LDS_ONLY_BARRIER() do { asm volatile("s_waitcnt lgkmcnt(0)" ::: "memory"); __builtin_amdgcn_s_barrier(); asm volatile("" ::: "memory"); } while (0)
template <class Map>
__device__ __forceinline__ void transpose_job(const float* src, int ldsrc, int Ksrc, bf16_t* dst, int Kd, int Nd, Map map, float* tilef, int bid, int nblk) {
    int tid = threadIdx.x; asm volatile("" : "+v"(tid));
    LAS unsigned char* tile = (LAS unsigned char*)tilef;
    const int ntk = Kd / 128, ntn = Nd / 128, ntot = ntk * ntn;
    const int n4 = tid & 31, kp0 = tid >> 5;
    const int rn = tid >> 2, rq = tid & 3;
    f32x4 va[4], vb[4];
    auto load = [&](int ti) {
        const int tn = ti / ntk, tk = ti - tn * ntk; const int sc = map(tn * 128 + n4 * 4);
#pragma unroll
        for (int i = 0; i < 4; ++i) { const int k = tk * 128 + 2 * (kp0 + 16 * i);
            va[i] = (sc >= 0 && k < Ksrc) ? *(const f32x4*)(src + (size_t)k * ldsrc + sc) : (f32x4){0.f, 0.f, 0.f, 0.f};
            vb[i] = (sc >= 0 && k + 1 < Ksrc) ? *(const f32x4*)(src + (size_t)(k + 1) * ldsrc + sc) : (f32x4){0.f, 0.f, 0.f, 0.f}; }
    };
    int ti = bid;
    if (ti < ntot) load(ti);
    for (; ti < ntot; ti += nblk) {
        const int tn = ti / ntk, tk = ti - tn * ntk;
#pragma unroll
        for (int i = 0; i < 4; ++i) { const int kp = kp0 + 16 * i;
#pragma unroll
            for (int j = 0; j < 4; ++j) *(LAS unsigned*)(tile + ((n4 * 4 + j) * TP + 2 * kp) * 2) = cvt_pk_bf16(va[i][j], vb[i][j]); }
        LDS_ONLY_BARRIER();
        if (ti + nblk < ntot) load(ti + nblk);
        bf16_t* drow = dst + (size_t)(tn * 128 + rn) * Kd + tk * 128 + rq * 32;
#pragma unroll
        for (int i = 0; i < 4; ++i) *(u32x4*)(drow + i * 8) = *(const LAS u32x4*)(tile + (rn * TP + rq * 32 + i * 8) * 2);
        LDS_ONLY_BARRIER();
    }
}
struct MapId { __device__ int operator()(int n) const { return n; } };
struct MapWin { __device__ int operator()(int n) const { return n < DSH ? n : (n < ZC_P ? -1 : n - (ZC_P - DSH)); } };

__device__ __forceinline__ float z_shift(KArgP p, const bf16_t* Z, int r, int zc) {
    const float z = bf2f(Z[(size_t)r * ZLD + zc]);
    const bool smp = r >= MP; const int t = smp ? (r - MP) & 3 : r & 2047;
    float pv;
    if (t > 0) pv = bf2f(Z[(size_t)(r - 1) * ZLD + zc]); else pv = smp ? p->in[2][(size_t)((r - MP) >> 2) * DSH + zc] : 0.f;
    return z + (pv - z) * p->in[8][zc];
}

struct HeadConst { float mu_r, mu_k, mu_v, k_k, k_a, r_k; };
__device__ __forceinline__ void stage_token(float zr, float zk, float zv, float pr, float pk, float pv, float xw, float a, float g, const HeadConst& hc, float* o, float* bon, int lane) {
    const float r = zr + (pr - zr) * hc.mu_r, k = zk + (pk - zk) * hc.mu_k, v = zv + (pv - zv) * hc.mu_v;
    const float y = -xw;
    const float sp = fmaxf(y, 0.f) + __logf(1.0f + __expf(-fabsf(y)));
    const float dec = __expf(-__expf(-sp - 0.5f));
    const float kr = k * hc.k_k; const float n2 = wave_sum(kr * kr); const float kk = kr * rsqrtf(fmaxf(n2, 1e-24f));
    const float kp = k * (1.0f + (a - 1.0f) * hc.k_a);
    const float bs = wave_sum(r * kp * hc.r_k);
    o[0 * 64 + lane] = dec; o[1 * 64 + lane] = kk; o[2 * 64 + lane] = kk * a; o[3 * 64 + lane] = kp; o[4 * 64 + lane] = r; o[5 * 64 + lane] = v; o[6 * 64 + lane] = g;
    if (lane == 0) *bon = bs;
}

constexpr int ST = 72;
constexpr int L_AT = 0, L_BT = 9216, L_KT = 18432, L_RT = 27648, L_ATT = 36864, L_VMT = 46080, L_BGT = 55296, L_KGT = 64512,
              L_LOFF = 73728, L_LAK = 82944, L_MRB = 92160, L_MRK = 101376, L_LDIAG = 110592, L_CUM = 114688;
constexpr int L_TBD = L_CUM, L_SOLT = L_BT;
constexpr size_t SC_PF = 0, SC_QF = (size_t)2048 * 8192, SC_W2F = (size_t)2 * 2048 * 8192, SC_YLF = (size_t)3 * 2048 * 8192, SC_GAM = (size_t)4 * 2048 * 8192, SC_BON = SC_GAM + (size_t)2048 * 256;

__device__ __forceinline__ bf16x8 frag(LAS unsigned char* lds, int off, int row0, int ks, int lane) {
    return *(const LAS bf16x8*)(lds + off + ((row0 + (lane & 15)) * ST + ks * 32 + (lane >> 4) * 8) * 2);
}
__device__ __forceinline__ void st4(LAS unsigned char* lds, int off, int row, int col, f32x4 v) {
    u32x2 w; w.x = cvt_pk_bf16(v[0], v[1]); w.y = cvt_pk_bf16(v[2], v[3]); *(LAS u32x2*)(lds + off + (row * ST + col) * 2) = w;
}
__device__ __forceinline__ f32x4 ld4(LAS unsigned char* lds, int off, int row, int col) {
    const u32x2 w = *(const LAS u32x2*)(lds + off + (row * ST + col) * 2); return (f32x4){lo_bf(w.x), hi_bf(w.x), lo_bf(w.y), hi_bf(w.y)};
}
#define MFMA16(x, y, acc) __builtin_amdgcn_mfma_f32_16x16x32_bf16((x), (y), (acc), 0, 0, 0)
#define LDS_FENCE() asm volatile("s_waitcnt lgkmcnt(0)" ::: "memory")

struct PARaw { bf16_t z[9][3], xw[8], xa[8]; };
__device__ __forceinline__ void pa_load(KArgP p, int cu, int w, int lane, PARaw& R) {
    const int bh = cu >> 5, c = cu & 31, b = bh >> 4, h = bh & 15, ch = h * 64 + lane;
    const bf16_t* Z = (const bf16_t*)(p->ws + W_Z); const bf16_t* XW = (const bf16_t*)(p->ws + W_XW); const bf16_t* XA = (const bf16_t*)(p->ws + W_XA);
    const int row0 = b * 2048 + c * 64 + w * 8; const bool first = (c == 0 && w == 0);
#pragma unroll
    for (int i = 0; i < 9; ++i)
#pragma unroll
        for (int qq = 0; qq < 3; ++qq) R.z[i][qq] = (i == 0 && first) ? (bf16_t)0 : Z[(size_t)(row0 - 1 + i) * ZLD + qq * 1024 + ch];
#pragma unroll
    for (int i = 0; i < 8; ++i) { R.xw[i] = XW[(size_t)(row0 + i) * 1024 + ch]; R.xa[i] = XA[(size_t)(row0 + i) * 1024 + ch]; }
}
#define PA_BAR() do { asm volatile("s_waitcnt lgkmcnt(0)" ::: "memory"); __builtin_amdgcn_s_barrier(); asm volatile("" ::: "memory"); } while (0)
__device__ __forceinline__ void wkv_pass_a(KArgP p, int cu, LAS unsigned char* lds, PARaw& R, int ncu) {
    int tid = threadIdx.x; asm volatile("" : "+v"(tid));
    const int w = __builtin_amdgcn_readfirstlane(tid >> 6), lane = tid & 63, q = lane >> 4, l15 = lane & 15;
    const int bh = cu >> 5, c = cu & 31, b = bh >> 4, h = bh & 15, ch = h * 64 + lane;
    const bf16_t* Z = (const bf16_t*)(p->ws + W_Z); const bf16_t* XW = (const bf16_t*)(p->ws + W_XW); const bf16_t* XA = (const bf16_t*)(p->ws + W_XA);
    unsigned char* sc = p->ws + W_RA;
    const int row0 = b * 2048 + c * 64 + w * 8;
    float kk[8], bb[8], kp[8], rr[8], vv[8], ld[8];
    {
        const float mu_r = p->in[8][ch], mu_k = p->in[8][1024 + ch], mu_v = p->in[8][2048 + ch], k_k = p->in[14][ch], k_a = p->in[15][ch], r_k = p->in[16][ch];
        float pz[3];
#pragma unroll
        for (int qq = 0; qq < 3; ++qq) pz[qq] = bf2f(R.z[0][qq]);
        float bon[8];
#pragma unroll
        for (int i = 0; i < 8; ++i) {
            float z[3];
#pragma unroll
            for (int qq = 0; qq < 3; ++qq) z[qq] = bf2f(R.z[i + 1][qq]);
            const float xw = bf2f(R.xw[i]), a = bf2f(R.xa[i]);
            const float r = z[0] + (pz[0] - z[0]) * mu_r, k = z[1] + (pz[1] - z[1]) * mu_k, v = z[2] + (pz[2] - z[2]) * mu_v;
#pragma unroll
            for (int qq = 0; qq < 3; ++qq) pz[qq] = z[qq];
            const float y = -xw; const float sp = fmaxf(y, 0.f) + __logf(1.0f + __expf(-fabsf(y)));
            ld[i] = -__expf(-sp - 0.5f);
            const float kr = k * k_k; const float n2 = wave_sum(kr * kr); kk[i] = kr * rsqrtf(fmaxf(n2, 1e-24f));
            kp[i] = k * (1.0f + (a - 1.0f) * k_a); bb[i] = kk[i] * a; rr[i] = r; vv[i] = v;
            bon[i] = wave_sum(r * kp[i] * r_k);
        }
        if (ncu >= 0) pa_load(p, ncu, w, lane, R);
        { float tot = 0.f;
#pragma unroll
          for (int i = 0; i < 8; ++i) tot += ld[i];
          *(LAS float*)(lds + L_CUM + (w * 64 + lane) * 4) = tot; }
        if (lane < 8) { float bv = bon[0];
#pragma unroll
            for (int i = 1; i < 8; ++i) bv = (lane == i) ? bon[i] : bv;
            *(float*)(sc + SC_BON + (size_t)cu * 256 + (w * 8 + lane) * 4) = bv; }
    }
    PA_BAR();
    float cum[8], cumC;
    {
        float base = 0.f, all = 0.f;
#pragma unroll
        for (int seg = 0; seg < 8; ++seg) { const float tq = *(const LAS float*)(lds + L_CUM + (seg * 64 + lane) * 4); all += tq; base += (seg < w) ? tq : 0.f; }
        float acc = base;
#pragma unroll
        for (int i = 0; i < 8; ++i) { acc += ld[i]; cum[i] = acc; }
        cumC = all;
    }
    if (w == 0) *(float*)(sc + SC_GAM + (size_t)cu * 256 + lane * 4) = __expf(cumC);
    {
        float att[8], bgt[8], kgt[8];
#pragma unroll
        for (int i = 0; i < 8; ++i) {
            const int t = w * 8 + i; const float ep = __expf(cum[i]), em = __expf(-cum[i]), eg = __expf(cumC - cum[i]);
            att[i] = -kk[i] * __expf(cum[i] - ld[i]); bgt[i] = bb[i] * eg; kgt[i] = kp[i] * eg;
            *(LAS bf16_t*)(lds + L_AT + (t * ST + lane) * 2) = f2bf(att[i]);
            *(LAS bf16_t*)(lds + L_RT + (t * ST + lane) * 2) = f2bf(rr[i] * ep);
            *(LAS bf16_t*)(lds + L_BT + (t * ST + lane) * 2) = f2bf(bb[i] * em);
            *(LAS bf16_t*)(lds + L_KT + (t * ST + lane) * 2) = f2bf(kp[i] * em);
        }
        u32x4 x;
        x.x = cvt_pk_bf16(att[0], att[1]); x.y = cvt_pk_bf16(att[2], att[3]); x.z = cvt_pk_bf16(att[4], att[5]); x.w = cvt_pk_bf16(att[6], att[7]); *(LAS u32x4*)(lds + L_ATT + (lane * ST + w * 8) * 2) = x;
        x.x = cvt_pk_bf16(vv[0], vv[1]); x.y = cvt_pk_bf16(vv[2], vv[3]); x.z = cvt_pk_bf16(vv[4], vv[5]); x.w = cvt_pk_bf16(vv[6], vv[7]); *(LAS u32x4*)(lds + L_VMT + (lane * ST + w * 8) * 2) = x;
        x.x = cvt_pk_bf16(bgt[0], bgt[1]); x.y = cvt_pk_bf16(bgt[2], bgt[3]); x.z = cvt_pk_bf16(bgt[4], bgt[5]); x.w = cvt_pk_bf16(bgt[6], bgt[7]); *(LAS u32x4*)(lds + L_BGT + (lane * ST + w * 8) * 2) = x;
        x.x = cvt_pk_bf16(kgt[0], kgt[1]); x.y = cvt_pk_bf16(kgt[2], kgt[3]); x.z = cvt_pk_bf16(kgt[4], kgt[5]); x.w = cvt_pk_bf16(kgt[6], kgt[7]); *(LAS u32x4*)(lds + L_KGT + (lane * ST + w * 8) * 2) = x;
    }
    PA_BAR();
    for (int i = tid; i < 9216 / 16; i += NTHR) *(LAS u32x4*)(lds + L_TBD + i * 16) = (u32x4){0u, 0u, 0u, 0u};
    {
        const int jt = w & 3, isR = w >> 2; const int yoff = isR ? L_RT : L_AT;
        const bf16x8 y0 = frag(lds, yoff, 16 * jt, 0, lane), y1 = frag(lds, yoff, 16 * jt, 1, lane);
        const int t = 16 * jt + l15;
#pragma unroll
        for (int xt = 0; xt < 8; ++xt) {
            const int isK = xt >> 2, it = xt & 3; const int xoff = isK ? L_KT : L_BT;
            f32x4 acc = (f32x4){0.f, 0.f, 0.f, 0.f};
            if (it <= jt) { acc = MFMA16(frag(lds, xoff, 16 * it, 0, lane), y0, acc); acc = MFMA16(frag(lds, xoff, 16 * it, 1, lane), y1, acc); }
#pragma unroll
            for (int i = 0; i < 4; ++i) { const int s = 16 * it + 4 * q + i; const bool keep = isR ? (s <= t) : (s < t); acc[i] = keep ? acc[i] : 0.f; }
            const int dst = isR ? (isK ? L_MRK : L_MRB) : (isK ? L_LAK : L_LOFF);
            if (!isR && !isK && it == jt) { *(LAS f32x4*)(lds + L_LDIAG + ((jt * 16 + l15) * 16 + 4 * q) * 4) = acc; acc = (f32x4){0.f, 0.f, 0.f, 0.f}; }
            st4(lds, dst, t, 16 * it + 4 * q, acc);
        }
    }
    PA_BAR();
    f32x4 xacc[4];
#pragma unroll
    for (int i = 0; i < 4; ++i) xacc[i] = (f32x4){0.f, 0.f, 0.f, 0.f};
    if (w == 0) {
        const int blk = q, j = l15; float tc[16];
#pragma unroll
        for (int t = 0; t < 16; ++t) {
            float acc = (t == j) ? 1.0f : 0.0f;
            f32x4 lr[4];
#pragma unroll
            for (int g = 0; g < 4; ++g) lr[g] = *(const LAS f32x4*)(lds + L_LDIAG + ((blk * 16 + t) * 16 + g * 4) * 4);
#pragma unroll
            for (int s = 0; s < t; ++s) acc += lr[s >> 2][s & 3] * tc[s];
            tc[t] = acc;
            *(LAS bf16_t*)(lds + L_TBD + ((16 * blk + t) * ST + 16 * blk + j) * 2) = f2bf(acc);
        }
    } else if (w >= 4) {
        const int vt = w - 4;
#pragma unroll
        for (int i = 0; i < 4; ++i)
#pragma unroll
            for (int ks = 0; ks < 2; ++ks) xacc[i] = MFMA16(frag(lds, L_LAK, 16 * i, ks, lane), frag(lds, L_VMT, 16 * vt, ks, lane), xacc[i]);
    }
    PA_BAR();
    {
        const int crow = 16 * w + l15;
#pragma unroll
        for (int i = 0; i < 4; ++i) {
            f32x4 acc = (w < 4) ? ld4(lds, L_ATT, crow, 16 * i + 4 * q) : xacc[i];
#pragma unroll
            for (int ks = 0; ks < 2; ++ks) acc = MFMA16(frag(lds, L_LOFF, 16 * i, ks, lane), frag(lds, L_SOLT, 16 * w, ks, lane), acc);
            st4(lds, L_SOLT, crow, 16 * i + 4 * q, acc);
            LDS_FENCE();
            f32x4 acc2 = (f32x4){0.f, 0.f, 0.f, 0.f};
#pragma unroll
            for (int ks = 0; ks < 2; ++ks) acc2 = MFMA16(frag(lds, L_TBD, 16 * i, ks, lane), frag(lds, L_SOLT, 16 * w, ks, lane), acc2);
            st4(lds, L_SOLT, crow, 16 * i + 4 * q, acc2);
            LDS_FENCE();
        }
    }
    PA_BAR();
    {
        const int a = w >> 1, pr = w & 1;
        { f32x4 acc[2];
#pragma unroll
            for (int u = 0; u < 2; ++u) { const int kt = 2 * pr + u; acc[u] = ld4(lds, L_RT, 16 * a + l15, 16 * kt + 4 * q);
#pragma unroll
                for (int ks = 0; ks < 2; ++ks) acc[u] = MFMA16(frag(lds, L_SOLT, 16 * kt, ks, lane), frag(lds, L_MRB, 16 * a, ks, lane), acc[u]); }
            *(u32x4*)(sc + SC_W2F + (size_t)cu * 8192 + ((a * 2 + pr) * 64 + lane) * 16) = pack8(acc[0], acc[1]); }
#pragma unroll
        for (int u = 0; u < 2; ++u) { const int vt = 2 * pr + u; f32x4 acc = (f32x4){0.f, 0.f, 0.f, 0.f};
#pragma unroll
            for (int ks = 0; ks < 2; ++ks) { acc = MFMA16(frag(lds, L_SOLT, 64 + 16 * vt, ks, lane), frag(lds, L_MRB, 16 * a, ks, lane), acc); acc = MFMA16(frag(lds, L_VMT, 16 * vt, ks, lane), frag(lds, L_MRK, 16 * a, ks, lane), acc); }
            u32x2 o; o.x = cvt_pk_bf16(acc[0], acc[1]); o.y = cvt_pk_bf16(acc[2], acc[3]);
            *(u32x2*)(sc + SC_YLF + (size_t)cu * 8192 + ((vt * 4 + a) * 64 + lane) * 8) = o; }
        { f32x4 acc[2];
#pragma unroll
            for (int u = 0; u < 2; ++u) { const int kt = 2 * pr + u; acc[u] = (f32x4){0.f, 0.f, 0.f, 0.f};
#pragma unroll
                for (int ks = 0; ks < 2; ++ks) acc[u] = MFMA16(frag(lds, L_SOLT, 16 * kt, ks, lane), frag(lds, L_BGT, 16 * a, ks, lane), acc[u]); }
            *(u32x4*)(sc + SC_PF + (size_t)cu * 8192 + ((a * 2 + pr) * 64 + lane) * 16) = pack8(acc[0], acc[1]); }
#pragma unroll
        for (int u = 0; u < 2; ++u) { const int vt = 2 * pr + u; f32x4 acc = (f32x4){0.f, 0.f, 0.f, 0.f};
#pragma unroll
            for (int ks = 0; ks < 2; ++ks) { acc = MFMA16(frag(lds, L_BGT, 16 * a, ks, lane), frag(lds, L_SOLT, 64 + 16 * vt, ks, lane), acc); acc = MFMA16(frag(lds, L_KGT, 16 * a, ks, lane), frag(lds, L_VMT, 16 * vt, ks, lane), acc); }
            u32x2 o; o.x = cvt_pk_bf16(acc[0], acc[1]); o.y = cvt_pk_bf16(acc[2], acc[3]);
            *(u32x2*)(sc + SC_QF + (size_t)cu * 8192 + ((a * 4 + vt) * 64 + lane) * 8) = o; }
    }
    PA_BAR();
}

#undef PA_BAR_UNUSED
__device__ __forceinline__ void wkv_pass_b(KArgP p, int task, int lane) {
    const int bh = task >> 2, vs = task & 3, q = lane >> 4, l15 = lane & 15;
    const unsigned char* sc = p->ws + W_RA; unsigned char* sf = p->ws + W_SF;
    f32x4 S[4];
#pragma unroll
    for (int m = 0; m < 4; ++m) S[m] = (f32x4){0.f, 0.f, 0.f, 0.f};
    for (int c = 0; c < 32; ++c) {
        const int cu = bh * 32 + c;
        u32x4 pf[4][2]; u32x2 qf[4]; f32x4 gm[4];
#pragma unroll
        for (int m = 0; m < 4; ++m) {
#pragma unroll
            for (int ks = 0; ks < 2; ++ks) pf[m][ks] = *(const u32x4*)(sc + SC_PF + (size_t)cu * 8192 + ((m * 2 + ks) * 64 + lane) * 16);
            qf[m] = *(const u32x2*)(sc + SC_QF + (size_t)cu * 8192 + ((m * 4 + vs) * 64 + lane) * 8);
            gm[m] = *(const f32x4*)(sc + SC_GAM + (size_t)cu * 256 + (16 * m + 4 * q) * 4);
        }
        u32x4 sfr[2];
#pragma unroll
        for (int ks = 0; ks < 2; ++ks) { sfr[ks] = pack8(S[2 * ks], S[2 * ks + 1]); *(u32x4*)(sf + (size_t)cu * 8192 + ((vs * 2 + ks) * 64 + lane) * 16) = sfr[ks]; }
#pragma unroll
        for (int m = 0; m < 4; ++m) {
            f32x4 acc = S[m] * gm[m] + (f32x4){lo_bf(qf[m].x), hi_bf(qf[m].x), lo_bf(qf[m].y), hi_bf(qf[m].y)};
#pragma unroll
            for (int ks = 0; ks < 2; ++ks) { bf16x8 av, bv; __builtin_memcpy(&av, &pf[m][ks], 16); __builtin_memcpy(&bv, &sfr[ks], 16); acc = MFMA16(av, bv, acc); }
            S[m] = acc;
        }
    }
#pragma unroll
    for (int m = 0; m < 4; ++m) *(f32x4*)(p->out + O_PWKV + ((size_t)bh * 64 + 16 * vs + l15) * 64 + 16 * m + 4 * q) = S[m];
}

__device__ __forceinline__ void wkv_pass_c(KArgP p, int cu, int jt, int lane) {
    const int bh = cu >> 5, c = cu & 31, b = bh >> 4, h = bh & 15, q = lane >> 4, l15 = lane & 15;
    const unsigned char* sc = p->ws + W_RA; const unsigned char* sf = p->ws + W_SF;
    const bf16_t* Z = (const bf16_t*)(p->ws + W_Z); const bf16_t* GG = (const bf16_t*)(p->ws + W_GG); bf16_t* YA = (bf16_t*)(p->ws + W_DYA);
    const int t = c * 64 + 16 * jt + l15; const int row = b * 2048 + t;
    bf16x8 w2[2], sfr[4][2]; u32x2 yl[4], zc[4], zp[4], gz[4];
#pragma unroll
    for (int ks = 0; ks < 2; ++ks) w2[ks] = *(const bf16x8*)(sc + SC_W2F + (size_t)cu * 8192 + ((jt * 2 + ks) * 64 + lane) * 16);
#pragma unroll
    for (int vt = 0; vt < 4; ++vt) { const int chv = h * 64 + 16 * vt + 4 * q;
        yl[vt] = *(const u32x2*)(sc + SC_YLF + (size_t)cu * 8192 + ((vt * 4 + jt) * 64 + lane) * 8);
#pragma unroll
        for (int ks = 0; ks < 2; ++ks) sfr[vt][ks] = *(const bf16x8*)(sf + (size_t)cu * 8192 + ((vt * 2 + ks) * 64 + lane) * 16);
        zc[vt] = *(const u32x2*)(Z + (size_t)row * ZLD + 2048 + chv);
        zp[vt] = (t > 0) ? *(const u32x2*)(Z + (size_t)(row - 1) * ZLD + 2048 + chv) : (u32x2){0u, 0u};
        gz[vt] = *(const u32x2*)(GG + (size_t)row * 1024 + chv); }
    const float bon = *(const float*)(sc + SC_BON + (size_t)cu * 256 + (16 * jt + l15) * 4);
    f32x4 y[4]; float s1 = 0.f;
#pragma unroll
    for (int vt = 0; vt < 4; ++vt) {
        f32x4 acc = (f32x4){lo_bf(yl[vt].x), hi_bf(yl[vt].x), lo_bf(yl[vt].y), hi_bf(yl[vt].y)};
#pragma unroll
        for (int ks = 0; ks < 2; ++ks) acc = MFMA16(sfr[vt][ks], w2[ks], acc);
        y[vt] = acc; s1 += (acc[0] + acc[1]) + (acc[2] + acc[3]);
    }
    s1 = xor32_sum(xor16_sum(s1)); const float mu = s1 * (1.0f / 64.0f);
    float s2 = 0.f;
#pragma unroll
    for (int vt = 0; vt < 4; ++vt) { y[vt] -= mu; s2 += (y[vt][0] * y[vt][0] + y[vt][1] * y[vt][1]) + (y[vt][2] * y[vt][2] + y[vt][3] * y[vt][3]); }
    s2 = xor32_sum(xor16_sum(s2)); const float rstd = rsqrtf(s2 * (1.0f / 64.0f) + GN_EPS);
#pragma unroll
    for (int vt = 0; vt < 4; ++vt) {
        const int chv = h * 64 + 16 * vt + 4 * q;
        const f32x4 zv = (f32x4){lo_bf(zc[vt].x), hi_bf(zc[vt].x), lo_bf(zc[vt].y), hi_bf(zc[vt].y)}, pv = (f32x4){lo_bf(zp[vt].x), hi_bf(zp[vt].x), lo_bf(zp[vt].y), hi_bf(zp[vt].y)};
        const f32x4 muv = *(const f32x4*)(p->in[8] + 2048 + chv); const f32x4 vm = zv + (pv - zv) * muv;
        const f32x4 g = (f32x4){lo_bf(gz[vt].x), hi_bf(gz[vt].x), lo_bf(gz[vt].y), hi_bf(gz[vt].y)};
        const f32x4 lw = *(const f32x4*)(p->in[17] + chv), lb = *(const f32x4*)(p->in[18] + chv);
        const f32x4 o = ((y[vt] * rstd) * lw + lb + bon * vm) * g;
        u32x2 ow; ow.x = cvt_pk_bf16(o[0], o[1]); ow.y = cvt_pk_bf16(o[2], o[3]);
        *(u32x2*)(YA + (size_t)row * 1024 + chv) = ow;
    }
}

__device__ __forceinline__ void scan_sample(KArgP p, int unit, float* lds) {
    int tid = threadIdx.x; asm volatile("" : "+v"(tid));
    const int wave = tid >> 6, lane = tid & 63, b = unit >> 4, h = unit & 15, ch = h * 64 + lane;
    const bf16_t* Z = (const bf16_t*)(p->ws + W_Z); const bf16_t* XW = (const bf16_t*)(p->ws + W_XW); const bf16_t* XA = (const bf16_t*)(p->ws + W_XA); const bf16_t* GG = (const bf16_t*)(p->ws + W_GG);
    bf16_t* YA = (bf16_t*)(p->ws + W_DYA);
    float* ops = lds + wave * (4 * 7 * 64 + 64);
    float* bon = ops + 4 * 7 * 64;
    HeadConst hc; hc.mu_r = p->in[8][ch]; hc.mu_k = p->in[8][1024 + ch]; hc.mu_v = p->in[8][2048 + ch]; hc.k_k = p->in[14][ch]; hc.k_a = p->in[15][ch]; hc.r_k = p->in[16][ch];
    const float lw = p->in[17][ch], lb = p->in[18][ch];
    const int rbase = MP + b * 4;
    float pz[3];
#pragma unroll
    for (int q = 0; q < 3; ++q) pz[q] = p->in[2][(size_t)b * DSH + q * 1024 + ch];
#pragma unroll
    for (int t = 0; t < 4; ++t) {
        float z[3];
#pragma unroll
        for (int q = 0; q < 3; ++q) z[q] = bf2f(Z[(size_t)(rbase + t) * ZLD + q * 1024 + ch]);
        const size_t ro = (size_t)(rbase + t) * 1024 + ch;
        stage_token(z[0], z[1], z[2], pz[0], pz[1], pz[2], bf2f(XW[ro]), bf2f(XA[ro]), bf2f(GG[ro]), hc, ops + t * 7 * 64, bon + t, lane);
#pragma unroll
        for (int q = 0; q < 3; ++q) pz[q] = z[q];
    }
    f32x4 S[16];
    const float* s0 = p->in[3] + ((size_t)unit * 64 + lane) * 64;
#pragma unroll
    for (int j = 0; j < 16; ++j) S[j] = *(const f32x4*)(s0 + j * 4);
    __syncthreads();
#pragma nounroll
    for (int t = 0; t < 4; ++t) {
        const float* o = ops + t * 7 * 64;
        f32x4 a4 = (f32x4){0.f, 0.f, 0.f, 0.f};
#pragma unroll
        for (int j = 0; j < 16; ++j) { a4 += S[j] * *(const f32x4*)(o + 64 + j * 4); if ((j & 3) == 3) asm volatile("" ::: "memory"); }
        const float sa = -((a4[0] + a4[1]) + (a4[2] + a4[3]));
        const float vv = o[320 + lane];
        f32x4 y4 = (f32x4){0.f, 0.f, 0.f, 0.f};
#pragma unroll
        for (int j = 0; j < 16; ++j) { S[j] = S[j] * *(const f32x4*)(o + j * 4) + (sa * *(const f32x4*)(o + 128 + j * 4) + vv * *(const f32x4*)(o + 192 + j * 4)); y4 += S[j] * *(const f32x4*)(o + 256 + j * 4); if ((j & 1) == 1) asm volatile("" ::: "memory"); }
        const float y = (y4[0] + y4[1]) + (y4[2] + y4[3]);
        const float mu = wave_sum(y) * (1.0f / 64.0f); const float d = y - mu; const float var = wave_sum(d * d) * (1.0f / 64.0f);
        const float yn = d * rsqrtf(var + GN_EPS) * lw + lb;
        YA[(size_t)(rbase + t) * 1024 + ch] = f2bf((yn + bon[t] * vv) * o[384 + lane]);
    }
    float* so = p->out + O_SWKV + ((size_t)unit * 64 + lane) * 64;
#pragma unroll
    for (int j = 0; j < 16; ++j) *(f32x4*)(so + j * 4) = S[j];
    __syncthreads();
}

__device__ __forceinline__ void row_load_bf(f32x4 (&o)[8], const bf16_t* C, int row, int lane) {
#pragma unroll
    for (int i = 0; i < 8; ++i) { const u32x2 w = *(const u32x2*)(C + (size_t)row * DM + i * 256 + lane * 4); o[i] = (f32x4){lo_bf(w.x), hi_bf(w.x), lo_bf(w.y), hi_bf(w.y)}; }
}
template <int S>
__device__ __forceinline__ f32x4 part_sum(const float* P, int srow, int c) {
    f32x4 a = *(const f32x4*)(P + (size_t)srow * DM + c);
#pragma unroll
    for (int sp = 1; sp < S; ++sp) a += *(const f32x4*)(P + ((size_t)sp * 512 + srow) * DM + c);
    return a;
}
__device__ __forceinline__ float sumsq8(const f32x4 (&v)[8]) { float s = 0.f;
#pragma unroll
    for (int i = 0; i < 8; ++i) s += (v[i][0] * v[i][0] + v[i][1] * v[i][1]) + (v[i][2] * v[i][2] + v[i][3] * v[i][3]);
    return s; }

__global__ void __launch_bounds__(NTHR, 2) fwd_megakernel(Params p_unused) {
    extern __shared__ __attribute__((aligned(16))) unsigned char lds_raw[];
    cg::grid_group grid = cg::this_grid();
    LAS unsigned char* lds = (LAS unsigned char*)lds_raw;
    float* ldsf = (float*)lds_raw;
    const int bid = blockIdx.x, nblk = gridDim.x;
    __shared__ uint4 xb_words;
    if (threadIdx.x == 0) xb_words = make_uint4(0u, 0u, 0u, 0u);
    __syncthreads();
    if (kargs()->ws == nullptr) grid.sync();
    const XcdBarrier xbar = xcd_barrier_post((unsigned*)(kargs()->ws + W_BAR), (volatile LAS unsigned*)&xb_words);
#define PHASE_BEGIN() KArgP p = kargs(); int tid = threadIdx.x; asm volatile("" : "+v"(tid)); const int wave = tid >> 6, lane = tid & 63; (void)wave; (void)lane; \
    unsigned char* ws = p->ws; bf16_t* Z = (bf16_t*)(ws + W_Z); float* ssq = (float*)(ws + W_SSQ); float* Y = p->out + O_Y; (void)Z; (void)ssq; (void)Y;

    {
        PHASE_BEGIN();
    transpose_job(p->in[7], 8480, 2048, (bf16_t*)(ws + W_IN), 2048, 8704, MapWin(), ldsf, bid, nblk);
    {
        bf16_t* H = (bf16_t*)(ws + W_H); const float* gw = p->in[6];
        for (int row = bid * 8 + wave; row < M; row += 2 * nblk * 8) {
            const int rowB = row + nblk * 8; const bool hasB = rowB < M;
            const float* xa = xrow(p, row); const float* xb = xrow(p, hasB ? rowB : row); f32x4 va[8], vb[8];
#pragma unroll
            for (int i = 0; i < 8; ++i) { va[i] = *(const f32x4*)(xa + i * 256 + lane * 4); vb[i] = *(const f32x4*)(xb + i * 256 + lane * 4); }
            const float ra = rsqrtf(wave_sum(sumsq8(va)) * (1.0f / DM) + NORM_EPS), rb = rsqrtf(wave_sum(sumsq8(vb)) * (1.0f / DM) + NORM_EPS);
#pragma unroll
            for (int i = 0; i < 8; ++i) { const f32x4 g = *(const f32x4*)(gw + i * 256 + lane * 4); const f32x4 oa = va[i] * ra * g, ob = vb[i] * rb * g;
                u32x2 w; w.x = cvt_pk_bf16(oa[0], oa[1]); w.y = cvt_pk_bf16(oa[2], oa[3]); *(u32x2*)(H + (size_t)row * DM + i * 256 + lane * 4) = w;
                if (hasB) { u32x2 w2; w2.x = cvt_pk_bf16(ob[0], ob[1]); w2.y = cvt_pk_bf16(ob[2], ob[3]); *(u32x2*)(H + (size_t)rowB * DM + i * 256 + lane * 4) = w2; } }
        }
        for (int e = bid * NTHR + tid; e < 128 * 11 * 256; e += nblk * NTHR) { const int c4 = e & 255, j = (e >> 8) % 11, b = (e >> 8) / 11;
            *(f32x4*)(p->out + O_SPOOL + ((size_t)b * 15 + j) * 1024 + c4 * 4) = *(const f32x4*)(p->in[4] + ((size_t)b * 15 + j + 4) * 1024 + c4 * 4); }
    }
    }
    xcd_barrier(xbar);

    {
        PHASE_BEGIN();
        pg8::Gemm g{(const bf16_t*)(ws + W_H), (const bf16_t*)(ws + W_IN), M, 8704, 2048, 2048, 2048, 0, 0}; pg8::StaticOrder S; S.init(M, 8704, nblk, bid, 2048);
        EpiZ E{Z, p->out}; pg8::gemm_phase(lds, g, S, E);
        { const int nfull = (34 * 34) / nblk, nrem = (34 * 34) - nfull * nblk;
          if (bid >= nrem && nrem > 0 && nblk - nrem >= 8) { const int ob = bid - nrem, onb = nblk - nrem;
            transpose_job(p->in[19], 2048, 1024, (bf16_t*)(ws + W_AB), 1024, 2048, MapId(), ldsf, ob, onb);
            transpose_job(p->in[22], 2048, 1024, (bf16_t*)(ws + W_AB) + (size_t)2048 * 1024, 1024, 2048, MapId(), ldsf, ob, onb);
            transpose_job(p->in[23], 2048, 2048, (bf16_t*)(ws + W_O), 2048, 2048, MapId(), ldsf, ob, onb);
            for (int g = 0; g < 4; ++g) transpose_job(p->in[20] + (size_t)g * 65536, 256, 256, (bf16_t*)(ws + W_POOL) + (size_t)g * 65536, 256, 256, MapId(), ldsf, ob, onb);
            transpose_job(p->in[10], 1024, 64, (bf16_t*)(ws + W_LR), 256, 1024, MapId(), ldsf, ob, onb);
            transpose_job(p->in[12], 1024, 64, (bf16_t*)(ws + W_LR) + (size_t)1024 * 256, 256, 1024, MapId(), ldsf, ob, onb);
            transpose_job(p->in[13], 1024, 160, (bf16_t*)(ws + W_LR) + (size_t)2048 * 256, 256, 1024, MapId(), ldsf, ob, onb);
          } else if (nrem == 0 || nblk - nrem < 8) {
            transpose_job(p->in[19], 2048, 1024, (bf16_t*)(ws + W_AB), 1024, 2048, MapId(), ldsf, bid, nblk);
            transpose_job(p->in[22], 2048, 1024, (bf16_t*)(ws + W_AB) + (size_t)2048 * 1024, 1024, 2048, MapId(), ldsf, bid, nblk);
            transpose_job(p->in[23], 2048, 2048, (bf16_t*)(ws + W_O), 2048, 2048, MapId(), ldsf, bid, nblk);
            for (int g = 0; g < 4; ++g) transpose_job(p->in[20] + (size_t)g * 65536, 256, 256, (bf16_t*)(ws + W_POOL) + (size_t)g * 65536, 256, 256, MapId(), ldsf, bid, nblk);
            transpose_job(p->in[10], 1024, 64, (bf16_t*)(ws + W_LR), 256, 1024, MapId(), ldsf, bid, nblk);
            transpose_job(p->in[12], 1024, 64, (bf16_t*)(ws + W_LR) + (size_t)1024 * 256, 256, 1024, MapId(), ldsf, bid, nblk);
            transpose_job(p->in[13], 1024, 160, (bf16_t*)(ws + W_LR) + (size_t)2048 * 256, 256, 1024, MapId(), ldsf, bid, nblk);
          } }
    }
    xcd_barrier(xbar);

    {
        PHASE_BEGIN();
        bf16_t* A2 = (bf16_t*)(ws + W_A2);
        for (int e = bid * NTHR + tid; e < M * 96; e += nblk * NTHR) { const int r = e / 96, j8 = e - r * 96; u32x4 o = (u32x4){0u, 0u, 0u, 0u};
            int kind = -1, zc = 0;
            if (j8 < 8) { kind = 0; zc = ZC_LR + j8 * 8; } else if (j8 >= 32 && j8 < 40) { kind = 1; zc = ZC_LR + 64 + (j8 - 32) * 8; } else if (j8 >= 64 && j8 < 84) { kind = 2; zc = ZC_LR + 128 + (j8 - 64) * 8; }
            if (kind >= 0) {
                const bool smp = r >= MP; const int t = smp ? (r - MP) & 3 : r & 2047;
                f32x4 z0, z1, p0, p1; unpack8(*(const u32x4*)(Z + (size_t)r * ZLD + zc), z0, z1);
                if (t > 0) unpack8(*(const u32x4*)(Z + (size_t)(r - 1) * ZLD + zc), p0, p1);
                else if (smp) { const float* sp = p->in[2] + (size_t)((r - MP) >> 2) * DSH + zc; p0 = *(const f32x4*)sp; p1 = *(const f32x4*)(sp + 4); }
                else { p0 = (f32x4){0.f, 0.f, 0.f, 0.f}; p1 = p0; }
                const f32x4 m0 = *(const f32x4*)(p->in[8] + zc), m1 = *(const f32x4*)(p->in[8] + zc + 4);
                f32x4 v0 = z0 + (p0 - z0) * m0, v1 = z1 + (p1 - z1) * m1;
#pragma unroll
                for (int j = 0; j < 4; ++j) {
                    if (kind == 0) { v0[j] = 1.0f - 2.0f * __builtin_amdgcn_rcpf(1.0f + __expf(2.0f * v0[j])); v1[j] = 1.0f - 2.0f * __builtin_amdgcn_rcpf(1.0f + __expf(2.0f * v1[j])); }
                    else if (kind == 2) { v0[j] = sigmoidf_(v0[j]); v1[j] = sigmoidf_(v1[j]); } }
                o = pack8(v0, v1); }
            *(u32x4*)(A2 + (size_t)r * 768 + j8 * 8) = o; }
        bf16_t* D = (bf16_t*)(ws + W_DYA);
        for (int e = bid * NTHR + tid; e < 512 * 128; e += nblk * NTHR) { const int seg = e >> 7, c = (e & 127) * 8; const int gi = c >> 8, win = 2 << gi;
            const int r0 = seg * 16, t0 = r0 & 2047;
            f32x4 s0 = (f32x4){0.f, 0.f, 0.f, 0.f}, s1 = s0;
            for (int j = 1; j < win; ++j) { if (t0 - j >= 0) { f32x4 a, bq; unpack8(*(const u32x4*)(Z + (size_t)(r0 - j) * ZLD + ZC_P + c), a, bq); s0 += a; s1 += bq; } }
#pragma unroll 4
            for (int i = 0; i < 16; ++i) { const int t = t0 + i; f32x4 a, bq; unpack8(*(const u32x4*)(Z + (size_t)(r0 + i) * ZLD + ZC_P + c), a, bq);
                s0 += a; s1 += bq; const float ic = 1.0f / (float)min(win, t + 1);
                *(u32x4*)(D + (size_t)(r0 + i) * 1024 + c) = pack8(s0 * ic - a, s1 * ic - bq);
                if (t - win + 1 >= 0) { f32x4 oa, ob; unpack8(*(const u32x4*)(Z + (size_t)(r0 + i - win + 1) * ZLD + ZC_P + c), oa, ob); s0 -= oa; s1 -= ob; } }
        }
        for (int e = bid * NTHR + tid; e < 512 * 128; e += nblk * NTHR) { const int r = MP + (e >> 7), c = (e & 127) * 8; const int gi = c >> 8, win = 2 << gi;
            const int b = (r - MP) >> 2, t = (r - MP) & 3;
            f32x4 s0 = (f32x4){0.f, 0.f, 0.f, 0.f}, s1 = s0, z0 = s0, z1 = s0;
            for (int j = 0; j < win; ++j) { const int tj = t - j; f32x4 a, bq;
                if (tj >= 0) unpack8(*(const u32x4*)(Z + (size_t)(r - j) * ZLD + ZC_P + c), a, bq);
                else { const float* sp = p->in[4] + ((size_t)b * 15 + (15 + tj)) * 1024 + c; a = *(const f32x4*)sp; bq = *(const f32x4*)(sp + 4); }
                if (j == 0) { z0 = a; z1 = bq; }
                s0 += a; s1 += bq; }
            const float ic = 1.0f / (float)win;
            *(u32x4*)(D + (size_t)r * 1024 + c) = pack8(s0 * ic - z0, s1 * ic - z1); }
    }
    xcd_barrier(xbar);

    {
        PHASE_BEGIN();
        pg8::Gemm g{(const bf16_t*)(ws + W_A2), (const bf16_t*)(ws + W_LR), M, 3072, 256, 768, 256, 2, 256}; pg8::LowRankOrder S; S.part = 0; S.G = nblk; S.c = bid; S.ntk = 4;
        EpiLR E{(bf16_t*)(ws + W_XW), p->in[9], p->in[11]}; pg8::gemm_phase(lds, g, S, E);
        pg8::Gemm g3{(const bf16_t*)(ws + W_DYA), (const bf16_t*)(ws + W_POOL), M, 1024, 256, 1024, 256, 0, 256}; pg8::StaticOrder S3; S3.init(M, 1024, nblk, nblk - 1 - bid, 256);
        EpiPool E3{(bf16_t*)(ws + W_YB), p->in[21]}; pg8::gemm_phase(lds, g3, S3, E3);
    }
    xcd_barrier(xbar);

    {
        PHASE_BEGIN();
        scan_sample(p, bid * 8 + wave, ldsf);
        __syncthreads();
        { PARaw R; int cu = bid; if (cu < 2048) pa_load(p, cu, wave, lane, R);
          for (; cu < 2048; cu += nblk) wkv_pass_a(p, cu, lds, R, cu + nblk < 2048 ? cu + nblk : -1);
          __syncthreads(); }
    }
    xcd_barrier(xbar);
    {
        PHASE_BEGIN();
        if (bid < 64) { if (wave < 4) wkv_pass_b(p, bid * 4 + wave, lane); }
        else {
            const int ob = bid - 64, onb = nblk - 64;
            pg8::Gemm g{(const bf16_t*)(ws + W_YB), (const bf16_t*)(ws + W_AB) + (size_t)2048 * 1024, M, 2048, 1024, 1024, 1024, 0, 0};
            pg8::MixOrder S; S.base.init(MP, 2048, 1, 0, 1024); S.G = onb; S.c = ob; S.sample_only = false;
            EpiGateB E{(bf16_t*)(ws + W_MM), Z}; pg8::gemm_phase(lds, g, S, E);
            pg8::Gemm ga{(const bf16_t*)(ws + W_DYA), (const bf16_t*)(ws + W_AB), M, 2048, 1024, 1024, 1024, 0, 0}; pg8::MixOrder SS = S; SS.sample_only = true;
            EpiGateA EA{Z, (bf16_t*)(ws + W_MM)}; pg8::gemm_phase(lds, ga, SS, EA);
            { const int first1 = 256 - (onb - 16), nfree = (onb - 16) - first1;
              pg8::Gemm gl{(const bf16_t*)(ws + W_A2), (const bf16_t*)(ws + W_LR), M, 3072, 256, 768, 256, 2, 256};
              pg8::LowRankOrder SL; SL.part = 1; SL.G = nfree > 0 ? nfree : onb; SL.c = nfree > 0 ? ((ob >= first1 && ob < onb - 16) ? ob - first1 : -1) : ob; SL.ntk = 4;
              EpiLR EL{(bf16_t*)(ws + W_XW), p->in[9], p->in[11]}; pg8::gemm_phase(lds, gl, SL, EL); }
        }
    }
    xcd_barrier(xbar);
    {
        PHASE_BEGIN();
        for (int cu = bid * 2 + (wave >> 2); cu < 2048; cu += nblk * 2) { if (wave < 8) wkv_pass_c(p, cu, wave & 3, lane); }
    }
    xcd_barrier(xbar);
    {
        PHASE_BEGIN();
        transpose_job(p->in[26], 11264, 2048, (bf16_t*)(ws + W_GU), 2048, 11264, MapId(), ldsf, bid, nblk);
        transpose_job(p->in[29], 2048, 5632, (bf16_t*)(ws + W_D), 5632, 2048, MapId(), ldsf, bid, nblk);
        pg8::Gemm g{(const bf16_t*)(ws + W_DYA), (const bf16_t*)(ws + W_AB), M, 2048, 1024, 1024, 1024, 0, 0}; pg8::StaticOrder S; S.init(MP, 2048, nblk, bid, 1024);
        EpiGateA E{Z, (bf16_t*)(ws + W_MM)}; pg8::gemm_phase(lds, g, S, E);
    }
    xcd_barrier(xbar);

    {
        PHASE_BEGIN();
        pg8::Gemm g{(const bf16_t*)(ws + W_MM), (const bf16_t*)(ws + W_O), M, 2048, 2048, 2048, 2048, 0, 0}; pg8::SplitOrder S; S.init(nblk, bid, 2048, 8);
        EpiOutP E{(bf16_t*)(ws + W_O16), (float*)(ws + W_PART5)}; pg8::gemm_phase(lds, g, S, E);
    }
    xcd_barrier(xbar);

    {
        PHASE_BEGIN();
        bf16_t* H2 = (bf16_t*)(ws + W_H2); const float* g1 = p->in[24]; const float* g2 = p->in[25]; const float* PT = (const float*)(ws + W_PART5); const bf16_t* O16 = (const bf16_t*)(ws + W_O16);
        const int stride = nblk * 8;
        for (int row = bid * 8 + wave; row < MP; row += 2 * stride) {
            const int rowB = row + stride; const bool hasB = rowB < MP;
            f32x4 oa[8], ob[8], xa[8], xb[8];
            row_load_bf(oa, O16, row, lane); if (hasB) row_load_bf(ob, O16, rowB, lane);
#pragma unroll
            for (int i = 0; i < 8; ++i) { xa[i] = *(const f32x4*)(p->in[0] + (size_t)row * DM + i * 256 + lane * 4); if (hasB) xb[i] = *(const f32x4*)(p->in[0] + (size_t)rowB * DM + i * 256 + lane * 4); }
            const float ra = rsqrtf(wave_sum(sumsq8(oa)) * (1.0f / DM) + NORM_EPS), rb = hasB ? rsqrtf(wave_sum(sumsq8(ob)) * (1.0f / DM) + NORM_EPS) : 0.f;
#pragma unroll
            for (int i = 0; i < 8; ++i) { const int c = i * 256 + lane * 4; const f32x4 g = *(const f32x4*)(g1 + c);
                xa[i] = xa[i] + oa[i] * ra * g; *(f32x4*)(Y + (size_t)row * DM + c) = xa[i];
                if (hasB) { xb[i] = xb[i] + ob[i] * rb * g; *(f32x4*)(Y + (size_t)rowB * DM + c) = xb[i]; } }
            const float qa = rsqrtf(wave_sum(sumsq8(xa)) * (1.0f / DM) + NORM_EPS), qb = hasB ? rsqrtf(wave_sum(sumsq8(xb)) * (1.0f / DM) + NORM_EPS) : 0.f;
#pragma unroll
            for (int i = 0; i < 8; ++i) { const int c = i * 256 + lane * 4; const f32x4 g = *(const f32x4*)(g2 + c);
                { const f32x4 o = xa[i] * qa * g; u32x2 w; w.x = cvt_pk_bf16(o[0], o[1]); w.y = cvt_pk_bf16(o[2], o[3]); *(u32x2*)(H2 + (size_t)row * DM + c) = w; }
                if (hasB) { const f32x4 o = xb[i] * qb * g; u32x2 w; w.x = cvt_pk_bf16(o[0], o[1]); w.y = cvt_pk_bf16(o[2], o[3]); *(u32x2*)(H2 + (size_t)rowB * DM + c) = w; } }
        }
        for (int srow = bid * 8 + wave; srow < M - MP; srow += stride) {
            const int row = MP + srow; float s1 = 0.f;
#pragma unroll 1
            for (int i = 0; i < 8; ++i) { const f32x4 o = part_sum<8>(PT, srow, i * 256 + lane * 4); s1 += (o[0] * o[0] + o[1] * o[1]) + (o[2] * o[2] + o[3] * o[3]); }
            const float ra = rsqrtf(wave_sum(s1) * (1.0f / DM) + NORM_EPS); float s2 = 0.f;
#pragma unroll 1
            for (int i = 0; i < 8; ++i) { const int c = i * 256 + lane * 4; const f32x4 o = part_sum<8>(PT, srow, c);
                const f32x4 v = *(const f32x4*)(p->in[1] + (size_t)srow * DM + c) + o * ra * *(const f32x4*)(g1 + c); *(f32x4*)(Y + (size_t)row * DM + c) = v; s2 += (v[0] * v[0] + v[1] * v[1]) + (v[2] * v[2] + v[3] * v[3]); }
            const float qa = rsqrtf(wave_sum(s2) * (1.0f / DM) + NORM_EPS);
            asm volatile("s_waitcnt vmcnt(0)" ::: "memory");
#pragma unroll 1
            for (int i = 0; i < 8; ++i) { const int c = i * 256 + lane * 4; const f32x4 o = *(const f32x4*)(Y + (size_t)row * DM + c) * qa * *(const f32x4*)(g2 + c);
                u32x2 w; w.x = cvt_pk_bf16(o[0], o[1]); w.y = cvt_pk_bf16(o[2], o[3]); *(u32x2*)(H2 + (size_t)row * DM + c) = w; }
        }
    }
    xcd_barrier(xbar);

    {
        PHASE_BEGIN();
        pg8::Gemm g{(const bf16_t*)(ws + W_H2), (const bf16_t*)(ws + W_GU), M, DFF, 2048, 2048, 2048, 0, 0}; pg8::StaticOrder S; S.init(M, DFF, nblk, bid, 2048);
        EpiGate7 E{(bf16_t*)(ws + W_GATE), p->out}; pg8::gemm_phase(lds, g, S, E);
    }
    xcd_barrier(xbar);

    {
        PHASE_BEGIN();
        pg8::Gemm g{(const bf16_t*)(ws + W_H2), (const bf16_t*)(ws + W_GU) + (size_t)DFF * 2048, M, DFF, 2048, 2048, 2048, 0, 0}; pg8::StaticOrder S; S.init(M, DFF, nblk, bid, 2048);
        EpiAct E{(const bf16_t*)(ws + W_GATE), (bf16_t*)(ws + W_ACT), p->in[27], p->in[28], p->in[5]}; pg8::gemm_phase(lds, g, S, E);
    }
    xcd_barrier(xbar);

    {
        PHASE_BEGIN();
        pg8::Gemm g{(const bf16_t*)(ws + W_ACT), (const bf16_t*)(ws + W_D), M, 2048, DFF, DFF, DFF, 0, 0}; pg8::SplitOrder S; S.init(nblk, bid, DFF, 11);
        EpiOutP E{(bf16_t*)(ws + W_F), (float*)(ws + W_PART9)}; pg8::gemm_phase(lds, g, S, E);
    }
    xcd_barrier(xbar);

    {
        PHASE_BEGIN();
        const bf16_t* F = (const bf16_t*)(ws + W_F); const float* g3 = p->in[30]; const float* PT = (const float*)(ws + W_PART9);
        const int stride = nblk * 8;
        for (int row = bid * 8 + wave; row < MP; row += 2 * stride) {
            const int rowB = row + stride; const bool hasB = rowB < MP;
            f32x4 fa[8], fb[8], xa[8], xb[8];
            row_load_bf(fa, F, row, lane); if (hasB) row_load_bf(fb, F, rowB, lane);
#pragma unroll
            for (int i = 0; i < 8; ++i) { xa[i] = *(const f32x4*)(Y + (size_t)row * DM + i * 256 + lane * 4); if (hasB) xb[i] = *(const f32x4*)(Y + (size_t)rowB * DM + i * 256 + lane * 4); }
            const float ra = rsqrtf(wave_sum(sumsq8(fa)) * (1.0f / DM) + NORM_EPS), rb = hasB ? rsqrtf(wave_sum(sumsq8(fb)) * (1.0f / DM) + NORM_EPS) : 0.f;
#pragma unroll
            for (int i = 0; i < 8; ++i) { const int c = i * 256 + lane * 4; const f32x4 g = *(const f32x4*)(g3 + c);
                *(f32x4*)(Y + (size_t)row * DM + c) = xa[i] + fa[i] * ra * g;
                if (hasB) *(f32x4*)(Y + (size_t)rowB * DM + c) = xb[i] + fb[i] * rb * g; }
        }
        for (int srow = bid * 8 + wave; srow < M - MP; srow += stride) {
            const int row = MP + srow; float s1 = 0.f;
#pragma unroll 1
            for (int i = 0; i < 8; ++i) { const f32x4 o = part_sum<11>(PT, srow, i * 256 + lane * 4); s1 += (o[0] * o[0] + o[1] * o[1]) + (o[2] * o[2] + o[3] * o[3]); }
            const float ra = rsqrtf(wave_sum(s1) * (1.0f / DM) + NORM_EPS);
#pragma unroll 1
            for (int i = 0; i < 8; ++i) { const int c = i * 256 + lane * 4; const f32x4 o = part_sum<11>(PT, srow, c);
                *(f32x4*)(Y + (size_t)row * DM + c) = *(const f32x4*)(Y + (size_t)row * DM + c) + o * ra * *(const f32x4*)(g3 + c); }
        }
    }
}

extern "C" void kernel_launch(void* const* d_in, const int* in_sizes, int n_in, void* d_out, int out_size, void* d_ws, size_t ws_size, hipStream_t stream) {
    static int grid_blocks = 0;
    if (!grid_blocks) {
        int dev = 0, cus = 0, per_cu = 0;
        hipGetDevice(&dev);
        hipDeviceGetAttribute(&cus, hipDeviceAttributeMultiprocessorCount, dev);
        hipFuncSetAttribute((const void*)fwd_megakernel, hipFuncAttributeMaxDynamicSharedMemorySize, LDS_BYTES);
        hipOccupancyMaxActiveBlocksPerMultiprocessor(&per_cu, (const void*)fwd_megakernel, NTHR, LDS_BYTES);
        if (per_cu < 1) per_cu = 1;
        grid_blocks = cus * 1;
        if (ws_size < W_END) fprintf(stderr, "kernel_launch: workspace too small: %zu < %zu\n", ws_size, (size_t)W_END);
        if (n_in != 31) fprintf(stderr, "kernel_launch: expected 31 inputs, got %d\n", n_in);
    }
    Params p{};
    for (int i = 0; i < 31; ++i) p.in[i] = (const float*)d_in[i];
    p.out = (float*)d_out; p.ws = (unsigned char*)d_ws;
    hipMemsetAsync((unsigned char*)d_ws + W_BAR, 0, 16384, stream);
    void* args[] = {&p};
    hipError_t e = hipLaunchCooperativeKernel((const void*)fwd_megakernel, dim3(grid_blocks), dim3(NTHR), args, LDS_BYTES, stream);
    if (e != hipSuccess) fprintf(stderr, "cooperative launch failed: %s (grid %d)\n", hipGetErrorString(e), grid_blocks);
}
```
